# Optimizing an MI355X kernel written in HIP

```python
import math
import jax, jax.numpy as jnp
from jax import lax
import numpy as np

D_MODEL = 1024
BATCH = 2
SEQ = 8192
DEPTH = 1

MEM_LEN = 256
ATTN_HEADS = 8
ATTN_HEAD_DIM = D_MODEL // 16
ATTN_WIDTH = ATTN_HEADS * ATTN_HEAD_DIM
SSM_WIDTH = D_MODEL - ATTN_WIDTH
SSM_GROUP = 16
SSM_GROUPS = SSM_WIDTH // SSM_GROUP
SSM_STATE = 64
MIX_WIDTH = ATTN_WIDTH + SSM_WIDTH
IN_WIDTH = 3 * ATTN_WIDTH + SSM_WIDTH
Q_BLOCK = 128
DT_MIN = 1e-3
DT_MAX = 1e-1
XATTN_HEADS = 4
XATTN_HEAD_DIM = D_MODEL // XATTN_HEADS
PEER_HEADS = 8
PEER_KEYS = 128
PEER_EXPERTS = PEER_KEYS * PEER_KEYS
PEER_TOPK = 16
PEER_KEY_DIM = 128
PEER_QUERY_DIM = 2 * PEER_KEY_DIM
TOKEN_BLOCK = 128
EPS = 1e-6

kernel_name = "hybrid_sba_s5_peer_block"


def rmsnorm(x, g):
    xf = x.astype(jnp.float32)
    y = xf * lax.rsqrt(jnp.mean(xf * xf, axis=-1, keepdims=True) + EPS)
    return (y * g.astype(jnp.float32)).astype(x.dtype)


def stick_breaking_attention(q, k, v):
    b, h, s, dh = q.shape
    nb = s // Q_BLOCK
    scale = dh ** -0.5
    q_blocks = q.reshape(b, h, nb, Q_BLOCK, dh).transpose(2, 0, 1, 3, 4)
    key_pos = jnp.arange(s)

    def block(args):
        q_blk, blk = args
        z = jnp.einsum('bhqd,bhkd->bhqk', q_blk, k, preferred_element_type=jnp.float32) * scale
        q_pos = blk * Q_BLOCK + jnp.arange(Q_BLOCK)
        mask = key_pos[None, :] < q_pos[:, None]
        log_stay = jnp.where(mask, jax.nn.log_sigmoid(-z), 0.0)
        later = lax.cumsum(log_stay, axis=3, reverse=True) - log_stay
        w = jnp.where(mask, jnp.exp(jax.nn.log_sigmoid(z) + later), 0.0)
        return jnp.einsum('bhqk,bhkd->bhqd', w.astype(v.dtype), v)

    out = lax.map(block, (q_blocks, jnp.arange(nb)))
    return out.transpose(1, 2, 0, 3, 4).reshape(b, h, s, dh)


def s5_mixer(u, a_re, a_im, log_dt, b_re, b_im, c_re, c_im, d_skip, w_glu, b_glu):
    bsz, s, _ = u.shape
    f32 = jnp.float32
    uf = u.astype(f32).reshape(bsz, s, SSM_GROUPS, SSM_GROUP)
    lam = lax.complex(a_re.astype(f32), a_im.astype(f32))
    dt = jnp.exp(log_dt.astype(f32))[:, None]
    lam_bar = jnp.exp(lam * dt)
    b_mat = lax.complex(b_re.astype(f32), b_im.astype(f32))
    b_bar = ((lam_bar - 1.0) / lam)[..., None] * b_mat
    bu = jnp.einsum('gpc,bsgc->bsgp', b_bar, uf.astype(jnp.complex64))
    a_seq = jnp.broadcast_to(lam_bar, bu.shape)

    def combine(left, right):
        a_l, b_l = left
        a_r, b_r = right
        return a_r * a_l, a_r * b_l + b_r

    _, states = lax.associative_scan(combine, (a_seq, bu), axis=1)
    c_mat = lax.complex(c_re.astype(f32), c_im.astype(f32))
    y = jnp.real(jnp.einsum('gcp,bsgp->bsgc', c_mat, states)) + d_skip.astype(f32) * uf
    y = jax.nn.gelu(y.reshape(bsz, s, SSM_WIDTH))
    gate = jax.nn.sigmoid(y @ w_glu.astype(f32) + b_glu.astype(f32))
    return (y * gate).astype(u.dtype)


def memory_cross_attention(h, mem_n, w_xq, w_xkv, w_xo):
    b, s, _ = h.shape
    m = mem_n.shape[1]
    q = (h @ w_xq).reshape(b, s, XATTN_HEADS, XATTN_HEAD_DIM)
    kv = (mem_n @ w_xkv).reshape(b, m, 2, XATTN_HEADS, XATTN_HEAD_DIM)
    k, v = kv[:, :, 0], kv[:, :, 1]
    scores = jnp.einsum('bshd,bmhd->bhsm', q, k, preferred_element_type=jnp.float32) * (XATTN_HEAD_DIM ** -0.5)
    p = jax.nn.softmax(scores, axis=-1).astype(v.dtype)
    out = jnp.einsum('bhsm,bmhd->bshd', p, v).reshape(b, s, D_MODEL)
    return out @ w_xo


def peer_ffn(h, w_pq, sub_keys, peer_u, peer_v):
    b, s, d = h.shape
    q = (h @ w_pq).reshape(b, s, PEER_HEADS, 2, PEER_KEY_DIM)
    scores = jnp.einsum('bshid,hikd->bshik', q, sub_keys, preferred_element_type=jnp.float32)
    half_val, half_idx = lax.top_k(scores, PEER_TOPK)
    cand = half_val[..., 0, :, None] + half_val[..., 1, None, :]
    cand = cand.reshape(b, s, PEER_HEADS, PEER_TOPK * PEER_TOPK)
    best_val, best_pos = lax.top_k(cand, PEER_TOPK)
    i1 = jnp.take_along_axis(half_idx[..., 0, :], best_pos // PEER_TOPK, axis=-1)
    i2 = jnp.take_along_axis(half_idx[..., 1, :], best_pos % PEER_TOPK, axis=-1)
    expert = i1 * PEER_KEYS + i2
    gate = jax.nn.softmax(best_val, axis=-1)
    nb = s // TOKEN_BLOCK

    def to_blocks(t):
        return t.reshape(b, nb, TOKEN_BLOCK, *t.shape[2:]).swapaxes(0, 1)

    def block(args):
        h_blk, e_blk, g_blk = args
        u_sel = peer_u[e_blk]
        act = jnp.einsum('btd,bthkd->bthk', h_blk, u_sel, preferred_element_type=jnp.float32)
        w = (g_blk * jax.nn.gelu(act)).astype(h.dtype)
        v_sel = peer_v[e_blk]
        return jnp.einsum('bthk,bthkd->btd', w, v_sel)

    out = lax.map(block, (to_blocks(h), to_blocks(expert), to_blocks(gate)))
    return out.swapaxes(0, 1).reshape(b, s, d)


def setup_inputs(seed: int = 0) -> dict:
    key = jax.random.key(seed)
    ks = jax.random.split(key, 32)
    f32 = jnp.float32
    L = DEPTH

    def nrm(k, shape, scale):
        return jax.random.normal(k, shape, f32) * scale

    def gain(k, shape):
        return 1.0 + 0.02 * jax.random.normal(k, shape, f32)

    n = jnp.arange(SSM_STATE, dtype=f32)
    a_re = -0.5 + 0.01 * jax.random.normal(ks[4], (L, SSM_GROUPS, SSM_STATE), f32)
    a_im = math.pi * n + 0.01 * jax.random.normal(ks[5], (L, SSM_GROUPS, SSM_STATE), f32)
    log_dt = jax.random.uniform(ks[6], (L, SSM_GROUPS), f32, math.log(DT_MIN), math.log(DT_MAX))
    return {
        "x": nrm(ks[0], (BATCH, SEQ, D_MODEL), 1.0),
        "mem": nrm(ks[1], (BATCH, MEM_LEN, D_MODEL), 1.0),
        "g_mix": gain(ks[2], (L, D_MODEL)),
        "w_in": nrm(ks[3], (L, D_MODEL, IN_WIDTH), D_MODEL ** -0.5),
        "a_re": a_re,
        "a_im": a_im,
        "log_dt": log_dt,
        "b_re": nrm(ks[7], (L, SSM_GROUPS, SSM_STATE, SSM_GROUP), (2 * SSM_GROUP) ** -0.5),
        "b_im": nrm(ks[8], (L, SSM_GROUPS, SSM_STATE, SSM_GROUP), (2 * SSM_GROUP) ** -0.5),
        "c_re": nrm(ks[9], (L, SSM_GROUPS, SSM_GROUP, SSM_STATE), (2 * SSM_STATE) ** -0.5),
        "c_im": nrm(ks[10], (L, SSM_GROUPS, SSM_GROUP, SSM_STATE), (2 * SSM_STATE) ** -0.5),
        "d_skip": nrm(ks[11], (L, SSM_GROUPS, SSM_GROUP), 1.0),
        "w_glu": nrm(ks[12], (L, SSM_WIDTH, SSM_WIDTH), SSM_WIDTH ** -0.5),
        "b_glu": nrm(ks[13], (L, SSM_WIDTH), 0.01),
        "g_attn_out": gain(ks[14], (L, ATTN_WIDTH)),
        "g_ssm_out": gain(ks[15], (L, SSM_WIDTH)),
        "w_out": nrm(ks[16], (L, MIX_WIDTH, D_MODEL), MIX_WIDTH ** -0.5),
        "g_xattn": gain(ks[17], (L, D_MODEL)),
        "g_mem": gain(ks[18], (L, D_MODEL)),
        "w_xq": nrm(ks[19], (L, D_MODEL, D_MODEL), D_MODEL ** -0.5),
        "w_xkv": nrm(ks[20], (L, D_MODEL, 2 * D_MODEL), D_MODEL ** -0.5),
        "w_xo": nrm(ks[21], (L, D_MODEL, D_MODEL), D_MODEL ** -0.5),
        "g_ffn": gain(ks[22], (L, D_MODEL)),
        "w_pq": nrm(ks[23], (L, D_MODEL, PEER_HEADS * PEER_QUERY_DIM), D_MODEL ** -0.5),
        "sub_keys": nrm(ks[24], (L, PEER_HEADS, 2, PEER_KEYS, PEER_KEY_DIM), PEER_KEY_DIM ** -0.5),
        "peer_u": nrm(ks[25], (L, PEER_EXPERTS, D_MODEL), D_MODEL ** -0.5),
        "peer_v": nrm(ks[26], (L, PEER_EXPERTS, D_MODEL), PEER_HEADS ** -0.5),
        "g_final": gain(ks[27], (D_MODEL,)),
    }


def reference(x, mem, g_mix, w_in, a_re, a_im, log_dt, b_re, b_im, c_re, c_im, d_skip,
              w_glu, b_glu, g_attn_out, g_ssm_out, w_out, g_xattn, g_mem, w_xq, w_xkv, w_xo,
              g_ffn, w_pq, sub_keys, peer_u, peer_v, g_final):
    b, s, _ = x.shape
    h = x
    for layer in range(DEPTH):
        xn = rmsnorm(h, g_mix[layer])
        proj = xn @ w_in[layer]
        q = proj[..., :ATTN_WIDTH]
        k = proj[..., ATTN_WIDTH:2 * ATTN_WIDTH]
        v = proj[..., 2 * ATTN_WIDTH:3 * ATTN_WIDTH]
        u = proj[..., 3 * ATTN_WIDTH:]

        def heads(t):
            return t.reshape(b, s, ATTN_HEADS, ATTN_HEAD_DIM).transpose(0, 2, 1, 3)

        attn = stick_breaking_attention(heads(q), heads(k), heads(v))
        attn = attn.transpose(0, 2, 1, 3).reshape(b, s, ATTN_WIDTH)
        ssm = s5_mixer(u, a_re[layer], a_im[layer], log_dt[layer], b_re[layer], b_im[layer],
                       c_re[layer], c_im[layer], d_skip[layer], w_glu[layer], b_glu[layer])
        mixed = jnp.concatenate([rmsnorm(attn, g_attn_out[layer]),
                                 rmsnorm(ssm, g_ssm_out[layer])], axis=-1)
        h = h + mixed @ w_out[layer]
        h = h + memory_cross_attention(rmsnorm(h, g_xattn[layer]), rmsnorm(mem, g_mem[layer]),
                                       w_xq[layer], w_xkv[layer], w_xo[layer])
        h = h + peer_ffn(rmsnorm(h, g_ffn[layer]), w_pq[layer], sub_keys[layer],
                         peer_u[layer], peer_v[layer])
    return rmsnorm(h, g_final)
```

```cpp
#include <hip/hip_runtime.h>
#include <stdint.h>

typedef unsigned short bf16_t;

#define NTOK 16384
#define SEQ 8192
#define DM 1024

__device__ __forceinline__ bf16_t f2bf(float f) {
  unsigned u = __float_as_uint(f);
  u += 0x7fffu + ((u >> 16) & 1u);
  return (bf16_t)(u >> 16);
}
__device__ __forceinline__ float bf2f(bf16_t h) { return __uint_as_float(((unsigned)h) << 16); }
__device__ __forceinline__ float bflo(unsigned u) { return __uint_as_float(u << 16); }
__device__ __forceinline__ float bfhi(unsigned u) { return __uint_as_float(u & 0xffff0000u); }

__device__ __forceinline__ float wave_sum(float v) {
#pragma unroll
  for (int o = 32; o >= 1; o >>= 1) v += __shfl_xor(v, o);
  return v;
}
__device__ __forceinline__ float wave_max(float v) {
#pragma unroll
  for (int o = 32; o >= 1; o >>= 1) v = fmaxf(v, __shfl_xor(v, o));
  return v;
}
__device__ __forceinline__ float gelu_tanh(float x) {
  float y = 0.7978845608028654f * (x + 0.044715f * x * x * x);
  return x / (1.0f + __expf(-2.0f * y));
}
__device__ __forceinline__ float sigmoidf_(float x) { return 1.0f / (1.0f + __expf(-x)); }
__device__ __forceinline__ float softplusf_(float z) { return fmaxf(z, 0.f) + log1pf(expf(-fabsf(z))); }

__device__ __forceinline__ float ldA(const float* p) { return *p; }
__device__ __forceinline__ float ldA(const bf16_t* p) { return bf2f(*p); }

__global__ void __launch_bounds__(256) k_rmsnorm_bf16(const float* __restrict__ x, const float* __restrict__ g,
                                                      bf16_t* __restrict__ out, int rows, int D) {
  int wave = (blockIdx.x * 256 + threadIdx.x) >> 6, lane = threadIdx.x & 63;
  if (wave >= rows) return;
  const float* xr = x + (size_t)wave * D;
  float ss = 0.f;
  for (int i = lane; i < D; i += 64) { float v = xr[i]; ss += v * v; }
  ss = wave_sum(ss);
  float r = rsqrtf(ss / (float)D + 1e-6f);
  for (int i = lane; i < D; i += 64) out[(size_t)wave * D + i] = f2bf(xr[i] * r * g[i]);
}
__global__ void __launch_bounds__(256) k_mixnorm(bf16_t* __restrict__ mix, const float* __restrict__ ga,
                                                 const float* __restrict__ gs) {
  int wave = (blockIdx.x * 256 + threadIdx.x) >> 6, lane = threadIdx.x & 63;
  int row = wave >> 1, half = wave & 1;
  if (row >= NTOK) return;
  bf16_t* p = mix + (size_t)row * 1024 + half * 512;
  const float* g = half ? gs : ga;
  float v[8]; float ss = 0.f;
#pragma unroll
  for (int i = 0; i < 8; ++i) { v[i] = bf2f(p[lane + 64 * i]); ss += v[i] * v[i]; }
  ss = wave_sum(ss);
  float r = rsqrtf(ss / 512.f + 1e-6f);
#pragma unroll
  for (int i = 0; i < 8; ++i) p[lane + 64 * i] = f2bf(v[i] * r * g[lane + 64 * i]);
}

struct EpiInProj { bf16_t* qkv; float* u;
  __device__ void operator()(int m, int n, float acc) const {
    if (n < 1536) qkv[(size_t)m * 1536 + n] = f2bf(acc); else u[(size_t)m * 512 + (n - 1536)] = acc; } };
struct EpiGlu { const bf16_t* y; const float* b; bf16_t* mix;
  __device__ void operator()(int m, int n, float acc) const {
    float yv = bf2f(y[(size_t)m * 512 + n]);
    mix[(size_t)m * 1024 + 512 + n] = f2bf(yv * sigmoidf_(acc + b[n])); } };
struct EpiResInit { const float* x; float* h;
  __device__ void operator()(int m, int n, float acc) const { h[(size_t)m * 1024 + n] = x[(size_t)m * 1024 + n] + acc; } };
struct EpiResAdd { float* h;
  __device__ void operator()(int m, int n, float acc) const { h[(size_t)m * 1024 + n] += acc; } };
struct EpiBf16 { bf16_t* o; int ld;
  __device__ void operator()(int m, int n, float acc) const { o[(size_t)m * ld + n] = f2bf(acc); } };

template <typename Epi>
__global__ void __launch_bounds__(256) k_gemm_naive(const bf16_t* __restrict__ A, int lda, const float* __restrict__ W,
                                                    int N, int K, int M, Epi epi) {
  int n = blockIdx.x * 256 + threadIdx.x;
  int m0 = blockIdx.y * 4;
  if (n >= N) return;
  float a0 = 0, a1 = 0, a2 = 0, a3 = 0;
  const bf16_t* Ar = A + (size_t)m0 * lda;
  for (int k = 0; k < K; ++k) {
    float w = W[(size_t)k * N + n];
    a0 += bf2f(Ar[k]) * w; a1 += bf2f(Ar[lda + k]) * w; a2 += bf2f(Ar[2 * lda + k]) * w; a3 += bf2f(Ar[3 * lda + k]) * w;
  }
  epi(m0, n, a0); epi(m0 + 1, n, a1); epi(m0 + 2, n, a2); epi(m0 + 3, n, a3);
}

__global__ void __launch_bounds__(256) k_attn_naive(const bf16_t* __restrict__ qkv, bf16_t* __restrict__ mix) {
  int idx = blockIdx.x * 256 + threadIdx.x;
  int t = idx & (SEQ - 1), h = (idx >> 13) & 7, b = idx >> 16;
  const bf16_t* base = qkv + (size_t)b * SEQ * 1536 + h * 64;
  float q[64], o[64];
  {
    const uint4* qp = (const uint4*)(base + (size_t)t * 1536);
#pragma unroll
    for (int i = 0; i < 8; ++i) {
      uint4 v = qp[i];
      q[8 * i + 0] = bflo(v.x); q[8 * i + 1] = bfhi(v.x); q[8 * i + 2] = bflo(v.y); q[8 * i + 3] = bfhi(v.y);
      q[8 * i + 4] = bflo(v.z); q[8 * i + 5] = bfhi(v.z); q[8 * i + 6] = bflo(v.w); q[8 * i + 7] = bfhi(v.w);
    }
  }
#pragma unroll
  for (int d = 0; d < 64; ++d) o[d] = 0.f;
  float C = 0.f;
  for (int s = t - 1; s >= 0; --s) {
    const uint4* kp = (const uint4*)(base + (size_t)s * 1536 + 512);
    float z = 0.f;
#pragma unroll
    for (int i = 0; i < 8; ++i) {
      uint4 v = kp[i];
      z += q[8 * i + 0] * bflo(v.x) + q[8 * i + 1] * bfhi(v.x) + q[8 * i + 2] * bflo(v.y) + q[8 * i + 3] * bfhi(v.y) +
           q[8 * i + 4] * bflo(v.z) + q[8 * i + 5] * bfhi(v.z) + q[8 * i + 6] * bflo(v.w) + q[8 * i + 7] * bfhi(v.w);
    }
    z *= 0.125f;
    float Cprev = C;
    C += softplusf_(z);
    float w = expf(z - C);
    const uint4* vp = (const uint4*)(base + (size_t)s * 1536 + 1024);
#pragma unroll
    for (int i = 0; i < 8; ++i) {
      uint4 v = vp[i];
      o[8 * i + 0] += w * bflo(v.x); o[8 * i + 1] += w * bfhi(v.x); o[8 * i + 2] += w * bflo(v.y); o[8 * i + 3] += w * bfhi(v.y);
      o[8 * i + 4] += w * bflo(v.z); o[8 * i + 5] += w * bfhi(v.z); o[8 * i + 6] += w * bflo(v.w); o[8 * i + 7] += w * bfhi(v.w);
    }
    if (C > 105.f) break;
    (void)Cprev;
  }
  bf16_t* op = mix + ((size_t)b * SEQ + t) * 1024 + h * 64;
#pragma unroll
  for (int d = 0; d < 64; d += 2) {
    unsigned pk = (unsigned)f2bf(o[d]) | ((unsigned)f2bf(o[d + 1]) << 16);
    *(unsigned*)(op + d) = pk;
  }
}

__global__ void __launch_bounds__(64) k_ssm_naive(const float* __restrict__ U, const float* __restrict__ a_re,
                                                  const float* __restrict__ a_im, const float* __restrict__ log_dt,
                                                  const float* __restrict__ b_re, const float* __restrict__ b_im,
                                                  const float* __restrict__ c_re, const float* __restrict__ c_im,
                                                  const float* __restrict__ d_skip, bf16_t* __restrict__ Y) {
  __shared__ float xs[128];
  int bg = blockIdx.x, b = bg >> 5, g = bg & 31, lane = threadIdx.x, p = lane;
  double are = a_re[g * 64 + p], aim = a_im[g * 64 + p], dt = exp((double)log_dt[g]);
  double er = exp(are * dt), sn, cs; sincos(aim * dt, &sn, &cs);
  double lbr_d = er * cs, lbi_d = er * sn;
  double nr = lbr_d - 1.0, ni = lbi_d, den = are * are + aim * aim;
  double cr = (nr * are + ni * aim) / den, ci = (ni * are - nr * aim) / den;
  float lbr = (float)lbr_d, lbi = (float)lbi_d;
  float bbr[16], bbi[16];
#pragma unroll
  for (int c = 0; c < 16; ++c) {
    double br = b_re[(g * 64 + p) * 16 + c], bi = b_im[(g * 64 + p) * 16 + c];
    bbr[c] = (float)(cr * br - ci * bi); bbi[c] = (float)(cr * bi + ci * br);
  }
  int c2 = lane & 15, q2 = lane >> 4;
  float cre[16], cim[16];
#pragma unroll
  for (int j = 0; j < 16; ++j) {
    cre[j] = c_re[(g * 16 + c2) * 64 + q2 * 16 + j]; cim[j] = c_im[(g * 16 + c2) * 64 + q2 * 16 + j];
  }
  float dsk = d_skip[g * 16 + c2];
  float xr = 0.f, xi = 0.f;
  const float* Ub = U + (size_t)b * SEQ * 512 + g * 16;
  bf16_t* Yb = Y + (size_t)b * SEQ * 512 + g * 16;
  for (int t = 0; t < SEQ; ++t) {
    const float4* up = (const float4*)(Ub + (size_t)t * 512);
    float u[16];
#pragma unroll
    for (int i = 0; i < 4; ++i) { float4 v = up[i]; u[4 * i] = v.x; u[4 * i + 1] = v.y; u[4 * i + 2] = v.z; u[4 * i + 3] = v.w; }
    float bur = 0.f, bui = 0.f;
#pragma unroll
    for (int c = 0; c < 16; ++c) { bur += bbr[c] * u[c]; bui += bbi[c] * u[c]; }
    float nxr = lbr * xr - lbi * xi + bur, nxi = lbr * xi + lbi * xr + bui;
    xr = nxr; xi = nxi;
    __syncthreads();
    xs[p] = xr; xs[64 + p] = xi;
    __syncthreads();
    float acc = 0.f;
#pragma unroll
    for (int j = 0; j < 16; ++j) acc += cre[j] * xs[q2 * 16 + j] - cim[j] * xs[64 + q2 * 16 + j];
    acc += __shfl_xor(acc, 16); acc += __shfl_xor(acc, 32);
    if (lane < 16) {
      float y = acc + dsk * Ub[(size_t)t * 512 + c2];
      Yb[(size_t)t * 512 + c2] = f2bf(gelu_tanh(y));
    }
  }
}

__global__ void __launch_bounds__(256) k_xattn_naive(const bf16_t* __restrict__ QX, const bf16_t* __restrict__ KV,
                                                     bf16_t* __restrict__ XO) {
  __shared__ float qs[4][256];
  __shared__ float ps[4][256];
  int tok = blockIdx.x, h = threadIdx.x >> 6, lane = threadIdx.x & 63, b = tok >> 13;
  for (int i = lane; i < 256; i += 64) qs[h][i] = bf2f(QX[(size_t)tok * 1024 + h * 256 + i]);
  __syncthreads();
  float sc[4];
#pragma unroll
  for (int j = 0; j < 4; ++j) {
    int m = lane + 64 * j;
    const uint4* kp = (const uint4*)(KV + ((size_t)b * 256 + m) * 2048 + h * 256);
    float s = 0.f;
    for (int i = 0; i < 32; ++i) {
      uint4 v = kp[i]; const float* qq = &qs[h][8 * i];
      s += qq[0] * bflo(v.x) + qq[1] * bfhi(v.x) + qq[2] * bflo(v.y) + qq[3] * bfhi(v.y) + qq[4] * bflo(v.z) +
           qq[5] * bfhi(v.z) + qq[6] * bflo(v.w) + qq[7] * bfhi(v.w);
    }
    sc[j] = s * 0.0625f;
  }
  float mx = wave_max(fmaxf(fmaxf(sc[0], sc[1]), fmaxf(sc[2], sc[3])));
  float sum = 0.f;
#pragma unroll
  for (int j = 0; j < 4; ++j) { sc[j] = expf(sc[j] - mx); sum += sc[j]; }
  sum = wave_sum(sum);
  float inv = 1.0f / sum;
#pragma unroll
  for (int j = 0; j < 4; ++j) ps[h][lane + 64 * j] = sc[j] * inv;
  __syncthreads();
  float o0 = 0, o1 = 0, o2 = 0, o3 = 0;
  const bf16_t* vb = KV + (size_t)b * 256 * 2048 + 1024 + h * 256 + lane * 4;
  for (int m = 0; m < 256; ++m) {
    uint2 v = *(const uint2*)(vb + (size_t)m * 2048);
    float pm = ps[h][m];
    o0 += pm * bflo(v.x); o1 += pm * bfhi(v.x); o2 += pm * bflo(v.y); o3 += pm * bfhi(v.y);
  }
  uint2 pk; pk.x = (unsigned)f2bf(o0) | ((unsigned)f2bf(o1) << 16); pk.y = (unsigned)f2bf(o2) | ((unsigned)f2bf(o3) << 16);
  *(uint2*)(XO + (size_t)tok * 1024 + h * 256 + lane * 4) = pk;
}

#define INS16(val, idx, V, I)                                   \
  {                                                             \
    float nv = (val); int ni = (idx);                           \
    _Pragma("unroll") for (int j = 0; j < 16; ++j) {            \
      bool gt = nv > V[j];                                      \
      float tv = gt ? V[j] : nv; int ti = gt ? I[j] : ni;       \
      V[j] = gt ? nv : V[j]; I[j] = gt ? ni : I[j];             \
      nv = tv; ni = ti;                                         \
    }                                                           \
  }

__global__ void __launch_bounds__(256) k_peer_route(const bf16_t* __restrict__ PQ, const float* __restrict__ subk,
                                                    int* __restrict__ EXP, float* __restrict__ GATE) {
  __shared__ float qs[2048];
  __shared__ float sc[2048];
  __shared__ float tv[16][16];
  __shared__ int ti[16][16];
  int tok = blockIdx.x, tid = threadIdx.x;
  for (int i = tid; i < 2048; i += 256) qs[i] = bf2f(PQ[(size_t)tok * 2048 + i]);
  __syncthreads();
  for (int j = 0; j < 8; ++j) {
    int si = tid + 256 * j;
    int hh = si >> 7;
    const float4* kp = (const float4*)(subk + (size_t)si * 128);
    const float* qq = qs + hh * 128;
    float s = 0.f;
    for (int d = 0; d < 32; ++d) { float4 v = kp[d]; s += qq[4 * d] * v.x + qq[4 * d + 1] * v.y + qq[4 * d + 2] * v.z + qq[4 * d + 3] * v.w; }
    sc[si] = s;
  }
  __syncthreads();
  if (tid < 16) {
    float V[16]; int I[16];
#pragma unroll
    for (int j = 0; j < 16; ++j) { V[j] = -3.0e38f; I[j] = 0; }
    for (int k = 0; k < 128; ++k) INS16(sc[tid * 128 + k], k, V, I)
#pragma unroll
    for (int j = 0; j < 16; ++j) { tv[tid][j] = V[j]; ti[tid][j] = I[j]; }
  }
  __syncthreads();
  if (tid < 8) {
    float V[16]; int I[16];
#pragma unroll
    for (int j = 0; j < 16; ++j) { V[j] = -3.0e38f; I[j] = 0; }
    for (int a = 0; a < 16; ++a)
      for (int bb = 0; bb < 16; ++bb) INS16(tv[2 * tid][a] + tv[2 * tid + 1][bb], a * 16 + bb, V, I)
    float mx = V[0], sum = 0.f;
    float e[16];
#pragma unroll
    for (int j = 0; j < 16; ++j) { e[j] = expf(V[j] - mx); sum += e[j]; }
    float inv = 1.f / sum;
#pragma unroll
    for (int j = 0; j < 16; ++j) {
      int pos = I[j];
      int i1 = ti[2 * tid][pos >> 4], i2 = ti[2 * tid + 1][pos & 15];
      EXP[(size_t)tok * 128 + tid * 16 + j] = i1 * 128 + i2;
      GATE[(size_t)tok * 128 + tid * 16 + j] = e[j] * inv;
    }
  }
}

__global__ void __launch_bounds__(256) k_peer_gather(const bf16_t* __restrict__ HN, const int* __restrict__ EXP,
                                                     const float* __restrict__ GATE, const float* __restrict__ PU,
                                                     const float* __restrict__ PV, const float* __restrict__ gfin,
                                                     float* __restrict__ H) {
  __shared__ float part[4][1024];
  __shared__ float red[4];
  int tok = blockIdx.x, w = threadIdx.x >> 6, lane = threadIdx.x & 63;
  float hn[16], acc[16];
#pragma unroll
  for (int i = 0; i < 16; ++i) { hn[i] = bf2f(HN[(size_t)tok * 1024 + lane + 64 * i]); acc[i] = 0.f; }
  for (int j = 0; j < 32; ++j) {
    int e = EXP[(size_t)tok * 128 + w * 32 + j];
    float gt = GATE[(size_t)tok * 128 + w * 32 + j];
    const float* ur = PU + (size_t)e * 1024;
    float d = 0.f;
#pragma unroll
    for (int i = 0; i < 16; ++i) d += hn[i] * ur[lane + 64 * i];
    d = wave_sum(d);
    float wgt = gt * gelu_tanh(d);
    const float* vr = PV + (size_t)e * 1024;
#pragma unroll
    for (int i = 0; i < 16; ++i) acc[i] += wgt * vr[lane + 64 * i];
  }
#pragma unroll
  for (int i = 0; i < 16; ++i) part[w][lane + 64 * i] = acc[i];
  __syncthreads();
  float v[4]; float ss = 0.f;
#pragma unroll
  for (int i = 0; i < 4; ++i) {
    int c = threadIdx.x + 256 * i;
    v[i] = H[(size_t)tok * 1024 + c] + part[0][c] + part[1][c] + part[2][c] + part[3][c];
    ss += v[i] * v[i];
  }
  ss = wave_sum(ss);
  if (lane == 0) red[w] = ss;
  __syncthreads();
  float tot = red[0] + red[1] + red[2] + red[3];
  float r = rsqrtf(tot / 1024.f + 1e-6f);
#pragma unroll
  for (int i = 0; i < 4; ++i) { int c = threadIdx.x + 256 * i; H[(size_t)tok * 1024 + c] = v[i] * r * gfin[c]; }
}

extern "C" void kernel_launch(void* const* d_in, const int* in_sizes, int n_in, void* d_out, int out_size, void* d_ws,
                              size_t ws_size, hipStream_t stream) {
  const float* x = (const float*)d_in[0];
  const float* mem = (const float*)d_in[1];
  const float* g_mix = (const float*)d_in[2];
  const float* w_in = (const float*)d_in[3];
  const float* a_re = (const float*)d_in[4];
  const float* a_im = (const float*)d_in[5];
  const float* log_dt = (const float*)d_in[6];
  const float* b_re = (const float*)d_in[7];
  const float* b_im = (const float*)d_in[8];
  const float* c_re = (const float*)d_in[9];
  const float* c_im = (const float*)d_in[10];
  const float* d_skip = (const float*)d_in[11];
  const float* w_glu = (const float*)d_in[12];
  const float* b_glu = (const float*)d_in[13];
  const float* g_attn_out = (const float*)d_in[14];
  const float* g_ssm_out = (const float*)d_in[15];
  const float* w_out = (const float*)d_in[16];
  const float* g_xattn = (const float*)d_in[17];
  const float* g_mem = (const float*)d_in[18];
  const float* w_xq = (const float*)d_in[19];
  const float* w_xkv = (const float*)d_in[20];
  const float* w_xo = (const float*)d_in[21];
  const float* g_ffn = (const float*)d_in[22];
  const float* w_pq = (const float*)d_in[23];
  const float* sub_keys = (const float*)d_in[24];
  const float* peer_u = (const float*)d_in[25];
  const float* peer_v = (const float*)d_in[26];
  const float* g_final = (const float*)d_in[27];
  float* H = (float*)d_out;

  char* ws = (char*)d_ws;
  const size_t MB = 1024 * 1024;
  bf16_t* XN = (bf16_t*)(ws + 0);
  bf16_t* QKV = (bf16_t*)(ws + 32 * MB);
  float* U = (float*)(ws + 80 * MB);
  bf16_t* MIX = (bf16_t*)(ws + 112 * MB);
  bf16_t* Y = (bf16_t*)(ws + 144 * MB);
  bf16_t* MEMN = (bf16_t*)(ws + 160 * MB);
  bf16_t* KVM = (bf16_t*)(ws + 161 * MB);
  bf16_t* QX = QKV;
  bf16_t* XO = (bf16_t*)U;
  bf16_t* PQ = QKV;
  bf16_t* HN2 = MIX;
  int* EXP = (int*)Y;
  float* GATE = (float*)(ws + 152 * MB);

  k_rmsnorm_bf16<<<NTOK / 4, 256, 0, stream>>>(x, g_mix, XN, NTOK, DM);
  k_gemm_naive<<<dim3(2048 / 256, NTOK / 4), 256, 0, stream>>>(XN, 1024, w_in, 2048, 1024, NTOK, EpiInProj{QKV, U});
  k_attn_naive<<<2 * 8 * SEQ / 256, 256, 0, stream>>>(QKV, MIX);
  k_ssm_naive<<<64, 64, 0, stream>>>(U, a_re, a_im, log_dt, b_re, b_im, c_re, c_im, d_skip, Y);
  k_gemm_naive<<<dim3(512 / 256, NTOK / 4), 256, 0, stream>>>(Y, 512, w_glu, 512, 512, NTOK, EpiGlu{Y, b_glu, MIX});
  k_mixnorm<<<NTOK * 2 / 4, 256, 0, stream>>>(MIX, g_attn_out, g_ssm_out);
  k_gemm_naive<<<dim3(1024 / 256, NTOK / 4), 256, 0, stream>>>(MIX, 1024, w_out, 1024, 1024, NTOK, EpiResInit{x, H});
  k_rmsnorm_bf16<<<NTOK / 4, 256, 0, stream>>>(H, g_xattn, XN, NTOK, DM);
  k_rmsnorm_bf16<<<512 / 4, 256, 0, stream>>>(mem, g_mem, MEMN, 512, DM);
  k_gemm_naive<<<dim3(1024 / 256, NTOK / 4), 256, 0, stream>>>(XN, 1024, w_xq, 1024, 1024, NTOK, EpiBf16{QX, 1024});
  k_gemm_naive<<<dim3(2048 / 256, 512 / 4), 256, 0, stream>>>(MEMN, 1024, w_xkv, 2048, 1024, 512, EpiBf16{KVM, 2048});
  k_xattn_naive<<<NTOK, 256, 0, stream>>>(QX, KVM, XO);
  k_gemm_naive<<<dim3(1024 / 256, NTOK / 4), 256, 0, stream>>>(XO, 1024, w_xo, 1024, 1024, NTOK, EpiResAdd{H});
  k_rmsnorm_bf16<<<NTOK / 4, 256, 0, stream>>>(H, g_ffn, HN2, NTOK, DM);
  k_gemm_naive<<<dim3(2048 / 256, NTOK / 4), 256, 0, stream>>>(HN2, 1024, w_pq, 2048, 1024, NTOK, EpiBf16{PQ, 2048});
  k_peer_route<<<NTOK, 256, 0, stream>>>(PQ, sub_keys, EXP, GATE);
  k_peer_gather<<<NTOK, 256, 0, stream>>>(HN2, EXP, GATE, peer_u, peer_v, g_final, H);
}
```

```cpp
#include <hip/hip_runtime.h>
#include <stdint.h>
#include <hip/hip_cooperative_groups.h>
namespace cg = cooperative_groups;

typedef unsigned short bf16_t;

#define NTOK 16384
#define SEQ 8192
#define DM 1024

__device__ __forceinline__ bf16_t f2bf(float f) {
  unsigned u = __float_as_uint(f);
  u += 0x7fffu + ((u >> 16) & 1u);
  return (bf16_t)(u >> 16);
}
__device__ __forceinline__ float bf2f(bf16_t h) { return __uint_as_float(((unsigned)h) << 16); }
__device__ __forceinline__ float bflo(unsigned u) { return __uint_as_float(u << 16); }
__device__ __forceinline__ float bfhi(unsigned u) { return __uint_as_float(u & 0xffff0000u); }

__device__ __forceinline__ float wave_sum(float v) {
#pragma unroll
  for (int o = 32; o >= 1; o >>= 1) v += __shfl_xor(v, o);
  return v;
}
__device__ __forceinline__ float wave_max(float v) {
#pragma unroll
  for (int o = 32; o >= 1; o >>= 1) v = fmaxf(v, __shfl_xor(v, o));
  return v;
}
__device__ __forceinline__ float gelu_tanh(float x) {
  float y = 0.7978845608028654f * (x + 0.044715f * x * x * x);
  return x / (1.0f + __expf(-2.0f * y));
}
__device__ __forceinline__ float sigmoidf_(float x) { return 1.0f / (1.0f + __expf(-x)); }
__device__ __forceinline__ float softplusf_(float z) { return fmaxf(z, 0.f) + log1pf(expf(-fabsf(z))); }

__device__ __forceinline__ float ldA(const float* p) { return *p; }
__device__ __forceinline__ float ldA(const bf16_t* p) { return bf2f(*p); }


#define NTHR 512
#define NWAVE 8
__device__ __forceinline__ void wave_lds_sync() { __builtin_amdgcn_fence(__ATOMIC_ACQ_REL, "workgroup"); __builtin_amdgcn_wave_barrier(); }

struct Params {
  const float *x, *mem, *g_mix, *w_in, *a_re, *a_im, *log_dt, *b_re, *b_im, *c_re, *c_im, *d_skip, *w_glu, *b_glu,
      *g_attn_out, *g_ssm_out, *w_out, *g_xattn, *g_mem, *w_xq, *w_xkv, *w_xo, *g_ffn, *w_pq, *sub_keys, *peer_u, *peer_v, *g_final;
  float* H; char* ws;
};

__device__ void ph_rmsnorm(const float* __restrict__ x, const float* __restrict__ g, bf16_t* __restrict__ out, int rows) {
  int lane = threadIdx.x & 63;
  for (int row = blockIdx.x * NWAVE + (threadIdx.x >> 6); row < rows; row += gridDim.x * NWAVE) {
    const float* xr = x + (size_t)row * 1024;
    float v[16]; float ss = 0.f;
#pragma unroll
    for (int i = 0; i < 16; ++i) { v[i] = xr[lane + 64 * i]; ss += v[i] * v[i]; }
    ss = wave_sum(ss);
    float r = rsqrtf(ss / 1024.f + 1e-6f);
#pragma unroll
    for (int i = 0; i < 16; ++i) out[(size_t)row * 1024 + lane + 64 * i] = f2bf(v[i] * r * g[lane + 64 * i]);
  }
}
__device__ void ph_mixnorm(bf16_t* __restrict__ mix, const float* __restrict__ ga, const float* __restrict__ gs) {
  int lane = threadIdx.x & 63;
  for (int w = blockIdx.x * NWAVE + (threadIdx.x >> 6); w < NTOK * 2; w += gridDim.x * NWAVE) {
    int row = w >> 1, half = w & 1;
    bf16_t* p = mix + (size_t)row * 1024 + half * 512;
    const float* g = half ? gs : ga;
    float v[8]; float ss = 0.f;
#pragma unroll
    for (int i = 0; i < 8; ++i) { v[i] = bf2f(p[lane + 64 * i]); ss += v[i] * v[i]; }
    ss = wave_sum(ss);
    float r = rsqrtf(ss / 512.f + 1e-6f);
#pragma unroll
    for (int i = 0; i < 8; ++i) p[lane + 64 * i] = f2bf(v[i] * r * g[lane + 64 * i]);
  }
}

struct EpiInProj { bf16_t* qkv; float* u;
  __device__ void operator()(int m, int n, float acc) const {
    if (n < 1536) qkv[(size_t)m * 1536 + n] = f2bf(acc); else u[(size_t)m * 512 + (n - 1536)] = acc; } };
struct EpiGlu { const bf16_t* y; const float* b; bf16_t* mix;
  __device__ void operator()(int m, int n, float acc) const {
    float yv = bf2f(y[(size_t)m * 512 + n]);
    mix[(size_t)m * 1024 + 512 + n] = f2bf(yv * sigmoidf_(acc + b[n])); } };
struct EpiResInit { const float* x; float* h;
  __device__ void operator()(int m, int n, float acc) const { h[(size_t)m * 1024 + n] = x[(size_t)m * 1024 + n] + acc; } };
struct EpiResAdd { float* h;
  __device__ void operator()(int m, int n, float acc) const { h[(size_t)m * 1024 + n] += acc; } };
struct EpiBf16 { bf16_t* o; int ld;
  __device__ void operator()(int m, int n, float acc) const { o[(size_t)m * ld + n] = f2bf(acc); } };

template <typename Epi>
__device__ void ph_gemm_naive(const bf16_t* __restrict__ A, int lda, const float* __restrict__ W, int N, int K, int M, Epi epi) {
  long total = (long)(M / 4) * N;
  for (long idx = (long)blockIdx.x * NTHR + threadIdx.x; idx < total; idx += (long)gridDim.x * NTHR) {
    int n = (int)(idx % N); int m0 = (int)(idx / N) * 4;
    float a0 = 0, a1 = 0, a2 = 0, a3 = 0;
    const bf16_t* Ar = A + (size_t)m0 * lda;
    for (int k = 0; k < K; ++k) {
      float w = W[(size_t)k * N + n];
      a0 += bf2f(Ar[k]) * w; a1 += bf2f(Ar[lda + k]) * w; a2 += bf2f(Ar[2 * lda + k]) * w; a3 += bf2f(Ar[3 * lda + k]) * w;
    }
    epi(m0, n, a0); epi(m0 + 1, n, a1); epi(m0 + 2, n, a2); epi(m0 + 3, n, a3);
  }
}

__device__ void ph_attn_naive(const bf16_t* __restrict__ qkv, bf16_t* __restrict__ mix) {
  for (int idx = blockIdx.x * NTHR + threadIdx.x; idx < 2 * 8 * SEQ; idx += gridDim.x * NTHR) {
    int t = idx & (SEQ - 1), h = (idx >> 13) & 7, b = idx >> 16;
    const bf16_t* base = qkv + (size_t)b * SEQ * 1536 + h * 64;
    float q[64], o[64];
    {
      const uint4* qp = (const uint4*)(base + (size_t)t * 1536);
#pragma unroll
      for (int i = 0; i < 8; ++i) {
        uint4 v = qp[i];
        q[8 * i + 0] = bflo(v.x); q[8 * i + 1] = bfhi(v.x); q[8 * i + 2] = bflo(v.y); q[8 * i + 3] = bfhi(v.y);
        q[8 * i + 4] = bflo(v.z); q[8 * i + 5] = bfhi(v.z); q[8 * i + 6] = bflo(v.w); q[8 * i + 7] = bfhi(v.w);
      }
    }
#pragma unroll
    for (int d = 0; d < 64; ++d) o[d] = 0.f;
    float C = 0.f;
    for (int s = t - 1; s >= 0; --s) {
      const uint4* kp = (const uint4*)(base + (size_t)s * 1536 + 512);
      float z = 0.f;
#pragma unroll
      for (int i = 0; i < 8; ++i) {
        uint4 v = kp[i];
        z += q[8 * i + 0] * bflo(v.x) + q[8 * i + 1] * bfhi(v.x) + q[8 * i + 2] * bflo(v.y) + q[8 * i + 3] * bfhi(v.y) +
             q[8 * i + 4] * bflo(v.z) + q[8 * i + 5] * bfhi(v.z) + q[8 * i + 6] * bflo(v.w) + q[8 * i + 7] * bfhi(v.w);
      }
      z *= 0.125f;
      C += softplusf_(z);
      float w = expf(z - C);
      const uint4* vp = (const uint4*)(base + (size_t)s * 1536 + 1024);
#pragma unroll
      for (int i = 0; i < 8; ++i) {
        uint4 v = vp[i];
        o[8 * i + 0] += w * bflo(v.x); o[8 * i + 1] += w * bfhi(v.x); o[8 * i + 2] += w * bflo(v.y); o[8 * i + 3] += w * bfhi(v.y);
        o[8 * i + 4] += w * bflo(v.z); o[8 * i + 5] += w * bfhi(v.z); o[8 * i + 6] += w * bflo(v.w); o[8 * i + 7] += w * bfhi(v.w);
      }
      if (C > 105.f) break;
    }
    bf16_t* op = mix + ((size_t)b * SEQ + t) * 1024 + h * 64;
#pragma unroll
    for (int d = 0; d < 64; d += 2) {
      unsigned pk = (unsigned)f2bf(o[d]) | ((unsigned)f2bf(o[d + 1]) << 16);
      *(unsigned*)(op + d) = pk;
    }
  }
}

__device__ void ph_ssm_naive(const Params& P, const float* __restrict__ U, bf16_t* __restrict__ Y, float* smem) {
  int wv = threadIdx.x >> 6, lane = threadIdx.x & 63, p = lane;
  float* xs = smem + wv * 128;
  for (int bg = blockIdx.x * NWAVE + wv; bg < 64; bg += gridDim.x * NWAVE) {
    int b = bg >> 5, g = bg & 31;
    double are = P.a_re[g * 64 + p], aim = P.a_im[g * 64 + p], dt = exp((double)P.log_dt[g]);
    double er = exp(are * dt), sn, cs; sincos(aim * dt, &sn, &cs);
    double lbr_d = er * cs, lbi_d = er * sn;
    double nr = lbr_d - 1.0, ni = lbi_d, den = are * are + aim * aim;
    double cr = (nr * are + ni * aim) / den, ci = (ni * are - nr * aim) / den;
    float lbr = (float)lbr_d, lbi = (float)lbi_d;
    float bbr[16], bbi[16];
#pragma unroll
    for (int c = 0; c < 16; ++c) {
      double br = P.b_re[(g * 64 + p) * 16 + c], bi = P.b_im[(g * 64 + p) * 16 + c];
      bbr[c] = (float)(cr * br - ci * bi); bbi[c] = (float)(cr * bi + ci * br);
    }
    int c2 = lane & 15, q2 = lane >> 4;
    float cre[16], cim[16];
#pragma unroll
    for (int j = 0; j < 16; ++j) {
      cre[j] = P.c_re[(g * 16 + c2) * 64 + q2 * 16 + j]; cim[j] = P.c_im[(g * 16 + c2) * 64 + q2 * 16 + j];
    }
    float dsk = P.d_skip[g * 16 + c2];
    float xr = 0.f, xi = 0.f;
    const float* Ub = U + (size_t)b * SEQ * 512 + g * 16;
    bf16_t* Yb = Y + (size_t)b * SEQ * 512 + g * 16;
    for (int t = 0; t < SEQ; ++t) {
      const float4* up = (const float4*)(Ub + (size_t)t * 512);
      float u[16];
#pragma unroll
      for (int i = 0; i < 4; ++i) { float4 v = up[i]; u[4 * i] = v.x; u[4 * i + 1] = v.y; u[4 * i + 2] = v.z; u[4 * i + 3] = v.w; }
      float bur = 0.f, bui = 0.f;
#pragma unroll
      for (int c = 0; c < 16; ++c) { bur += bbr[c] * u[c]; bui += bbi[c] * u[c]; }
      float nxr = lbr * xr - lbi * xi + bur, nxi = lbr * xi + lbi * xr + bui;
      xr = nxr; xi = nxi;
      wave_lds_sync();
      xs[p] = xr; xs[64 + p] = xi;
      wave_lds_sync();
      float acc = 0.f;
#pragma unroll
      for (int j = 0; j < 16; ++j) acc += cre[j] * xs[q2 * 16 + j] - cim[j] * xs[64 + q2 * 16 + j];
      acc += __shfl_xor(acc, 16); acc += __shfl_xor(acc, 32);
      if (lane < 16) {
        float y = acc + dsk * Ub[(size_t)t * 512 + c2];
        Yb[(size_t)t * 512 + c2] = f2bf(gelu_tanh(y));
      }
    }
  }
}

__device__ void ph_xattn_naive(const bf16_t* __restrict__ QX, const bf16_t* __restrict__ KV, bf16_t* __restrict__ XO, float* smem) {
  int wv = threadIdx.x >> 6, lane = threadIdx.x & 63;
  float* qs = smem + wv * 512; float* ps = qs + 256;
  for (int item = blockIdx.x * NWAVE + wv; item < NTOK * 4; item += gridDim.x * NWAVE) {
    int tok = item >> 2, h = item & 3, b = tok >> 13;
    wave_lds_sync();
    for (int i = lane; i < 256; i += 64) qs[i] = bf2f(QX[(size_t)tok * 1024 + h * 256 + i]);
    wave_lds_sync();
    float sc[4];
#pragma unroll
    for (int j = 0; j < 4; ++j) {
      int m = lane + 64 * j;
      const uint4* kp = (const uint4*)(KV + ((size_t)b * 256 + m) * 2048 + h * 256);
      float s = 0.f;
      for (int i = 0; i < 32; ++i) {
        uint4 v = kp[i]; const float* qq = &qs[8 * i];
        s += qq[0] * bflo(v.x) + qq[1] * bfhi(v.x) + qq[2] * bflo(v.y) + qq[3] * bfhi(v.y) + qq[4] * bflo(v.z) +
             qq[5] * bfhi(v.z) + qq[6] * bflo(v.w) + qq[7] * bfhi(v.w);
      }
      sc[j] = s * 0.0625f;
    }
    float mx = wave_max(fmaxf(fmaxf(sc[0], sc[1]), fmaxf(sc[2], sc[3])));
    float sum = 0.f;
#pragma unroll
    for (int j = 0; j < 4; ++j) { sc[j] = expf(sc[j] - mx); sum += sc[j]; }
    sum = wave_sum(sum);
    float inv = 1.0f / sum;
#pragma unroll
    for (int j = 0; j < 4; ++j) ps[lane + 64 * j] = sc[j] * inv;
    wave_lds_sync();
    float o0 = 0, o1 = 0, o2 = 0, o3 = 0;
    const bf16_t* vb = KV + (size_t)b * 256 * 2048 + 1024 + h * 256 + lane * 4;
    for (int m = 0; m < 256; ++m) {
      uint2 v = *(const uint2*)(vb + (size_t)m * 2048);
      float pm = ps[m];
      o0 += pm * bflo(v.x); o1 += pm * bfhi(v.x); o2 += pm * bflo(v.y); o3 += pm * bfhi(v.y);
    }
    uint2 pk; pk.x = (unsigned)f2bf(o0) | ((unsigned)f2bf(o1) << 16); pk.y = (unsigned)f2bf(o2) | ((unsigned)f2bf(o3) << 16);
    *(uint2*)(XO + (size_t)tok * 1024 + h * 256 + lane * 4) = pk;
  }
}

#define INS16(val, idx, V, I)                                   \
  {                                                             \
    float nv = (val); int ni = (idx);                           \
    _Pragma("unroll") for (int j = 0; j < 16; ++j) {            \
      bool gt = nv > V[j];                                      \
      float tv = gt ? V[j] : nv; int ti = gt ? I[j] : ni;       \
      V[j] = gt ? nv : V[j]; I[j] = gt ? ni : I[j];             \
      nv = tv; ni = ti;                                         \
    }                                                           \
  }

__device__ void ph_route_naive(const bf16_t* __restrict__ PQ, const float* __restrict__ subk, int* __restrict__ EXP,
                               float* __restrict__ GATE, float* smem) {
  float* qs = smem; float* sc = smem + 2048; float* tv = smem + 4096; int* ti = (int*)(smem + 4096 + 256);
  int tid = threadIdx.x;
  for (int tok = blockIdx.x; tok < NTOK; tok += gridDim.x) {
    __syncthreads();
    for (int i = tid; i < 2048; i += NTHR) qs[i] = bf2f(PQ[(size_t)tok * 2048 + i]);
    __syncthreads();
    for (int j = 0; j < 4; ++j) {
      int si = tid + NTHR * j;
      int hh = si >> 7;
      const float4* kp = (const float4*)(subk + (size_t)si * 128);
      const float* qq = qs + hh * 128;
      float s = 0.f;
      for (int d = 0; d < 32; ++d) { float4 v = kp[d]; s += qq[4 * d] * v.x + qq[4 * d + 1] * v.y + qq[4 * d + 2] * v.z + qq[4 * d + 3] * v.w; }
      sc[si] = s;
    }
    __syncthreads();
    if (tid < 16) {
      float V[16]; int I[16];
#pragma unroll
      for (int j = 0; j < 16; ++j) { V[j] = -3.0e38f; I[j] = 0; }
      for (int k = 0; k < 128; ++k) INS16(sc[tid * 128 + k], k, V, I)
#pragma unroll
      for (int j = 0; j < 16; ++j) { tv[tid * 16 + j] = V[j]; ti[tid * 16 + j] = I[j]; }
    }
    __syncthreads();
    if (tid < 8) {
      float V[16]; int I[16];
#pragma unroll
      for (int j = 0; j < 16; ++j) { V[j] = -3.0e38f; I[j] = 0; }
      for (int a = 0; a < 16; ++a)
        for (int bb = 0; bb < 16; ++bb) INS16(tv[(2 * tid) * 16 + a] + tv[(2 * tid + 1) * 16 + bb], a * 16 + bb, V, I)
      float mx = V[0], sum = 0.f;
      float e[16];
#pragma unroll
      for (int j = 0; j < 16; ++j) { e[j] = expf(V[j] - mx); sum += e[j]; }
      float inv = 1.f / sum;
#pragma unroll
      for (int j = 0; j < 16; ++j) {
        int pos = I[j];
        int i1 = ti[(2 * tid) * 16 + (pos >> 4)], i2 = ti[(2 * tid + 1) * 16 + (pos & 15)];
        EXP[(size_t)tok * 128 + tid * 16 + j] = i1 * 128 + i2;
        GATE[(size_t)tok * 128 + tid * 16 + j] = e[j] * inv;
      }
    }
  }
}

__device__ void ph_gather_naive(const bf16_t* __restrict__ HN, const int* __restrict__ EXP, const float* __restrict__ GATE,
                                const float* __restrict__ PU, const float* __restrict__ PV, const float* __restrict__ gfin,
                                float* __restrict__ H, float* smem) {
  float* part = smem;
  float* red = smem + 8192;
  int w = threadIdx.x >> 6, lane = threadIdx.x & 63;
  for (int tok = blockIdx.x; tok < NTOK; tok += gridDim.x) {
    float hn[16], acc[16];
#pragma unroll
    for (int i = 0; i < 16; ++i) { hn[i] = bf2f(HN[(size_t)tok * 1024 + lane + 64 * i]); acc[i] = 0.f; }
    for (int j = 0; j < 16; ++j) {
      int e = EXP[(size_t)tok * 128 + w * 16 + j];
      float gt = GATE[(size_t)tok * 128 + w * 16 + j];
      const float* ur = PU + (size_t)e * 1024;
      float d = 0.f;
#pragma unroll
      for (int i = 0; i < 16; ++i) d += hn[i] * ur[lane + 64 * i];
      d = wave_sum(d);
      float wgt = gt * gelu_tanh(d);
      const float* vr = PV + (size_t)e * 1024;
#pragma unroll
      for (int i = 0; i < 16; ++i) acc[i] += wgt * vr[lane + 64 * i];
    }
    __syncthreads();
#pragma unroll
    for (int i = 0; i < 16; ++i) part[w * 1024 + lane + 64 * i] = acc[i];
    __syncthreads();
    float v[2]; float ss = 0.f;
#pragma unroll
    for (int i = 0; i < 2; ++i) {
      int c = threadIdx.x + NTHR * i;
      float s = H[(size_t)tok * 1024 + c];
#pragma unroll
      for (int k = 0; k < 8; ++k) s += part[k * 1024 + c];
      v[i] = s; ss += s * s;
    }
    ss = wave_sum(ss);
    if (lane == 0) red[w] = ss;
    __syncthreads();
    float tot = 0.f;
#pragma unroll
    for (int k = 0; k < 8; ++k) tot += red[k];
    float r = rsqrtf(tot / 1024.f + 1e-6f);
#pragma unroll
    for (int i = 0; i < 2; ++i) { int c = threadIdx.x + NTHR * i; H[(size_t)tok * 1024 + c] = v[i] * r * gfin[c]; }
  }
}

__global__ void __launch_bounds__(NTHR) fwd_megakernel(Params P) {
  cg::grid_group grid = cg::this_grid();
  __shared__ __attribute__((aligned(16))) float smem[8704];
  const size_t MB = 1024 * 1024;
  char* ws = P.ws;
  bf16_t* XN = (bf16_t*)(ws + 0);
  bf16_t* QKV = (bf16_t*)(ws + 32 * MB);
  float* U = (float*)(ws + 80 * MB);
  bf16_t* MIX = (bf16_t*)(ws + 112 * MB);
  bf16_t* Y = (bf16_t*)(ws + 144 * MB);
  bf16_t* MEMN = (bf16_t*)(ws + 160 * MB);
  bf16_t* KVM = (bf16_t*)(ws + 161 * MB);
  bf16_t* QX = QKV; bf16_t* XO = (bf16_t*)U; bf16_t* PQ = QKV; bf16_t* HN2 = MIX;
  int* EXP = (int*)Y; float* GATE = (float*)(ws + 152 * MB);
  float* H = P.H;

  ph_rmsnorm(P.x, P.g_mix, XN, NTOK);
  ph_rmsnorm(P.mem, P.g_mem, MEMN, 512);
  grid.sync();
  ph_gemm_naive(XN, 1024, P.w_in, 2048, 1024, NTOK, EpiInProj{QKV, U});
  ph_gemm_naive(MEMN, 1024, P.w_xkv, 2048, 1024, 512, EpiBf16{KVM, 2048});
  grid.sync();
  ph_attn_naive(QKV, MIX);
  ph_ssm_naive(P, U, Y, smem);
  grid.sync();
  ph_gemm_naive(Y, 512, P.w_glu, 512, 512, NTOK, EpiGlu{Y, P.b_glu, MIX});
  grid.sync();
  ph_mixnorm(MIX, P.g_attn_out, P.g_ssm_out);
  grid.sync();
  ph_gemm_naive(MIX, 1024, P.w_out, 1024, 1024, NTOK, EpiResInit{P.x, H});
  grid.sync();
  ph_rmsnorm(H, P.g_xattn, XN, NTOK);
  grid.sync();
  ph_gemm_naive(XN, 1024, P.w_xq, 1024, 1024, NTOK, EpiBf16{QX, 1024});
  grid.sync();
  ph_xattn_naive(QX, KVM, XO, smem);
  grid.sync();
  ph_gemm_naive(XO, 1024, P.w_xo, 1024, 1024, NTOK, EpiResAdd{H});
  grid.sync();
  ph_rmsnorm(H, P.g_ffn, HN2, NTOK);
  grid.sync();
  ph_gemm_naive(HN2, 1024, P.w_pq, 2048, 1024, NTOK, EpiBf16{PQ, 2048});
  grid.sync();
  ph_route_naive(PQ, P.sub_keys, EXP, GATE, smem);
  grid.sync();
  ph_gather_naive(HN2, EXP, GATE, P.peer_u, P.peer_v, P.g_final, H, smem);
}

extern "C" void kernel_launch(void* const* d_in, const int* in_sizes, int n_in, void* d_out, int out_size, void* d_ws,
                              size_t ws_size, hipStream_t stream) {
  Params P{};
  const float** pp = (const float**)&P;
  for (int i = 0; i < 28; ++i) pp[i] = (const float*)d_in[i];
  P.H = (float*)d_out; P.ws = (char*)d_ws;
  static int grid_blocks = 0;
  if (!grid_blocks) {
    int dev = 0, cus = 0, per_cu = 0;
    hipGetDevice(&dev);
    hipDeviceGetAttribute(&cus, hipDeviceAttributeMultiprocessorCount, dev);
    hipOccupancyMaxActiveBlocksPerMultiprocessor(&per_cu, fwd_megakernel, NTHR, 0);
    grid_blocks = per_cu >= 1 ? cus : 0;
  }
  void* args[] = {&P};
  hipLaunchCooperativeKernel((void*)fwd_megakernel, dim3(grid_blocks), dim3(NTHR), args, 0, stream);
}
```

```cpp
#define LATE_W 0
#include <hip/hip_runtime.h>
#include <stdint.h>
#include <hip/hip_cooperative_groups.h>
namespace cg = cooperative_groups;

typedef unsigned short bf16_t;

#define NTOK 16384
#define SEQ 8192
#define DM 1024

__device__ __forceinline__ bf16_t f2bf(float f) {
  unsigned u = __float_as_uint(f);
  u += 0x7fffu + ((u >> 16) & 1u);
  return (bf16_t)(u >> 16);
}
__device__ __forceinline__ float bf2f(bf16_t h) { return __uint_as_float(((unsigned)h) << 16); }
__device__ __forceinline__ float bflo(unsigned u) { return __uint_as_float(u << 16); }
__device__ __forceinline__ float bfhi(unsigned u) { return __uint_as_float(u & 0xffff0000u); }

__device__ __forceinline__ float wave_sum(float v) {
#pragma unroll
  for (int o = 32; o >= 1; o >>= 1) v += __shfl_xor(v, o);
  return v;
}
__device__ __forceinline__ float wave_max(float v) {
#pragma unroll
  for (int o = 32; o >= 1; o >>= 1) v = fmaxf(v, __shfl_xor(v, o));
  return v;
}
__device__ __forceinline__ float gelu_tanh(float x) {
  float y = 0.7978845608028654f * (x + 0.044715f * x * x * x);
  return x / (1.0f + __expf(-2.0f * y));
}
__device__ __forceinline__ float sigmoidf_(float x) { return 1.0f / (1.0f + __expf(-x)); }
__device__ __forceinline__ float softplusf_(float z) { return fmaxf(z, 0.f) + log1pf(expf(-fabsf(z))); }

__device__ __forceinline__ float ldA(const float* p) { return *p; }
__device__ __forceinline__ float ldA(const bf16_t* p) { return bf2f(*p); }


namespace pg8 {
#define PG8_LAS __attribute__((address_space(3)))
typedef unsigned short bf16_t;
typedef short bf16x8 __attribute__((ext_vector_type(8)));
typedef float f32x4 __attribute__((ext_vector_type(4)));
typedef unsigned u32x4 __attribute__((ext_vector_type(4)));
constexpr int BM = 256, BK = 64, HALF = 128, HTB = HALF * BK * 2  , STAGE_BYTES = 8 * HTB, NXCD = 8, WGM = 8;

__host__ __device__ __forceinline__ int lds_byte(int r, int c) { const int st = (r >> 4) * 2 + (c >> 5), rr = r & 15, cc = c & 31, ob = rr * 64 + cc * 2; return st * 1024 + (ob ^ (((ob >> 9) & 1) << 5)); }
__host__ __device__ __forceinline__ void stage_rc(int b, int& R, int& C) { const int st = b / 1024, sb = b % 1024, swz = sb ^ (((sb >> 9) & 1) << 5); R = (st >> 1) * 16 + swz / 64; C = (st & 1) * 32 + (swz % 64) / 2; }
__host__ __device__ __forceinline__ int perm32(int rho) { const int n = rho >> 4, i = rho & 15; return 8 * (i >> 2) + 4 * n + (i & 3); }

struct Unit { int pm, pn; };
struct Gemm { const bf16_t* A; const bf16_t* Bt; int M, N, K; };

struct StaticOrder {
    int nM, nN, nwg, G, c;
    __host__ __device__ void init(int M, int N, int G_, int c_) { nM = M / BM; nN = N / BM; nwg = nM * nN; G = G_; c = c_; }
    __host__ __device__ bool next(int i, Unit& u) const {
        const long L = (long)i * G + c; if (L >= nwg) return false;
        int wgid = (int)L; { const int q = nwg / NXCD, r = nwg % NXCD, xcd = wgid % NXCD, off = wgid / NXCD; wgid = (xcd < r ? xcd * (q + 1) : r * (q + 1) + (xcd - r) * q) + off; }
        const int nig = WGM * nN, gid = wgid / nig, fm = gid * WGM, gsz = (nM - fm) < WGM ? (nM - fm) : WGM;
        u.pm = fm + ((wgid % nig) % gsz); u.pn = (wgid % nig) / gsz; return true;
    }
    __device__ __forceinline__ void a_ready(const Unit&) const {}
    __device__ __forceinline__ void done(const Unit&) const {}
};
typedef __bf16 bf16x2_cv __attribute__((ext_vector_type(2)));
typedef float f32x2_cv __attribute__((ext_vector_type(2)));
__device__ __forceinline__ unsigned cvt_pk_bf16(float lo, float hi) { const f32x2_cv v = {lo, hi}; return __builtin_bit_cast(unsigned, __builtin_convertvector(v, bf16x2_cv)); }
typedef float f32x2 __attribute__((ext_vector_type(2)));
__device__ __forceinline__ f32x2 gelu_pk(f32x2 v) {
    const f32x2 av = __builtin_elementwise_abs(v), d = av * 0.2316418882f + 1.0f;
    f32x2 t; t.x = __builtin_amdgcn_rcpf(d.x); t.y = __builtin_amdgcn_rcpf(d.y);
    f32x2 q = t * 0.5307027145f + (-0.7265760135f); q = q * t + 0.7107068705f; q = q * t + (-0.142248368f); q = q * t + 0.127414796f; q = q * t;
    const f32x2 s = (v * v) * (-0.72134752044f);
    f32x2 e; e.x = __builtin_amdgcn_exp2f(s.x); e.y = __builtin_amdgcn_exp2f(s.y);
    const f32x2 m = v * (q * e), r = v - m;
    f32x2 o; o.x = v.x < 0.f ? m.x : r.x; o.y = v.y < 0.f ? m.y : r.y; return o;
}

struct EpiF32 {
    static constexpr bool PERM = false, AFTER_DRAIN = false;
    float* C; int ldc; const float* bias;
    __device__ __forceinline__ void operator()(const f32x4 (&acc)[2][2][4][2], const Unit& u, int wr, int wc, int fr, int fq) const {
        const int row0 = u.pm * BM + wr * 64 + fr, col0 = u.pn * BM + wc * 32 + 4 * fq;
        f32x4 bv[2][2];
#pragma unroll
        for (int bj = 0; bj < 2; ++bj)
#pragma unroll
            for (int n = 0; n < 2; ++n) bv[bj][n] = bias ? *(const f32x4*)(bias + col0 + bj * HALF + n * 16) : (f32x4){0.f, 0.f, 0.f, 0.f};
#pragma unroll
        for (int ai = 0; ai < 2; ++ai)
#pragma unroll
            for (int m = 0; m < 4; ++m) { float* rowp = C + (size_t)(row0 + ai * HALF + m * 16) * ldc + col0;
#pragma unroll
                for (int bj = 0; bj < 2; ++bj)
#pragma unroll
                    for (int n = 0; n < 2; ++n) *(f32x4*)(rowp + bj * HALF + n * 16) = acc[ai][bj][m][n] + bv[bj][n]; }
    }
};
template <int ACT  > struct EpiBf16 {
    static constexpr bool PERM = true, AFTER_DRAIN = false;
    bf16_t* O; int ldc; const float* bias; int split_cols; size_t split_stride;
    __device__ __forceinline__ void operator()(const f32x4 (&acc)[2][2][4][2], const Unit& u, int wr, int wc, int fr, int fq) const {
        const int row0 = u.pm * BM + wr * 64 + fr; int colt = u.pn * BM; bf16_t* base = O;
        if (split_cols) { const int t = colt / split_cols; base += (size_t)t * split_stride; colt -= t * split_cols; }
        const int col0 = colt + wc * 32 + 8 * fq, bcol0 = u.pn * BM + wc * 32 + 8 * fq;
        f32x4 bv[2][2];
#pragma unroll
        for (int bj = 0; bj < 2; ++bj)
#pragma unroll
            for (int n = 0; n < 2; ++n) bv[bj][n] = bias ? *(const f32x4*)(bias + bcol0 + bj * HALF + 4 * n) : (f32x4){0.f, 0.f, 0.f, 0.f};
#pragma unroll
        for (int ai = 0; ai < 2; ++ai)
#pragma unroll
            for (int m = 0; m < 4; ++m) { bf16_t* rowp = base + (size_t)(row0 + ai * HALF + m * 16) * ldc + col0;
#pragma unroll
                for (int bj = 0; bj < 2; ++bj) { f32x4 v0 = acc[ai][bj][m][0] + bv[bj][0], v1 = acc[ai][bj][m][1] + bv[bj][1];
                    if (ACT == 1) { f32x2 a = gelu_pk((f32x2){v0[0], v0[1]}), b = gelu_pk((f32x2){v0[2], v0[3]}), c = gelu_pk((f32x2){v1[0], v1[1]}), d = gelu_pk((f32x2){v1[2], v1[3]});
                        v0 = (f32x4){a.x, a.y, b.x, b.y}; v1 = (f32x4){c.x, c.y, d.x, d.y}; }
                    if (ACT == 2) {
#pragma unroll
                        for (int j = 0; j < 4; ++j) { v0[j] = 0.5f * v0[j] * (1.0f + erff(v0[j] * 0.70710678f)); v1[j] = 0.5f * v1[j] * (1.0f + erff(v1[j] * 0.70710678f)); } }
                    u32x4 w; w.x = cvt_pk_bf16(v0[0], v0[1]); w.y = cvt_pk_bf16(v0[2], v0[3]); w.z = cvt_pk_bf16(v1[0], v1[1]); w.w = cvt_pk_bf16(v1[2], v1[3]);
                    *(u32x4*)(rowp + bj * HALF) = w; } }
    }
};

template <class Epi, class Sched, bool STAMP = false>
__device__ __forceinline__ void gemm_phase(PG8_LAS unsigned char* lds, const Gemm g, const Sched& S, const Epi& E, unsigned long long* stamps) {
    int tid_ = threadIdx.x; asm volatile("" : "+v"(tid_));
    const int tid = tid_, wid = __builtin_amdgcn_readfirstlane(tid >> 6), lane = tid & 63, wr = wid >> 2, wc = wid & 3, fr = lane & 15, fq = lane >> 4;
    const int K = g.K, nt = K / BK;
    int ts_lo = 0, ts_hi = 0, nts = 0; const unsigned long long rt_entry = STAMP ? (unsigned long long)wall_clock64() : 0ull;
#define PG8_STAMP() do { if (STAMP && wid == 0 && nts < 64) { const unsigned long long _c = (unsigned long long)clock64(); \
        ts_lo = (lane == nts) ? (int)(unsigned)_c : ts_lo; ts_hi = (lane == nts) ? (int)(unsigned)(_c >> 32) : ts_hi; ++nts; } } while (0)
    PG8_STAMP();
    unsigned voffA[2], voffB[2];
#pragma unroll
    for (int i = 0; i < 2; ++i) { int R, C; stage_rc(tid * 16 + i * 8192, R, C); const int Rb = Epi::PERM ? ((R & ~31) + perm32(R & 31)) : R;
        voffA[i] = (unsigned)(R * K + C) * 2u; voffB[i] = (unsigned)(Rb * K + C) * 2u; }
    const size_t kstep = (size_t)(BK * 2);
    const size_t hstep = (size_t)HALF * K * 2;
    const size_t tstep = 2 * hstep;
    const unsigned ldsw = (unsigned)wid * 1024u;
    const int aoff = lds_byte(wr * 64 + fr, fq * 8), boff = lds_byte(wc * 32 + fr, fq * 8);
#define PG8_SA(b, h) (((b) * 2 + (h)) * HTB)
#define PG8_SB(b, h) ((4 + (b) * 2 + (h)) * HTB)
#define PG8_STAGE(bufoff, gbase, voff) do { _Pragma("unroll") for (int _i = 0; _i < 2; ++_i) \
        __builtin_amdgcn_global_load_lds((const unsigned*)((const char*)(gbase) + (voff)[_i]), (PG8_LAS unsigned*)(lds + (bufoff) + ldsw + _i * 8192), 16, 0, 0); } while (0)
#define PG8_LDA(dst, b, h) do { _Pragma("unroll") for (int m = 0; m < 4; ++m) _Pragma("unroll") for (int k = 0; k < 2; ++k) dst[m][k] = *(const PG8_LAS bf16x8*)(lds + PG8_SA(b, h) + aoff + m * 2048 + k * 1024); } while (0)
#define PG8_LDB(dst, b, h) do { _Pragma("unroll") for (int n = 0; n < 2; ++n) _Pragma("unroll") for (int k = 0; k < 2; ++k) dst[n][k] = *(const PG8_LAS bf16x8*)(lds + PG8_SB(b, h) + boff + n * 2048 + k * 1024); } while (0)
#define PG8_MMA(ai, bj, At, Bt) do { __builtin_amdgcn_s_setprio(1); _Pragma("unroll") for (int m = 0; m < 4; ++m) _Pragma("unroll") for (int n = 0; n < 2; ++n) _Pragma("unroll") for (int k = 0; k < 2; ++k) \
        acc[ai][bj][m][n] = __builtin_amdgcn_mfma_f32_16x16x32_bf16(Bt[n][k], At[m][k], acc[ai][bj][m][n], 0, 0, 0); __builtin_amdgcn_s_setprio(0); } while (0)
#define PG8_WAIT_V(n) asm volatile("s_waitcnt vmcnt(" #n ")" ::: "memory")
#define PG8_WAIT_L(n) asm volatile("s_waitcnt lgkmcnt(" #n ")" ::: "memory")
#define PG8_BAR __builtin_amdgcn_s_barrier()
#define PG8_SCHED __builtin_amdgcn_sched_barrier(0)
    Unit cur, nxt; int ui = 0;
    if (!S.next(0, cur)) return;
    f32x4 acc[2][2][4][2];
#pragma unroll
    for (int a = 0; a < 2; ++a)
#pragma unroll
        for (int b = 0; b < 2; ++b)
#pragma unroll
            for (int m = 0; m < 4; ++m)
#pragma unroll
                for (int n = 0; n < 2; ++n) acc[a][b][m][n] = (f32x4){0.f, 0.f, 0.f, 0.f};
    bf16x8 At[4][2], B0[2][2], B1[2][2];
    const char* cA = (const char*)g.A + (size_t)cur.pm * tstep; const char* cB = (const char*)g.Bt + (size_t)cur.pn * tstep;
    S.a_ready(cur);
    PG8_STAGE(PG8_SB(0, 0), cB, voffB); PG8_STAGE(PG8_SA(0, 0), cA, voffA); PG8_STAGE(PG8_SB(0, 1), cB + hstep, voffB); PG8_STAGE(PG8_SA(0, 1), cA + hstep, voffA);
    if (wr == 1) PG8_BAR;
    PG8_WAIT_V(4); PG8_BAR;
    PG8_STAGE(PG8_SB(1, 0), cB + kstep, voffB); PG8_STAGE(PG8_SA(1, 0), cA + kstep, voffA); PG8_STAGE(PG8_SB(1, 1), cB + hstep + kstep, voffB);
    PG8_WAIT_V(6); PG8_BAR;
    PG8_STAMP();
    for (;;) {
        const bool has_next = S.next(ui + 1, nxt);
        const char* nA = has_next ? (const char*)g.A + (size_t)nxt.pm * tstep : cA; const char* nB = has_next ? (const char*)g.Bt + (size_t)nxt.pn * tstep : cB;
        for (int t = 0; t < nt; t += 2) {
            const bool last = (t == nt - 2);
            const char* a1 = cA + (size_t)(t + 1) * kstep;
            const char* a2 = last ? nA : cA + (size_t)(t + 2) * kstep; const char* b2 = last ? nB : cB + (size_t)(t + 2) * kstep;
            const char* a3 = a2 + kstep; const char* b3 = b2 + kstep;
            if (last && has_next) S.a_ready(nxt);
            PG8_LDB(B0, 0, 0); PG8_SCHED; PG8_LDA(At, 0, 0); PG8_STAGE(PG8_SA(1, 1), a1 + hstep, voffA);
            PG8_WAIT_L(8); PG8_BAR; PG8_WAIT_L(0); PG8_MMA(0, 0, At, B0); PG8_BAR; PG8_SCHED;
            PG8_LDB(B1, 0, 1); PG8_STAGE(PG8_SB(0, 0), b2, voffB);
            PG8_BAR; PG8_WAIT_L(0); PG8_MMA(0, 1, At, B1); PG8_BAR;
            PG8_LDA(At, 0, 1); PG8_STAGE(PG8_SA(0, 0), a2, voffA);
            PG8_BAR; PG8_WAIT_L(0); PG8_MMA(1, 0, At, B0); PG8_BAR; PG8_SCHED;
            PG8_STAGE(PG8_SB(0, 1), b2 + hstep, voffB);
            PG8_WAIT_V(6); PG8_BAR; PG8_MMA(1, 1, At, B1); PG8_BAR;
            PG8_LDB(B0, 1, 0); PG8_SCHED; PG8_LDA(At, 1, 0); PG8_STAGE(PG8_SA(0, 1), a2 + hstep, voffA);
            PG8_WAIT_L(8); PG8_BAR; PG8_WAIT_L(0); PG8_MMA(0, 0, At, B0); PG8_BAR; PG8_SCHED;
            PG8_LDB(B1, 1, 1); PG8_STAGE(PG8_SB(1, 0), b3, voffB);
            PG8_BAR; PG8_WAIT_L(0); PG8_MMA(0, 1, At, B1); PG8_BAR;
            PG8_LDA(At, 1, 1); PG8_STAGE(PG8_SA(1, 0), a3, voffA);
            PG8_BAR; PG8_WAIT_L(0); PG8_MMA(1, 0, At, B0); PG8_BAR; PG8_SCHED;
            PG8_STAGE(PG8_SB(1, 1), b3 + hstep, voffB);
            PG8_WAIT_V(6); PG8_BAR; PG8_MMA(1, 1, At, B1); PG8_BAR;
        }
        PG8_STAMP();
        if constexpr (!Epi::AFTER_DRAIN) { E(acc, cur, wr, wc, fr, fq); S.done(cur); }
        PG8_STAMP();
        if (!has_next) break;
#pragma unroll
        for (int a = 0; a < 2; ++a)
#pragma unroll
            for (int b = 0; b < 2; ++b)
#pragma unroll
                for (int m = 0; m < 4; ++m)
#pragma unroll
                    for (int n = 0; n < 2; ++n) acc[a][b][m][n] = (f32x4){0.f, 0.f, 0.f, 0.f};
        cur = nxt; cA = nA; cB = nB; ++ui;
    }
    PG8_WAIT_V(0);
    if (wr == 0) PG8_BAR;
    PG8_BAR;
    if constexpr (Epi::AFTER_DRAIN) { E.fused(acc, cur, wr, wc, fr, fq, lds, wid, lane); S.done(cur); }
    PG8_STAMP();
    if (STAMP && wid == 0) { stamps[lane] = lane < nts ? (((unsigned long long)(unsigned)ts_hi << 32) | (unsigned)ts_lo) : 0ull;
        if (lane == 62) stamps[62] = rt_entry; if (lane == 63) stamps[63] = (unsigned long long)wall_clock64(); }
#undef PG8_STAMP
#undef PG8_SA
#undef PG8_SB
#undef PG8_STAGE
#undef PG8_LDA
#undef PG8_LDB
#undef PG8_MMA
#undef PG8_WAIT_V
#undef PG8_WAIT_L
#undef PG8_BAR
#undef PG8_SCHED
}
}
#define NTHR 512
#define NWAVE 8
__device__ __forceinline__ void wave_lds_sync() { __builtin_amdgcn_fence(__ATOMIC_ACQ_REL, "workgroup"); __builtin_amdgcn_wave_barrier(); }

struct Params {
  const float *x, *mem, *g_mix, *w_in, *a_re, *a_im, *log_dt, *b_re, *b_im, *c_re, *c_im, *d_skip, *w_glu, *b_glu,
      *g_attn_out, *g_ssm_out, *w_out, *g_xattn, *g_mem, *w_xq, *w_xkv, *w_xo, *g_ffn, *w_pq, *sub_keys, *peer_u, *peer_v, *g_final;
  float* H; char* ws;
};

__device__ void ph_rmsnorm(const float* __restrict__ x, const float* __restrict__ g, bf16_t* __restrict__ out, int rows) {
  int lane = threadIdx.x & 63;
  for (int row = blockIdx.x * NWAVE + (threadIdx.x >> 6); row < rows; row += gridDim.x * NWAVE) {
    const float* xr = x + (size_t)row * 1024;
    float v[16]; float ss = 0.f;
#pragma unroll
    for (int i = 0; i < 16; ++i) { v[i] = xr[lane + 64 * i]; ss += v[i] * v[i]; }
    ss = wave_sum(ss);
    float r = rsqrtf(ss / 1024.f + 1e-6f);
#pragma unroll
    for (int i = 0; i < 16; ++i) out[(size_t)row * 1024 + lane + 64 * i] = f2bf(v[i] * r * g[lane + 64 * i]);
  }
}
__device__ void ph_mixnorm(bf16_t* __restrict__ mix, const float* __restrict__ ga, const float* __restrict__ gs) {
  int lane = threadIdx.x & 63;
  for (int w = blockIdx.x * NWAVE + (threadIdx.x >> 6); w < NTOK * 2; w += gridDim.x * NWAVE) {
    int row = w >> 1, half = w & 1;
    bf16_t* p = mix + (size_t)row * 1024 + half * 512;
    const float* g = half ? gs : ga;
    float v[8]; float ss = 0.f;
#pragma unroll
    for (int i = 0; i < 8; ++i) { v[i] = bf2f(p[lane + 64 * i]); ss += v[i] * v[i]; }
    ss = wave_sum(ss);
    float r = rsqrtf(ss / 512.f + 1e-6f);
#pragma unroll
    for (int i = 0; i < 8; ++i) p[lane + 64 * i] = f2bf(v[i] * r * g[lane + 64 * i]);
  }
}

struct EpiInProj { bf16_t* qkv; float* u;
  __device__ void operator()(int m, int n, float acc) const {
    if (n < 1536) qkv[(size_t)m * 1536 + n] = f2bf(acc); else u[(size_t)m * 512 + (n - 1536)] = acc; } };
struct EpiGlu { const bf16_t* y; const float* b; bf16_t* mix;
  __device__ void operator()(int m, int n, float acc) const {
    float yv = bf2f(y[(size_t)m * 512 + n]);
    mix[(size_t)m * 1024 + 512 + n] = f2bf(yv * sigmoidf_(acc + b[n])); } };
struct EpiResInit { const float* x; float* h;
  __device__ void operator()(int m, int n, float acc) const { h[(size_t)m * 1024 + n] = x[(size_t)m * 1024 + n] + acc; } };
struct EpiResAdd { float* h;
  __device__ void operator()(int m, int n, float acc) const { h[(size_t)m * 1024 + n] += acc; } };
struct EpiBf16 { bf16_t* o; int ld;
  __device__ void operator()(int m, int n, float acc) const { o[(size_t)m * ld + n] = f2bf(acc); } };

template <typename Epi>
__device__ void ph_gemm_naive(const bf16_t* __restrict__ A, int lda, const float* __restrict__ W, int N, int K, int M, Epi epi) {
  long total = (long)(M / 4) * N;
  for (long idx = (long)blockIdx.x * NTHR + threadIdx.x; idx < total; idx += (long)gridDim.x * NTHR) {
    int n = (int)(idx % N); int m0 = (int)(idx / N) * 4;
    float a0 = 0, a1 = 0, a2 = 0, a3 = 0;
    const bf16_t* Ar = A + (size_t)m0 * lda;
    for (int k = 0; k < K; ++k) {
      float w = W[(size_t)k * N + n];
      a0 += bf2f(Ar[k]) * w; a1 += bf2f(Ar[lda + k]) * w; a2 += bf2f(Ar[2 * lda + k]) * w; a3 += bf2f(Ar[3 * lda + k]) * w;
    }
    epi(m0, n, a0); epi(m0 + 1, n, a1); epi(m0 + 2, n, a2); epi(m0 + 3, n, a3);
  }
}

__device__ void ph_attn_naive(const bf16_t* __restrict__ qkv, bf16_t* __restrict__ mix) {
  for (int idx = blockIdx.x * NTHR + threadIdx.x; idx < 2 * 8 * SEQ; idx += gridDim.x * NTHR) {
    int t = idx & (SEQ - 1), h = (idx >> 13) & 7, b = idx >> 16;
    const bf16_t* base = qkv + (size_t)b * SEQ * 1536 + h * 64;
    float q[64], o[64];
    {
      const uint4* qp = (const uint4*)(base + (size_t)t * 1536);
#pragma unroll
      for (int i = 0; i < 8; ++i) {
        uint4 v = qp[i];
        q[8 * i + 0] = bflo(v.x); q[8 * i + 1] = bfhi(v.x); q[8 * i + 2] = bflo(v.y); q[8 * i + 3] = bfhi(v.y);
        q[8 * i + 4] = bflo(v.z); q[8 * i + 5] = bfhi(v.z); q[8 * i + 6] = bflo(v.w); q[8 * i + 7] = bfhi(v.w);
      }
    }
#pragma unroll
    for (int d = 0; d < 64; ++d) o[d] = 0.f;
    float C = 0.f;
    for (int s = t - 1; s >= 0; --s) {
      const uint4* kp = (const uint4*)(base + (size_t)s * 1536 + 512);
      float z = 0.f;
#pragma unroll
      for (int i = 0; i < 8; ++i) {
        uint4 v = kp[i];
        z += q[8 * i + 0] * bflo(v.x) + q[8 * i + 1] * bfhi(v.x) + q[8 * i + 2] * bflo(v.y) + q[8 * i + 3] * bfhi(v.y) +
             q[8 * i + 4] * bflo(v.z) + q[8 * i + 5] * bfhi(v.z) + q[8 * i + 6] * bflo(v.w) + q[8 * i + 7] * bfhi(v.w);
      }
      z *= 0.125f;
      C += softplusf_(z);
      float w = expf(z - C);
      const uint4* vp = (const uint4*)(base + (size_t)s * 1536 + 1024);
#pragma unroll
      for (int i = 0; i < 8; ++i) {
        uint4 v = vp[i];
        o[8 * i + 0] += w * bflo(v.x); o[8 * i + 1] += w * bfhi(v.x); o[8 * i + 2] += w * bflo(v.y); o[8 * i + 3] += w * bfhi(v.y);
        o[8 * i + 4] += w * bflo(v.z); o[8 * i + 5] += w * bfhi(v.z); o[8 * i + 6] += w * bflo(v.w); o[8 * i + 7] += w * bfhi(v.w);
      }
      if (C > 105.f) break;
    }
    bf16_t* op = mix + ((size_t)b * SEQ + t) * 1024 + h * 64;
#pragma unroll
    for (int d = 0; d < 64; d += 2) {
      unsigned pk = (unsigned)f2bf(o[d]) | ((unsigned)f2bf(o[d + 1]) << 16);
      *(unsigned*)(op + d) = pk;
    }
  }
}

__device__ void ph_ssm_naive(const Params& P, const float* __restrict__ U, bf16_t* __restrict__ Y, float* smem) {
  int wv = threadIdx.x >> 6, lane = threadIdx.x & 63, p = lane;
  float* xs = smem + wv * 128;
  for (int bg = blockIdx.x * NWAVE + wv; bg < 64; bg += gridDim.x * NWAVE) {
    int b = bg >> 5, g = bg & 31;
    double are = P.a_re[g * 64 + p], aim = P.a_im[g * 64 + p], dt = exp((double)P.log_dt[g]);
    double er = exp(are * dt), sn, cs; sincos(aim * dt, &sn, &cs);
    double lbr_d = er * cs, lbi_d = er * sn;
    double nr = lbr_d - 1.0, ni = lbi_d, den = are * are + aim * aim;
    double cr = (nr * are + ni * aim) / den, ci = (ni * are - nr * aim) / den;
    float lbr = (float)lbr_d, lbi = (float)lbi_d;
    float bbr[16], bbi[16];
#pragma unroll
    for (int c = 0; c < 16; ++c) {
      double br = P.b_re[(g * 64 + p) * 16 + c], bi = P.b_im[(g * 64 + p) * 16 + c];
      bbr[c] = (float)(cr * br - ci * bi); bbi[c] = (float)(cr * bi + ci * br);
    }
    int c2 = lane & 15, q2 = lane >> 4;
    float cre[16], cim[16];
#pragma unroll
    for (int j = 0; j < 16; ++j) {
      cre[j] = P.c_re[(g * 16 + c2) * 64 + q2 * 16 + j]; cim[j] = P.c_im[(g * 16 + c2) * 64 + q2 * 16 + j];
    }
    float dsk = P.d_skip[g * 16 + c2];
    float xr = 0.f, xi = 0.f;
    const float* Ub = U + (size_t)b * SEQ * 512 + g * 16;
    bf16_t* Yb = Y + (size_t)b * SEQ * 512 + g * 16;
    for (int t = 0; t < SEQ; ++t) {
      const float4* up = (const float4*)(Ub + (size_t)t * 512);
      float u[16];
#pragma unroll
      for (int i = 0; i < 4; ++i) { float4 v = up[i]; u[4 * i] = v.x; u[4 * i + 1] = v.y; u[4 * i + 2] = v.z; u[4 * i + 3] = v.w; }
      float bur = 0.f, bui = 0.f;
#pragma unroll
      for (int c = 0; c < 16; ++c) { bur += bbr[c] * u[c]; bui += bbi[c] * u[c]; }
      float nxr = lbr * xr - lbi * xi + bur, nxi = lbr * xi + lbi * xr + bui;
      xr = nxr; xi = nxi;
      wave_lds_sync();
      xs[p] = xr; xs[64 + p] = xi;
      wave_lds_sync();
      float acc = 0.f;
#pragma unroll
      for (int j = 0; j < 16; ++j) acc += cre[j] * xs[q2 * 16 + j] - cim[j] * xs[64 + q2 * 16 + j];
      acc += __shfl_xor(acc, 16); acc += __shfl_xor(acc, 32);
      if (lane < 16) {
        float y = acc + dsk * Ub[(size_t)t * 512 + c2];
        Yb[(size_t)t * 512 + c2] = f2bf(gelu_tanh(y));
      }
    }
  }
}

__device__ void ph_xattn_naive(const bf16_t* __restrict__ QX, const bf16_t* __restrict__ KV, bf16_t* __restrict__ XO, float* smem) {
  int wv = threadIdx.x >> 6, lane = threadIdx.x & 63;
  float* qs = smem + wv * 512; float* ps = qs + 256;
  for (int item = blockIdx.x * NWAVE + wv; item < NTOK * 4; item += gridDim.x * NWAVE) {
    int tok = item >> 2, h = item & 3, b = tok >> 13;
    wave_lds_sync();
    for (int i = lane; i < 256; i += 64) qs[i] = bf2f(QX[(size_t)tok * 1024 + h * 256 + i]);
    wave_lds_sync();
    float sc[4];
#pragma unroll
    for (int j = 0; j < 4; ++j) {
      int m = lane + 64 * j;
      const uint4* kp = (const uint4*)(KV + ((size_t)b * 256 + m) * 2048 + h * 256);
      float s = 0.f;
      for (int i = 0; i < 32; ++i) {
        uint4 v = kp[i]; const float* qq = &qs[8 * i];
        s += qq[0] * bflo(v.x) + qq[1] * bfhi(v.x) + qq[2] * bflo(v.y) + qq[3] * bfhi(v.y) + qq[4] * bflo(v.z) +
             qq[5] * bfhi(v.z) + qq[6] * bflo(v.w) + qq[7] * bfhi(v.w);
      }
      sc[j] = s * 0.0625f;
    }
    float mx = wave_max(fmaxf(fmaxf(sc[0], sc[1]), fmaxf(sc[2], sc[3])));
    float sum = 0.f;
#pragma unroll
    for (int j = 0; j < 4; ++j) { sc[j] = expf(sc[j] - mx); sum += sc[j]; }
    sum = wave_sum(sum);
    float inv = 1.0f / sum;
#pragma unroll
    for (int j = 0; j < 4; ++j) ps[lane + 64 * j] = sc[j] * inv;
    wave_lds_sync();
    float o0 = 0, o1 = 0, o2 = 0, o3 = 0;
    const bf16_t* vb = KV + (size_t)b * 256 * 2048 + 1024 + h * 256 + lane * 4;
    for (int m = 0; m < 256; ++m) {
      uint2 v = *(const uint2*)(vb + (size_t)m * 2048);
      float pm = ps[m];
      o0 += pm * bflo(v.x); o1 += pm * bfhi(v.x); o2 += pm * bflo(v.y); o3 += pm * bfhi(v.y);
    }
    uint2 pk; pk.x = (unsigned)f2bf(o0) | ((unsigned)f2bf(o1) << 16); pk.y = (unsigned)f2bf(o2) | ((unsigned)f2bf(o3) << 16);
    *(uint2*)(XO + (size_t)tok * 1024 + h * 256 + lane * 4) = pk;
  }
}

#define INS16(val, idx, V, I)                                   \
  {                                                             \
    float nv = (val); int ni = (idx);                           \
    _Pragma("unroll") for (int j = 0; j < 16; ++j) {            \
      bool gt = nv > V[j];                                      \
      float tv = gt ? V[j] : nv; int ti = gt ? I[j] : ni;       \
      V[j] = gt ? nv : V[j]; I[j] = gt ? ni : I[j];             \
      nv = tv; ni = ti;                                         \
    }                                                           \
  }

__device__ void ph_route_naive(const bf16_t* __restrict__ PQ, const float* __restrict__ subk, int* __restrict__ EXP,
                               float* __restrict__ GATE, float* smem) {
  float* qs = smem; float* sc = smem + 2048; float* tv = smem + 4096; int* ti = (int*)(smem + 4096 + 256);
  int tid = threadIdx.x;
  for (int tok = blockIdx.x; tok < NTOK; tok += gridDim.x) {
    __syncthreads();
    for (int i = tid; i < 2048; i += NTHR) qs[i] = bf2f(PQ[(size_t)tok * 2048 + i]);
    __syncthreads();
    for (int j = 0; j < 4; ++j) {
      int si = tid + NTHR * j;
      int hh = si >> 7;
      const float4* kp = (const float4*)(subk + (size_t)si * 128);
      const float* qq = qs + hh * 128;
      float s = 0.f;
      for (int d = 0; d < 32; ++d) { float4 v = kp[d]; s += qq[4 * d] * v.x + qq[4 * d + 1] * v.y + qq[4 * d + 2] * v.z + qq[4 * d + 3] * v.w; }
      sc[si] = s;
    }
    __syncthreads();
    if (tid < 16) {
      float V[16]; int I[16];
#pragma unroll
      for (int j = 0; j < 16; ++j) { V[j] = -3.0e38f; I[j] = 0; }
      for (int k = 0; k < 128; ++k) INS16(sc[tid * 128 + k], k, V, I)
#pragma unroll
      for (int j = 0; j < 16; ++j) { tv[tid * 16 + j] = V[j]; ti[tid * 16 + j] = I[j]; }
    }
    __syncthreads();
    if (tid < 8) {
      float V[16]; int I[16];
#pragma unroll
      for (int j = 0; j < 16; ++j) { V[j] = -3.0e38f; I[j] = 0; }
      for (int a = 0; a < 16; ++a)
        for (int bb = 0; bb < 16; ++bb) INS16(tv[(2 * tid) * 16 + a] + tv[(2 * tid + 1) * 16 + bb], a * 16 + bb, V, I)
      float mx = V[0], sum = 0.f;
      float e[16];
#pragma unroll
      for (int j = 0; j < 16; ++j) { e[j] = expf(V[j] - mx); sum += e[j]; }
      float inv = 1.f / sum;
#pragma unroll
      for (int j = 0; j < 16; ++j) {
        int pos = I[j];
        int i1 = ti[(2 * tid) * 16 + (pos >> 4)], i2 = ti[(2 * tid + 1) * 16 + (pos & 15)];
        EXP[(size_t)tok * 128 + tid * 16 + j] = i1 * 128 + i2;
        GATE[(size_t)tok * 128 + tid * 16 + j] = e[j] * inv;
      }
    }
  }
}

__device__ void ph_gather_naive(const bf16_t* __restrict__ HN, const int* __restrict__ EXP, const float* __restrict__ GATE,
                                const float* __restrict__ PU, const float* __restrict__ PV, const float* __restrict__ gfin,
                                float* __restrict__ H, float* smem) {
  float* part = smem;
  float* red = smem + 8192;
  int w = threadIdx.x >> 6, lane = threadIdx.x & 63;
  for (int tok = blockIdx.x; tok < NTOK; tok += gridDim.x) {
    float hn[16], acc[16];
#pragma unroll
    for (int i = 0; i < 16; ++i) { hn[i] = bf2f(HN[(size_t)tok * 1024 + lane + 64 * i]); acc[i] = 0.f; }
    for (int j = 0; j < 16; ++j) {
      int e = EXP[(size_t)tok * 128 + w * 16 + j];
      float gt = GATE[(size_t)tok * 128 + w * 16 + j];
      const float* ur = PU + (size_t)e * 1024;
      float d = 0.f;
#pragma unroll
      for (int i = 0; i < 16; ++i) d += hn[i] * ur[lane + 64 * i];
      d = wave_sum(d);
      float wgt = gt * gelu_tanh(d);
      const float* vr = PV + (size_t)e * 1024;
#pragma unroll
      for (int i = 0; i < 16; ++i) acc[i] += wgt * vr[lane + 64 * i];
    }
    __syncthreads();
#pragma unroll
    for (int i = 0; i < 16; ++i) part[w * 1024 + lane + 64 * i] = acc[i];
    __syncthreads();
    float v[2]; float ss = 0.f;
#pragma unroll
    for (int i = 0; i < 2; ++i) {
      int c = threadIdx.x + NTHR * i;
      float s = H[(size_t)tok * 1024 + c];
#pragma unroll
      for (int k = 0; k < 8; ++k) s += part[k * 1024 + c];
      v[i] = s; ss += s * s;
    }
    ss = wave_sum(ss);
    if (lane == 0) red[w] = ss;
    __syncthreads();
    float tot = 0.f;
#pragma unroll
    for (int k = 0; k < 8; ++k) tot += red[k];
    float r = rsqrtf(tot / 1024.f + 1e-6f);
#pragma unroll
    for (int i = 0; i < 2; ++i) { int c = threadIdx.x + NTHR * i; H[(size_t)tok * 1024 + c] = v[i] * r * gfin[c]; }
  }
}


#include <cstdint>
#define XB_TMO      128
#define XB_XCNT(j)  (256  + 64 * (j))
#define XB_XSUB(j)  (1280 + 64 * (j))
#define XB_XGEN(j)  (2304 + 64 * (j))
#define XB_TOP      3328
#define XB_TOPGEN   3392
#define XCD_BAR_WORDS 3456
#define XB_SPIN_CAP (1u << 18)
#define LAS __attribute__((address_space(3)))

__device__ __forceinline__ unsigned xb_ld(unsigned* p)              { return __hip_atomic_load(p, __ATOMIC_RELAXED, __HIP_MEMORY_SCOPE_AGENT); }
__device__ __forceinline__ unsigned xb_add(unsigned* p, unsigned v) { return __hip_atomic_fetch_add(p, v, __ATOMIC_RELAXED, __HIP_MEMORY_SCOPE_AGENT); }
__device__ __forceinline__ unsigned xb_xcc_id() { return (unsigned)__builtin_amdgcn_s_getreg((3 << 11) | 20) & 0xFu; }
#define XB_SPIN(cond, bar) do { unsigned _sp = 0; while (cond) { __builtin_amdgcn_s_sleep(1); \
    if ((++_sp & 255u) == 0u) { if (xb_ld(&(bar)[XB_TMO])) break; if (_sp > XB_SPIN_CAP) { atomicAdd(&(bar)[XB_TMO], 1u); break; } } } } while (0)

struct XcdBarrier {
    unsigned* bar; unsigned x;
    volatile LAS unsigned* st;
};

__device__ __forceinline__ XcdBarrier xcd_barrier_post(unsigned* bar, volatile LAS unsigned* st) {
    XcdBarrier b; b.bar = bar; b.x = xb_xcc_id(); b.st = st;
    if (threadIdx.x == 0) (void)xb_add(&bar[XB_XCNT(b.x)], 1u);
    return b;
}
__device__ __forceinline__ void xcd_barrier_complete(unsigned* bar, unsigned x, unsigned& nloc, unsigned& nx) {
    const unsigned G = gridDim.x * gridDim.y * gridDim.z;
    unsigned sum, cnt, mine, sp = 0u;
    for (;;) {
        sum = 0u; cnt = 0u; mine = 0u;
#pragma unroll
        for (unsigned j = 0; j < 16; ++j) { const unsigned c = xb_ld(&bar[XB_XCNT(j)]); sum += c; cnt += (c > 0u) ? 1u : 0u; mine = (j == x) ? c : mine; }
        if (sum == G) break;
        __builtin_amdgcn_s_sleep(1);
        if ((++sp & 255u) == 0u) { if (xb_ld(&bar[XB_TMO])) break; if (sp > XB_SPIN_CAP) { atomicAdd(&bar[XB_TMO], 1u); break; } }
    }
    nloc = mine > 0u ? mine : 1u; nx = cnt > 0u ? cnt : 1u;
}

__device__ __forceinline__ void xcd_barrier(const XcdBarrier& b) {
    asm volatile("s_waitcnt vmcnt(0)" ::: "memory");
    __syncthreads();
    if (threadIdx.x == 0) {
        unsigned* bar = b.bar;
        __builtin_amdgcn_s_waitcnt(0);
        unsigned nloc = b.st[0], nx = b.st[1];
        if (nloc == 0u) { xcd_barrier_complete(bar, b.x, nloc, nx); b.st[0] = nloc; b.st[1] = nx; }
        const unsigned old = xb_add(&bar[XB_XSUB(b.x)], 1u);
        const unsigned gen = old / nloc;
        if (old + 1u == (gen + 1u) * nloc) {
            __builtin_amdgcn_fence(__ATOMIC_RELEASE, "agent");
            asm volatile("s_waitcnt vmcnt(0)" ::: "memory");
            const unsigned og = xb_add(&bar[XB_TOP], 1u);
            const unsigned tg = og / nx;
            if (og + 1u == (tg + 1u) * nx) xb_add(&bar[XB_TOPGEN], 1u);
            else XB_SPIN(xb_ld(&bar[XB_TOPGEN]) == tg, bar);
            __builtin_amdgcn_fence(__ATOMIC_ACQUIRE, "agent");
            xb_add(&bar[XB_XGEN(b.x)], 1u);
            asm volatile("s_waitcnt vmcnt(0)" ::: "memory");
        } else {
            XB_SPIN(xb_ld(&bar[XB_XGEN(b.x)]) == gen, bar);
            __builtin_amdgcn_fence(__ATOMIC_ACQUIRE, "agent");
            asm volatile("s_waitcnt vmcnt(0)" ::: "memory");
        }
    }
    __syncthreads();
}


enum { I_x = 0, I_mem, I_g_mix, I_w_in, I_a_re, I_a_im, I_log_dt, I_b_re, I_b_im, I_c_re, I_c_im, I_d_skip, I_w_glu, I_b_glu,
       I_g_attn_out, I_g_ssm_out, I_w_out, I_g_xattn, I_g_mem, I_w_xq, I_w_xkv, I_w_xo, I_g_ffn, I_w_pq, I_sub_keys, I_peer_u,
       I_peer_v, I_g_final, I_H, I_ws };
typedef __attribute__((address_space(4))) const char* kaptr_t;
__device__ __forceinline__ const float* KP(int i) {
  kaptr_t ka = (kaptr_t)__builtin_amdgcn_kernarg_segment_ptr();
  asm volatile("" : "+s"(ka));
  typedef const float* cfptr_t;
  typedef __attribute__((address_space(4))) const cfptr_t* slot_t;
  return *(slot_t)(ka + 8 * i);
}
#define WSP(T, mb) ((T*)((char*)KP(I_ws) + (size_t)(mb) * 1048576))
#define WSB(T, mb, extra) ((T*)((char*)KP(I_ws) + (size_t)(mb) * 1048576 + (extra)))
#define O_XN 0
#define O_QK 32
#define O_VT 64
#define O_U16 80
#define O_XO 80
#define O_MIX 112
#define O_Y 144
#define O_EXP 216
#define O_GATE 224
#define O_MEMN 160
#define O_KM 161
#define O_VTM 162
#define O_WIN 164
#define O_WGLU 168
#define O_WOUT 169
#define O_WXQ 171
#define O_WXKV 173
#define O_WXO 177
#define O_WPQ 179
#define O_PU8 184
#define O_PV8 200
#define O_SC 248
#define O_E 249
#define O_SKB 251
#define SS1_PTR WSB(float, O_SC, 524288)
#define SS2_PTR WSB(float, O_SC, 524288 + 65536)
#define SS3_PTR WSB(float, O_SC, 524288 + 131072)
#define CNT3_PTR WSB(unsigned, O_SC, 524288 + 196608)
#define O_BAR 252

#define DBG_CNT_PTR (WSP(unsigned, O_BAR) + 3400)

typedef float f32x4 __attribute__((ext_vector_type(4)));
typedef unsigned u32x4 __attribute__((ext_vector_type(4)));
__device__ __forceinline__ u32x4 pack8(const f32x4& v0, const f32x4& v1) {
  u32x4 w; w.x = pg8::cvt_pk_bf16(v0[0], v0[1]); w.y = pg8::cvt_pk_bf16(v0[2], v0[3]);
  w.z = pg8::cvt_pk_bf16(v1[0], v1[1]); w.w = pg8::cvt_pk_bf16(v1[2], v1[3]); return w;
}
struct GEpiInProj {
  static constexpr bool PERM = true, AFTER_DRAIN = false;
  bf16_t* qf; bf16_t* kf; bf16_t* vf; bf16_t* u;
  __device__ __forceinline__ void operator()(const f32x4 (&acc)[2][2][4][2], const pg8::Unit& un, int wr, int wc, int fr, int fq) const {
    const int row0 = un.pm * 256 + wr * 64 + fr, colt = un.pn * 256, col0 = colt + wc * 32 + 8 * fq;
#pragma unroll
    for (int ai = 0; ai < 2; ++ai)
#pragma unroll
      for (int m = 0; m < 4; ++m) {
        const int row = row0 + ai * 128 + m * 16;
        const int b = row >> 13, t = row & (SEQ - 1), blk = t >> 5, kk = t & 31;
#pragma unroll
        for (int bj = 0; bj < 2; ++bj) {
          const int col = col0 + bj * 128;
          if (colt >= 1024) *(u32x4*)(u + (size_t)row * 512 + (col - 1024)) = pack8(acc[ai][bj][m][0], acc[ai][bj][m][1]);
          else {
            const bool isk = colt >= 512;
            const int cc = col & 511, h = cc >> 6, d0 = cc & 63, s = d0 >> 4, h2 = (d0 >> 3) & 1;
            const int r = isk ? (8 * ((kk >> 2) & 3) + 4 * (kk >> 4) + (kk & 3)) : kk;
            const size_t idx = (((((size_t)((b * 8 + h) * 256 + blk)) * 4 + s) * 2 + h2) * 32 + r) * 8;
            *(u32x4*)((isk ? kf : qf) + idx) = pack8(acc[ai][bj][m][0], acc[ai][bj][m][1]);
          }
        }
      }
  }
};
struct GEpiVT {
  static constexpr bool PERM = true, AFTER_DRAIN = false;
  bf16_t* vf;
  __device__ __forceinline__ void operator()(const f32x4 (&acc)[2][2][4][2], const pg8::Unit& un, int wr, int wc, int fr, int fq) const {
    const int row0 = un.pm * 256 + wr * 64 + fr, col0 = un.pn * 256 + wc * 32 + 8 * fq;
#pragma unroll
    for (int ai = 0; ai < 2; ++ai)
#pragma unroll
      for (int m = 0; m < 4; ++m) {
        const int vc = row0 + ai * 128 + m * 16, h = vc >> 6, d0 = vc & 63, mb = d0 >> 5, c0 = d0 & 31;
#pragma unroll
        for (int bj = 0; bj < 2; ++bj) {
          const int tokn = col0 + bj * 128, b = tokn >> 13, t = tokn & (SEQ - 1), blk = t >> 5, kk = t & 31, hk = kk >> 4, s2 = (kk >> 3) & 1;
          *(u32x4*)(vf + ((((((size_t)((b * 8 + h) * 256 + blk)) * 2 + mb) * 2 + s2) * 2 + hk) * 32 + c0) * 8) = pack8(acc[ai][bj][m][0], acc[ai][bj][m][1]);
        }
      }
  }
};
struct GEpiGlu {
  static constexpr bool PERM = true, AFTER_DRAIN = false;
  const bf16_t* y; const float* b; bf16_t* mix;
  __device__ __forceinline__ void operator()(const f32x4 (&acc)[2][2][4][2], const pg8::Unit& un, int wr, int wc, int fr, int fq) const {
    const int row0 = un.pm * 256 + wr * 64 + fr, col0 = un.pn * 256 + wc * 32 + 8 * fq;
#pragma unroll
    for (int bj = 0; bj < 2; ++bj) {
      const int col = col0 + bj * 128;
      const f32x4 b0 = *(const f32x4*)(b + col), b1 = *(const f32x4*)(b + col + 4);
#pragma unroll
      for (int ai = 0; ai < 2; ++ai)
#pragma unroll
        for (int m = 0; m < 4; ++m) {
          const int row = row0 + ai * 128 + m * 16;
          const u32x4 yv = *(const u32x4*)(y + (size_t)row * 512 + col);
          f32x4 g0 = acc[ai][bj][m][0] + b0, g1 = acc[ai][bj][m][1] + b1, o0, o1;
          o0[0] = bflo(yv.x) * sigmoidf_(g0[0]); o0[1] = bfhi(yv.x) * sigmoidf_(g0[1]);
          o0[2] = bflo(yv.y) * sigmoidf_(g0[2]); o0[3] = bfhi(yv.y) * sigmoidf_(g0[3]);
          o1[0] = bflo(yv.z) * sigmoidf_(g1[0]); o1[1] = bfhi(yv.z) * sigmoidf_(g1[1]);
          o1[2] = bflo(yv.w) * sigmoidf_(g1[2]); o1[3] = bfhi(yv.w) * sigmoidf_(g1[3]);
#if defined(DBG_GLU) && DBG_GLU == 1
          o0[0] = bflo(yv.x); o0[1] = bfhi(yv.x); o0[2] = bflo(yv.y); o0[3] = bfhi(yv.y); o1[0] = bflo(yv.z); o1[1] = bfhi(yv.z); o1[2] = bflo(yv.w); o1[3] = bfhi(yv.w);
#elif defined(DBG_GLU) && DBG_GLU == 2
          o0 = acc[ai][bj][m][0]; o1 = acc[ai][bj][m][1];
#endif
          *(u32x4*)(mix + (size_t)row * 1024 + 512 + col) = pack8(o0, o1);
        }
    }
  }
};
struct GEpiRes {
  static constexpr bool PERM = false, AFTER_DRAIN = false;
  const float* base; float* h;
  __device__ __forceinline__ void operator()(const f32x4 (&acc)[2][2][4][2], const pg8::Unit& un, int wr, int wc, int fr, int fq) const {
    const int row0 = un.pm * 256 + wr * 64 + fr, col0 = un.pn * 256 + wc * 32 + 4 * fq;
#pragma unroll
    for (int ai = 0; ai < 2; ++ai)
#pragma unroll
      for (int m = 0; m < 4; ++m) {
        const size_t off = (size_t)(row0 + ai * 128 + m * 16) * 1024 + col0;
#pragma unroll
        for (int bj = 0; bj < 2; ++bj)
#pragma unroll
          for (int n = 0; n < 2; ++n) {
            const f32x4 bs = *(const f32x4*)(base + off + bj * 128 + n * 16);
            *(f32x4*)(h + off + bj * 128 + n * 16) = bs + acc[ai][bj][m][n];
          }
      }
  }
};
struct GEpiBf16 {
  static constexpr bool PERM = true, AFTER_DRAIN = false;
  bf16_t* o; int ld;
  __device__ __forceinline__ void operator()(const f32x4 (&acc)[2][2][4][2], const pg8::Unit& un, int wr, int wc, int fr, int fq) const {
    const int row0 = un.pm * 256 + wr * 64 + fr, col0 = un.pn * 256 + wc * 32 + 8 * fq;
#pragma unroll
    for (int ai = 0; ai < 2; ++ai)
#pragma unroll
      for (int m = 0; m < 4; ++m) {
        bf16_t* rowp = o + (size_t)(row0 + ai * 128 + m * 16) * ld + col0;
#pragma unroll
        for (int bj = 0; bj < 2; ++bj) *(u32x4*)(rowp + bj * 128) = pack8(acc[ai][bj][m][0], acc[ai][bj][m][1]);
      }
  }
};

struct GEpiResN {
  static constexpr bool PERM = false, AFTER_DRAIN = false;
  const float* base; float* h; bf16_t* hb; float* ss;
  __device__ __forceinline__ void operator()(const f32x4 (&acc)[2][2][4][2], const pg8::Unit& un, int wr, int wc, int fr, int fq) const {
    const int row0 = un.pm * 256 + wr * 64 + fr, col0 = un.pn * 256 + wc * 32 + 4 * fq;
#pragma unroll
    for (int ai = 0; ai < 2; ++ai)
#pragma unroll
      for (int m = 0; m < 4; ++m) {
        const int row = row0 + ai * 128 + m * 16;
        const size_t off = (size_t)row * 1024 + col0;
        float s = 0.f;
#pragma unroll
        for (int bj = 0; bj < 2; ++bj)
#pragma unroll
          for (int n = 0; n < 2; ++n) {
            const f32x4 v = *(const f32x4*)(base + off + bj * 128 + n * 16) + acc[ai][bj][m][n];
            *(f32x4*)(h + off + bj * 128 + n * 16) = v;
            s += (v[0] * v[0] + v[1] * v[1]) + (v[2] * v[2] + v[3] * v[3]);
            uint2 pk; pk.x = pg8::cvt_pk_bf16(v[0], v[1]); pk.y = pg8::cvt_pk_bf16(v[2], v[3]);
            *(uint2*)(hb + off + bj * 128 + n * 16) = pk;
          }
        s += __shfl_xor(s, 16); s += __shfl_xor(s, 32);
        if (fq == 0) (void)__hip_atomic_fetch_add(ss + row, s, __ATOMIC_RELAXED, __HIP_MEMORY_SCOPE_AGENT);
      }
  }
};

template <bool BASE_BF16>
struct GEpiResB {
  static constexpr bool PERM = true, AFTER_DRAIN = false;
  const void* base; bf16_t* hb; float* ss;
  __device__ __forceinline__ void operator()(const f32x4 (&acc)[2][2][4][2], const pg8::Unit& un, int wr, int wc, int fr, int fq) const {
    const int row0 = un.pm * 256 + wr * 64 + fr, col0 = un.pn * 256 + wc * 32 + 8 * fq;
#pragma unroll
    for (int ai = 0; ai < 2; ++ai)
#pragma unroll
      for (int m = 0; m < 4; ++m) {
        const int row = row0 + ai * 128 + m * 16;
        const size_t off = (size_t)row * 1024 + col0;
        float s = 0.f;
#pragma unroll
        for (int bj = 0; bj < 2; ++bj) {
          f32x4 b0, b1;
          if (BASE_BF16) { const u32x4 t = *(const u32x4*)((const bf16_t*)base + off + bj * 128); b0[0] = bflo(t[0]); b0[1] = bfhi(t[0]); b0[2] = bflo(t[1]); b0[3] = bfhi(t[1]); b1[0] = bflo(t[2]); b1[1] = bfhi(t[2]); b1[2] = bflo(t[3]); b1[3] = bfhi(t[3]); }
          else { b0 = *(const f32x4*)((const float*)base + off + bj * 128); b1 = *(const f32x4*)((const float*)base + off + bj * 128 + 4); }
          const f32x4 v0 = b0 + acc[ai][bj][m][0], v1 = b1 + acc[ai][bj][m][1];
          s += (v0[0] * v0[0] + v0[1] * v0[1]) + (v0[2] * v0[2] + v0[3] * v0[3]) + (v1[0] * v1[0] + v1[1] * v1[1]) + (v1[2] * v1[2] + v1[3] * v1[3]);
          *(u32x4*)(hb + off + bj * 128) = pack8(v0, v1);
        }
        s += __shfl_xor(s, 16); s += __shfl_xor(s, 32);
        if (fq == 0) (void)__hip_atomic_fetch_add(ss + row, s, __ATOMIC_RELAXED, __HIP_MEMORY_SCOPE_AGENT);
      }
  }
};
struct GEpiBf16S {
  static constexpr bool PERM = true, AFTER_DRAIN = false;
  bf16_t* o; int ld; const float* ss;
  __device__ __forceinline__ void operator()(const f32x4 (&acc)[2][2][4][2], const pg8::Unit& un, int wr, int wc, int fr, int fq) const {
    const int row0 = un.pm * 256 + wr * 64 + fr, col0 = un.pn * 256 + wc * 32 + 8 * fq;
#pragma unroll
    for (int ai = 0; ai < 2; ++ai)
#pragma unroll
      for (int m = 0; m < 4; ++m) {
        const int row = row0 + ai * 128 + m * 16;
        const float rs = rsqrtf(ss[row] * (1.0f / 1024.f) + 1e-6f);
        bf16_t* rowp = o + (size_t)row * ld + col0;
#pragma unroll
        for (int bj = 0; bj < 2; ++bj) *(u32x4*)(rowp + bj * 128) = pack8(acc[ai][bj][m][0] * rs, acc[ai][bj][m][1] * rs);
      }
  }
};
template <class Epi>
__device__ __forceinline__ void run_gemm(unsigned char* lds, const bf16_t* A, const bf16_t* Bt, int M, int N, int K, int c, const Epi& E) {
  pg8::Gemm g{A, Bt, M, N, K}; pg8::StaticOrder S; S.init(M, N, (int)gridDim.x, c);
  pg8::gemm_phase<Epi, pg8::StaticOrder, false>((PG8_LAS unsigned char*)lds, g, S, E, nullptr);
}

struct GEpiGluN {
  static constexpr bool PERM = true, AFTER_DRAIN = true;
  const bf16_t* y; const float* b; bf16_t* mix; const float* gs; float* ss3; unsigned* cnt;
  __device__ __forceinline__ void fused(f32x4 (&acc)[2][2][4][2], const pg8::Unit& un, int wr, int wc, int fr, int fq, PG8_LAS unsigned char* lds, int wid, int lane) const {
    const int row0 = un.pm * 256 + wr * 64 + fr, col0 = un.pn * 256 + wc * 32 + 8 * fq;
#pragma unroll
    for (int ai = 0; ai < 2; ++ai)
#pragma unroll
      for (int m = 0; m < 4; ++m) {
        const int row = row0 + ai * 128 + m * 16;
        float s = 0.f;
#pragma unroll
        for (int bj = 0; bj < 2; ++bj) {
          const int col = col0 + bj * 128;
          const f32x4 b0 = *(const f32x4*)(b + col), b1 = *(const f32x4*)(b + col + 4);
          const u32x4 yv = *(const u32x4*)(y + (size_t)row * 512 + col);
          const f32x4 g0 = acc[ai][bj][m][0] + b0, g1 = acc[ai][bj][m][1] + b1;
          f32x4 o0, o1;
          o0[0] = bflo(yv.x) * sigmoidf_(g0[0]); o0[1] = bfhi(yv.x) * sigmoidf_(g0[1]); o0[2] = bflo(yv.y) * sigmoidf_(g0[2]); o0[3] = bfhi(yv.y) * sigmoidf_(g0[3]);
          o1[0] = bflo(yv.z) * sigmoidf_(g1[0]); o1[1] = bfhi(yv.z) * sigmoidf_(g1[1]); o1[2] = bflo(yv.w) * sigmoidf_(g1[2]); o1[3] = bfhi(yv.w) * sigmoidf_(g1[3]);
          acc[ai][bj][m][0] = o0; acc[ai][bj][m][1] = o1;
          s += (o0[0] * o0[0] + o0[1] * o0[1]) + (o0[2] * o0[2] + o0[3] * o0[3]) + (o1[0] * o1[0] + o1[1] * o1[1]) + (o1[2] * o1[2] + o1[3] * o1[3]);
        }
        s += __shfl_xor(s, 16); s += __shfl_xor(s, 32);
        if (fq == 0) (void)__hip_atomic_fetch_add(ss3 + row, s, __ATOMIC_RELAXED, __HIP_MEMORY_SCOPE_AGENT);
      }
    asm volatile("s_waitcnt vmcnt(0)" ::: "memory");
    __syncthreads();
    if (threadIdx.x == 0) {
      unsigned* c = cnt + 64 * un.pm;
      (void)__hip_atomic_fetch_add(c, 1u, __ATOMIC_RELAXED, __HIP_MEMORY_SCOPE_AGENT);
      unsigned spins = 0;
      while (__hip_atomic_load(c, __ATOMIC_RELAXED, __HIP_MEMORY_SCOPE_AGENT) < 2u) { __builtin_amdgcn_s_sleep(1); if (++spins > (1u << 22)) break; }
    }
    __syncthreads();
#pragma unroll
    for (int ai = 0; ai < 2; ++ai)
#pragma unroll
      for (int m = 0; m < 4; ++m) {
        const int row = row0 + ai * 128 + m * 16;
        const float rs = rsqrtf(__hip_atomic_load(ss3 + row, __ATOMIC_RELAXED, __HIP_MEMORY_SCOPE_AGENT) * (1.0f / 512.f) + 1e-6f);
#pragma unroll
        for (int bj = 0; bj < 2; ++bj) {
          const int col = col0 + bj * 128;
          const f32x4 q0 = *(const f32x4*)(gs + col), q1 = *(const f32x4*)(gs + col + 4);
          *(u32x4*)(mix + (size_t)row * 1024 + 512 + col) = pack8(acc[ai][bj][m][0] * rs * q0, acc[ai][bj][m][1] * rs * q1);
        }
      }
  }
};
template <class Epi>
__device__ __forceinline__ void run_gemm_nc(unsigned char* lds, const bf16_t* A, const bf16_t* Bt, int M, int N, int K, int c, const Epi& E) {
  pg8::Gemm g{A, Bt, M, N, K}; pg8::StaticOrder S; S.init(M, N, (int)gridDim.x, c);
  pg8::gemm_phase<Epi, pg8::StaticOrder, false>((PG8_LAS unsigned char*)lds, g, S, E, nullptr);
}

__device__ void prep_transpose_tile(const float* __restrict__ W, int K, int N, bf16_t* __restrict__ Wt, int tk, int tn, bf16_t* tile, const float* __restrict__ gk) {
  const int t = threadIdx.x;
  {
    const int k = t >> 3, n8 = (t & 7) * 8;
    const float* src = W + (size_t)(tk * 64 + k) * N + tn * 64 + n8;
    float4 a = *(const float4*)src, b = *(const float4*)(src + 4);
    if (gk) { const float gg = gk[tk * 64 + k]; a.x *= gg; a.y *= gg; a.z *= gg; a.w *= gg; b.x *= gg; b.y *= gg; b.z *= gg; b.w *= gg; }
    bf16_t* d = tile + k * 66 + n8;
    d[0] = f2bf(a.x); d[1] = f2bf(a.y); d[2] = f2bf(a.z); d[3] = f2bf(a.w);
    d[4] = f2bf(b.x); d[5] = f2bf(b.y); d[6] = f2bf(b.z); d[7] = f2bf(b.w);
  }
  __syncthreads();
  {
    const int n = t >> 3, k8 = (t & 7) * 8;
    const bf16_t* s = tile + k8 * 66 + n;
    uint4 o;
    o.x = (unsigned)s[0] | ((unsigned)s[66] << 16); o.y = (unsigned)s[2 * 66] | ((unsigned)s[3 * 66] << 16);
    o.z = (unsigned)s[4 * 66] | ((unsigned)s[5 * 66] << 16); o.w = (unsigned)s[6 * 66] | ((unsigned)s[7 * 66] << 16);
    *(uint4*)(Wt + (size_t)(tn * 64 + n) * K + tk * 64 + k8) = o;
  }
  __syncthreads();
}
__device__ void prep_mat(const float* __restrict__ W, int K, int N, bf16_t* __restrict__ Wt, bf16_t* tile, int rot, const float* __restrict__ gk = nullptr) {
  const int ntn = N / 64, total = (K / 64) * ntn;
  for (int tix = (blockIdx.x + rot) % gridDim.x; tix < total; tix += gridDim.x) prep_transpose_tile(W, K, N, Wt, tix / ntn, tix % ntn, tile, gk);
}
__device__ void prep_cvt_bf16(const float* __restrict__ src, bf16_t* __restrict__ dst, size_t n) {
  for (size_t i = ((size_t)blockIdx.x * NTHR + threadIdx.x) * 8; i < n; i += (size_t)gridDim.x * NTHR * 8) {
    const float4 a = *(const float4*)(src + i), b = *(const float4*)(src + i + 4);
    uint4 o;
    o.x = (unsigned)f2bf(a.x) | ((unsigned)f2bf(a.y) << 16); o.y = (unsigned)f2bf(a.z) | ((unsigned)f2bf(a.w) << 16);
    o.z = (unsigned)f2bf(b.x) | ((unsigned)f2bf(b.y) << 16); o.w = (unsigned)f2bf(b.z) | ((unsigned)f2bf(b.w) << 16);
    *(uint4*)(dst + i) = o;
  }
}

struct TileSrc { const float* W; bf16_t* Wt; const float* gk; int K, N, r, swp; };
__device__ __forceinline__ TileSrc tile_decode(int tix) {
  TileSrc t; t.swp = 0;
  if (tix < 512)       { t.W = KP(I_w_in);  t.Wt = WSP(bf16_t, O_WIN);  t.gk = nullptr;        t.K = 1024; t.N = 2048; t.r = tix; t.swp = 1; }
  else if (tix < 576)  { t.W = KP(I_w_glu); t.Wt = WSP(bf16_t, O_WGLU); t.gk = nullptr;        t.K = 512;  t.N = 512;  t.r = tix - 512; }
  else if (tix < 832)  { t.W = KP(I_w_out); t.Wt = WSP(bf16_t, O_WOUT); t.gk = nullptr;        t.K = 1024; t.N = 1024; t.r = tix - 576; }
  else if (tix < 1088) { t.W = KP(I_w_xq);  t.Wt = WSP(bf16_t, O_WXQ);  t.gk = KP(I_g_xattn);  t.K = 1024; t.N = 1024; t.r = tix - 832; }
  else if (tix < 1600) { t.W = KP(I_w_xkv); t.Wt = WSP(bf16_t, O_WXKV); t.gk = nullptr;        t.K = 1024; t.N = 2048; t.r = tix - 1088; }
  else if (tix < 1856) { t.W = KP(I_w_xo);  t.Wt = WSP(bf16_t, O_WXO);  t.gk = nullptr;        t.K = 1024; t.N = 1024; t.r = tix - 1600; }
  else                 { t.W = KP(I_w_pq);  t.Wt = WSP(bf16_t, O_WPQ);  t.gk = KP(I_g_ffn);    t.K = 1024; t.N = 2048; t.r = tix - 1856; }
  return t;
}
#define PREP_NTILES 2368
template <int MODE>
__device__ __forceinline__ int prep_tile_map(int i) {
  if (MODE == 0) return i < 832 ? i : i + 256;
  return i < 256 ? 832 + i : (i < 512 ? 1600 + (i - 256) : 1856 + (i - 512));
}
template <int MODE>
__device__ void prep_weights(unsigned char* lds, int wg, int G) {
  constexpr int NT = MODE == 0 ? 1344 : 1024;
  const int t = threadIdx.x, k = t >> 3, n8 = (t & 7) * 8, n = t >> 3, k8 = (t & 7) * 8;
  int tix = wg;
  if (tix >= NT) return;
  float4 a0, b0, a1, b1; float g0, g1 = 1.0f;
  TileSrc c0 = tile_decode(prep_tile_map<MODE>(tix)), c1 = c0;
  {
    const int ntn = c0.N / 64, tk = c0.r / ntn, tn = c0.r % ntn;
    const float* src = c0.W + (size_t)(tk * 64 + k) * c0.N + tn * 64 + n8;
    a0 = *(const float4*)src; b0 = *(const float4*)(src + 4); g0 = c0.gk ? c0.gk[tk * 64 + k] : 1.0f;
  }
  bool have1 = tix + G < NT;
  a1 = a0; b1 = b0;
  if (have1) {
    c1 = tile_decode(prep_tile_map<MODE>(tix + G));
    const int ntn = c1.N / 64, tk = c1.r / ntn, tn = c1.r % ntn;
    const float* src = c1.W + (size_t)(tk * 64 + k) * c1.N + tn * 64 + n8;
    a1 = *(const float4*)src; b1 = *(const float4*)(src + 4); g1 = c1.gk ? c1.gk[tk * 64 + k] : 1.0f;
  }
  int buf = 0;
  for (;;) {
    bf16_t* tile = (bf16_t*)(lds + buf * 8704);
    {
      bf16_t* d = tile + k * 66 + n8;
      d[0] = f2bf(a0.x * g0); d[1] = f2bf(a0.y * g0); d[2] = f2bf(a0.z * g0); d[3] = f2bf(a0.w * g0);
      d[4] = f2bf(b0.x * g0); d[5] = f2bf(b0.y * g0); d[6] = f2bf(b0.z * g0); d[7] = f2bf(b0.w * g0);
    }
    const int ntn = c0.N / 64, tk = c0.r / ntn, tn = c0.r % ntn;
    const int tnd = (c0.swp && tn >= 16) ? (tn ^ 8) : tn;
    bf16_t* dst = c0.Wt + (size_t)(tnd * 64 + n) * c0.K + tk * 64 + k8;
    const bool more = have1;
    a0 = a1; b0 = b1; g0 = g1; c0 = c1;
    have1 = tix + 2 * G < NT;
    if (have1) {
      c1 = tile_decode(prep_tile_map<MODE>(tix + 2 * G));
      const int ntn2 = c1.N / 64, tk2 = c1.r / ntn2, tn2 = c1.r % ntn2;
      const float* src = c1.W + (size_t)(tk2 * 64 + k) * c1.N + tn2 * 64 + n8;
      a1 = *(const float4*)src; b1 = *(const float4*)(src + 4); g1 = c1.gk ? c1.gk[tk2 * 64 + k] : 1.0f;
    }
    __syncthreads();
    {
      const bf16_t* s = tile + k8 * 66 + n;
      uint4 o;
      o.x = (unsigned)s[0] | ((unsigned)s[66] << 16); o.y = (unsigned)s[2 * 66] | ((unsigned)s[3 * 66] << 16);
      o.z = (unsigned)s[4 * 66] | ((unsigned)s[5 * 66] << 16); o.w = (unsigned)s[6 * 66] | ((unsigned)s[7 * 66] << 16);
      *(uint4*)dst = o;
    }
    if (!more) break;
    tix += G; buf ^= 1;
  }
  __syncthreads();
}
__device__ void prep_rmsnorm(const float* __restrict__ x, const float* __restrict__ g, bf16_t* __restrict__ out, int rows) {
  const int lane = threadIdx.x & 63;
  float4 gv[4];
#pragma unroll
  for (int i = 0; i < 4; ++i) gv[i] = *(const float4*)(g + 256 * i + 4 * lane);
#pragma unroll 2
  for (int row = blockIdx.x * NWAVE + (threadIdx.x >> 6); row < rows; row += gridDim.x * NWAVE) {
    const float* xr = x + (size_t)row * 1024;
    f32x4 v[4]; float ss = 0.f;
#pragma unroll
    for (int i = 0; i < 4; ++i) { v[i] = __builtin_nontemporal_load((const f32x4*)(xr + 256 * i + 4 * lane)); ss += v[i][0] * v[i][0] + v[i][1] * v[i][1] + v[i][2] * v[i][2] + v[i][3] * v[i][3]; }
    ss = wave_sum(ss);
    const float r = rsqrtf(ss / 1024.f + 1e-6f);
#pragma unroll
    for (int i = 0; i < 4; ++i) {
      uint2 o; o.x = pg8::cvt_pk_bf16(v[i][0] * r * gv[i].x, v[i][1] * r * gv[i].y); o.y = pg8::cvt_pk_bf16(v[i][2] * r * gv[i].z, v[i][3] * r * gv[i].w);
      *(uint2*)(out + (size_t)row * 1024 + 256 * i + 4 * lane) = o;
    }
  }
}

typedef short bf16x8 __attribute__((ext_vector_type(8)));
typedef float f32x16 __attribute__((ext_vector_type(16)));
#define SSM_L 128
#define SSM_ROWB 528
#define SSM_WBUF (32 * SSM_ROWB)
struct SsmC { float2* lam; float2* lamL; bf16_t* Bbar; bf16_t* CmT; float2* E; };

struct SsmIn { const float *a_re, *a_im, *log_dt, *b_re, *b_im, *c_re, *c_im; };
__device__ void prep_ssm(const SsmIn P, const SsmC C) {
  for (int w = threadIdx.x * gridDim.x + blockIdx.x; w < 32768; w += NTHR * gridDim.x) {
    const int idx = w >> 4, c = w & 15, g = idx >> 6, p = idx & 63;
    const double are = P.a_re[idx], aim = P.a_im[idx], dt = exp((double)P.log_dt[g]);
    double er = exp(are * dt), sn, cs; sincos(aim * dt, &sn, &cs);
    const double lbr = er * cs, lbi = er * sn;
    if (c == 0) {
      C.lam[idx] = make_float2((float)lbr, (float)lbi);
      er = exp(are * dt * SSM_L); sincos(aim * dt * SSM_L, &sn, &cs);
      C.lamL[idx] = make_float2((float)(er * cs), (float)(er * sn));
    }
    const double nr = lbr - 1.0, ni = lbi, den = are * are + aim * aim;
    const double cr = (nr * are + ni * aim) / den, ci = (ni * are - nr * aim) / den;
    const double br = P.b_re[idx * 16 + c], bi = P.b_im[idx * 16 + c];
    C.Bbar[(g * 128 + 2 * p) * 16 + c] = f2bf((float)(cr * br - ci * bi));
    C.Bbar[(g * 128 + 2 * p + 1) * 16 + c] = f2bf((float)(cr * bi + ci * br));
    C.CmT[(g * 16 + c) * 128 + 2 * p] = f2bf(P.c_re[(g * 16 + c) * 64 + p]);
    C.CmT[(g * 16 + c) * 128 + 2 * p + 1] = f2bf(-P.c_im[(g * 16 + c) * 64 + p]);
  }
}

template <bool PASS2>
__device__ void ph_ssm(const float* __restrict__ d_skip, const bf16_t* __restrict__ U16, const SsmC C, bf16_t* __restrict__ Y, unsigned char* lds) {
  const int wv = threadIdx.x >> 6, lane = threadIdx.x & 63;
  unsigned char* buf = lds + wv * SSM_WBUF;
  const int nw = gridDim.x * NWAVE;
  for (int u = blockIdx.x * NWAVE + wv; u < 4096; u += nw) {
    const int g = u & 31, bj = u >> 5, j = bj & 63, b = bj >> 6;
    const float2 lm = C.lam[g * 64 + lane];
    bf16x8 Bf[4];
#pragma unroll
    for (int nt = 0; nt < 4; ++nt) Bf[nt] = *(const bf16x8*)(C.Bbar + (g * 128 + 32 * nt + (lane & 31)) * 16 + 8 * (lane >> 5));
    float xr = 0.f, xi = 0.f;
    bf16x8 Cf[4]; f32x4 dsk;
    if (PASS2) {
      const float2 lL = C.lamL[g * 64 + lane];
      const float2* Eb = C.E + ((size_t)(b * 32 + g) * 64) * 64 + lane;
      for (int i0 = 0; i0 < j; i0 += 16) {
        float2 e[16];
#pragma unroll
        for (int q = 0; q < 16; ++q) { const int i = (i0 + q < j) ? i0 + q : j - 1; e[q] = Eb[i * 64]; }
#pragma unroll
        for (int q = 0; q < 16; ++q) {
          if (i0 + q < j) { const float nxr = lL.x * xr - lL.y * xi + e[q].x, nxi = lL.x * xi + lL.y * xr + e[q].y; xr = nxr; xi = nxi; }
        }
      }
#pragma unroll
      for (int s = 0; s < 4; ++s) Cf[s] = *(const bf16x8*)(C.CmT + (g * 16 + (lane & 15)) * 128 + 32 * s + 8 * (lane >> 4));
      dsk = *(const f32x4*)(d_skip + g * 16 + 4 * (lane >> 4));
    }
    for (int sub = 0; sub < 4; ++sub) {
      const int tok0 = b * SEQ + j * SSM_L + sub * 32;
      const bf16x8 af = *(const bf16x8*)(U16 + (size_t)(tok0 + (lane & 31)) * 512 + g * 16 + 8 * (lane >> 5));
      wave_lds_sync();
#pragma unroll
      for (int nt = 0; nt < 4; ++nt) {
        f32x16 acc;
#pragma unroll
        for (int i = 0; i < 16; ++i) acc[i] = 0.f;
        acc = __builtin_amdgcn_mfma_f32_32x32x16_bf16(af, Bf[nt], acc, 0, 0, 0);
#pragma unroll
        for (int i = 0; i < 16; ++i) {
          const int r = (i & 3) + 8 * (i >> 2) + 4 * (lane >> 5);
          *(float*)(buf + r * SSM_ROWB + (32 * nt + (lane & 31)) * 4) = acc[i];
        }
      }
      wave_lds_sync();
#pragma unroll 1
      for (int t0 = 0; t0 < 32; t0 += 8) {
        float2 bu[8];
#pragma unroll
        for (int q = 0; q < 8; ++q) bu[q] = *(const float2*)(buf + (t0 + q) * SSM_ROWB + lane * 8);
        unsigned xo[8];
#pragma unroll
        for (int q = 0; q < 8; ++q) {
          const float nxr = lm.x * xr - lm.y * xi + bu[q].x, nxi = lm.x * xi + lm.y * xr + bu[q].y;
          xr = nxr; xi = nxi;
          xo[q] = pg8::cvt_pk_bf16(xr, xi);
        }
        if (PASS2) {
          asm volatile("" ::: "memory");
#pragma unroll
          for (int q = 0; q < 8; ++q) *(unsigned*)(buf + (t0 + q) * SSM_ROWB + lane * 4) = xo[q];
        }
      }
      if (PASS2) {
        wave_lds_sync();
#pragma unroll
        for (int mt = 0; mt < 2; ++mt) {
          f32x4 ya = {0.f, 0.f, 0.f, 0.f};
#pragma unroll
          for (int s = 0; s < 4; ++s) {
            const bf16x8 xf = *(const bf16x8*)(buf + (16 * mt + (lane & 15)) * SSM_ROWB + (32 * s + 8 * (lane >> 4)) * 2);
            ya = __builtin_amdgcn_mfma_f32_16x16x32_bf16(Cf[s], xf, ya, 0, 0, 0);
          }
          const size_t off = (size_t)(tok0 + 16 * mt + (lane & 15)) * 512 + g * 16 + 4 * (lane >> 4);
          const uint2 uv = *(const uint2*)(U16 + off);
          const float y0 = gelu_tanh(ya[0] + dsk[0] * bflo(uv.x)), y1 = gelu_tanh(ya[1] + dsk[1] * bfhi(uv.x));
          const float y2 = gelu_tanh(ya[2] + dsk[2] * bflo(uv.y)), y3 = gelu_tanh(ya[3] + dsk[3] * bfhi(uv.y));
#if defined(DBG_FLUSH) && DBG_FLUSH == 1
          const float y0f = fabsf(y0) < 1e-30f ? 0.f : y0, y1f = fabsf(y1) < 1e-30f ? 0.f : y1, y2f = fabsf(y2) < 1e-30f ? 0.f : y2, y3f = fabsf(y3) < 1e-30f ? 0.f : y3;
          uint2 o; o.x = (unsigned)f2bf(y0f) | ((unsigned)f2bf(y1f) << 16); o.y = (unsigned)f2bf(y2f) | ((unsigned)f2bf(y3f) << 16);
#else
          uint2 o; o.x = (unsigned)f2bf(y0) | ((unsigned)f2bf(y1) << 16); o.y = (unsigned)f2bf(y2) | ((unsigned)f2bf(y3) << 16);
#endif
          *(uint2*)(Y + off) = o;
        }
      }
    }
    if (!PASS2) C.E[((size_t)(b * 32 + g) * 64 + j) * 64 + lane] = make_float2(xr, xi);
  }
}

typedef __bf16 bf16x2_t __attribute__((ext_vector_type(2)));
__device__ __forceinline__ float dot2bf(unsigned a, unsigned b, float c) {
  return __builtin_amdgcn_fdot2_f32_bf16(__builtin_bit_cast(bf16x2_t, a), __builtin_bit_cast(bf16x2_t, b), c, false);
}
__device__ void ph_gather(const bf16_t* __restrict__ HN, const int* __restrict__ EXP, const float* __restrict__ GATE,
                          const bf16_t* __restrict__ PU, const bf16_t* __restrict__ PV, const float* __restrict__ gfin,
                          float* __restrict__ H) {
  const int lane = threadIdx.x & 63;
  const int nw = gridDim.x * NWAVE;
  const int kk = lane >> 3;
  for (int tok = __builtin_amdgcn_readfirstlane(blockIdx.x * NWAVE + (threadIdx.x >> 6)); tok < NTOK; tok += nw) {
    const uint4 h0 = *(const uint4*)(HN + (size_t)tok * 1024 + 8 * lane), h1 = *(const uint4*)(HN + (size_t)tok * 1024 + 512 + 8 * lane);
    float acc[16];
#pragma unroll
    for (int i = 0; i < 16; ++i) acc[i] = 0.f;
    const int* ep = EXP + (size_t)tok * 128;
    const float* gp = GATE + (size_t)tok * 128;
    for (int bt = 0; bt < 16; ++bt) {
      int e[8];
#pragma unroll
      for (int k = 0; k < 8; ++k) e[k] = __builtin_amdgcn_readfirstlane(ep[bt * 8 + k]);
      const float gk = gp[bt * 8 + kk];
      uint4 u0[8], u1[8];
#pragma unroll
      for (int k = 0; k < 8; ++k) {
        const bf16_t* r = PU + (size_t)e[k] * 1024 + 8 * lane;
        u0[k] = *(const uint4*)r; u1[k] = *(const uint4*)(r + 512);
      }
      uint4 v0[8], v1[8];
#pragma unroll
      for (int k = 0; k < 8; ++k) {
        const bf16_t* r = PV + (size_t)e[k] * 1024 + 8 * lane;
        v0[k] = *(const uint4*)r; v1[k] = *(const uint4*)(r + 512);
      }
      float d[8];
#pragma unroll
      for (int k = 0; k < 8; ++k) {
        float s = dot2bf(h0.x, u0[k].x, 0.f); s = dot2bf(h0.y, u0[k].y, s); s = dot2bf(h0.z, u0[k].z, s); s = dot2bf(h0.w, u0[k].w, s);
        s = dot2bf(h1.x, u1[k].x, s); s = dot2bf(h1.y, u1[k].y, s); s = dot2bf(h1.z, u1[k].z, s); s = dot2bf(h1.w, u1[k].w, s);
        d[k] = s;
      }
      const bool b5 = lane & 32, b4 = lane & 16, b3 = lane & 8;
      float r4[4];
#pragma unroll
      for (int k = 0; k < 4; ++k) { const float keep = b5 ? d[k + 4] : d[k], send = b5 ? d[k] : d[k + 4]; r4[k] = keep + __shfl_xor(send, 32); }
      float r2[2];
#pragma unroll
      for (int k = 0; k < 2; ++k) { const float keep = b4 ? r4[k + 2] : r4[k], send = b4 ? r4[k] : r4[k + 2]; r2[k] = keep + __shfl_xor(send, 16); }
      float r1;
      { const float keep = b3 ? r2[1] : r2[0], send = b3 ? r2[0] : r2[1]; r1 = keep + __shfl_xor(send, 8); }
      r1 += __shfl_xor(r1, 4); r1 += __shfl_xor(r1, 2); r1 += __shfl_xor(r1, 1);
      const float wl = gk * gelu_tanh(r1);
#pragma unroll
      for (int k = 0; k < 8; ++k) {
        const float w = __shfl(wl, 8 * k);
        acc[0] += w * bflo(v0[k].x); acc[1] += w * bfhi(v0[k].x); acc[2] += w * bflo(v0[k].y); acc[3] += w * bfhi(v0[k].y);
        acc[4] += w * bflo(v0[k].z); acc[5] += w * bfhi(v0[k].z); acc[6] += w * bflo(v0[k].w); acc[7] += w * bfhi(v0[k].w);
        acc[8] += w * bflo(v1[k].x); acc[9] += w * bfhi(v1[k].x); acc[10] += w * bflo(v1[k].y); acc[11] += w * bfhi(v1[k].y);
        acc[12] += w * bflo(v1[k].z); acc[13] += w * bfhi(v1[k].z); acc[14] += w * bflo(v1[k].w); acc[15] += w * bfhi(v1[k].w);
      }
    }
    float* hp = H + (size_t)tok * 1024 + 8 * lane;
    float4 a0 = *(const float4*)hp, a1 = *(const float4*)(hp + 4), a2 = *(const float4*)(hp + 512), a3 = *(const float4*)(hp + 516);
    a0.x += acc[0]; a0.y += acc[1]; a0.z += acc[2]; a0.w += acc[3]; a1.x += acc[4]; a1.y += acc[5]; a1.z += acc[6]; a1.w += acc[7];
    a2.x += acc[8]; a2.y += acc[9]; a2.z += acc[10]; a2.w += acc[11]; a3.x += acc[12]; a3.y += acc[13]; a3.z += acc[14]; a3.w += acc[15];
    float ss = a0.x * a0.x + a0.y * a0.y + a0.z * a0.z + a0.w * a0.w + a1.x * a1.x + a1.y * a1.y + a1.z * a1.z + a1.w * a1.w +
               a2.x * a2.x + a2.y * a2.y + a2.z * a2.z + a2.w * a2.w + a3.x * a3.x + a3.y * a3.y + a3.z * a3.z + a3.w * a3.w;
    ss = wave_sum(ss);
    const float r = rsqrtf(ss / 1024.f + 1e-6f);
    const float4 g0 = *(const float4*)(gfin + 8 * lane), g1 = *(const float4*)(gfin + 8 * lane + 4), g2 = *(const float4*)(gfin + 512 + 8 * lane), g3 = *(const float4*)(gfin + 516 + 8 * lane);
    a0.x *= r * g0.x; a0.y *= r * g0.y; a0.z *= r * g0.z; a0.w *= r * g0.w; a1.x *= r * g1.x; a1.y *= r * g1.y; a1.z *= r * g1.z; a1.w *= r * g1.w;
    a2.x *= r * g2.x; a2.y *= r * g2.y; a2.z *= r * g2.z; a2.w *= r * g2.w; a3.x *= r * g3.x; a3.y *= r * g3.y; a3.z *= r * g3.z; a3.w *= r * g3.w;
    *(float4*)hp = a0; *(float4*)(hp + 4) = a1; *(float4*)(hp + 512) = a2; *(float4*)(hp + 516) = a3;
  }
}

#define PU_SCALE 64.0f
#define PV_SCALE 8.0f
__device__ void prep_cvt_fp8(const float* __restrict__ src, unsigned char* __restrict__ dst, size_t n, float scale) {
  const int lane = threadIdx.x & 63;
  const size_t wv = (size_t)blockIdx.x * NWAVE + (threadIdx.x >> 6), nwv = (size_t)gridDim.x * NWAVE;
#pragma unroll 4
  for (size_t i = wv * 1024; i < n; i += nwv * 1024) {
    f32x4 a[4];
#pragma unroll
    for (int d = 0; d < 4; ++d) a[d] = __builtin_nontemporal_load((const f32x4*)(src + i + 256 * d + 4 * lane));
#pragma unroll
    for (int d = 0; d < 4; ++d) {
      int w = 0;
      w = __builtin_amdgcn_cvt_pk_fp8_f32(a[d][0] * scale, a[d][1] * scale, w, false);
      w = __builtin_amdgcn_cvt_pk_fp8_f32(a[d][2] * scale, a[d][3] * scale, w, true);
      *(unsigned*)(dst + i + 256 * d + 4 * lane) = (unsigned)w;
    }
  }
}
typedef float f32x2_t __attribute__((ext_vector_type(2)));
__device__ __forceinline__ float dot16_fp8(const uint4& u, const float (&h)[16], float s) {
  const unsigned w[4] = {u.x, u.y, u.z, u.w};
#pragma unroll
  for (int d = 0; d < 4; ++d) {
    const f32x2_t lo = __builtin_amdgcn_cvt_pk_f32_fp8((int)w[d], false), hi = __builtin_amdgcn_cvt_pk_f32_fp8((int)w[d], true);
    s += h[4 * d] * lo.x; s += h[4 * d + 1] * lo.y; s += h[4 * d + 2] * hi.x; s += h[4 * d + 3] * hi.y;
  }
  return s;
}
__device__ __forceinline__ void axpy16_fp8(const uint4& v, float w_, float (&acc)[16]) {
  const unsigned w[4] = {v.x, v.y, v.z, v.w};
#pragma unroll
  for (int d = 0; d < 4; ++d) {
    const f32x2_t lo = __builtin_amdgcn_cvt_pk_f32_fp8((int)w[d], false), hi = __builtin_amdgcn_cvt_pk_f32_fp8((int)w[d], true);
    acc[4 * d] += w_ * lo.x; acc[4 * d + 1] += w_ * lo.y; acc[4 * d + 2] += w_ * hi.x; acc[4 * d + 3] += w_ * hi.y;
  }
}

__device__ __forceinline__ float dot16_fp8_pk(const uint4& u, const f32x2_t (&h2)[8]) {
  const unsigned w[4] = {u.x, u.y, u.z, u.w};
  f32x2_t s = {0.f, 0.f};
#pragma unroll
  for (int d = 0; d < 4; ++d) {
    const f32x2_t lo = __builtin_amdgcn_cvt_pk_f32_fp8((int)w[d], false), hi = __builtin_amdgcn_cvt_pk_f32_fp8((int)w[d], true);
    s = __builtin_elementwise_fma(h2[2 * d], lo, s); s = __builtin_elementwise_fma(h2[2 * d + 1], hi, s);
  }
  return s.x + s.y;
}
__device__ __forceinline__ void axpy16_fp8_pk(const uint4& v, float w_, f32x2_t (&acc2)[8]) {
  const unsigned w[4] = {v.x, v.y, v.z, v.w};
  const f32x2_t ww = {w_, w_};
#pragma unroll
  for (int d = 0; d < 4; ++d) {
    const f32x2_t lo = __builtin_amdgcn_cvt_pk_f32_fp8((int)w[d], false), hi = __builtin_amdgcn_cvt_pk_f32_fp8((int)w[d], true);
    acc2[2 * d] = __builtin_elementwise_fma(lo, ww, acc2[2 * d]); acc2[2 * d + 1] = __builtin_elementwise_fma(hi, ww, acc2[2 * d + 1]);
  }
}
__device__ void ph_gather8(const bf16_t* __restrict__ HN, const int* __restrict__ EXP, const float* __restrict__ GATE,
                           const unsigned char* __restrict__ PU8, const unsigned char* __restrict__ PV8,
                           const float* __restrict__ gfin, const float* H, float* Hout) {
  const int lane = threadIdx.x & 63;
  const int nw = gridDim.x * NWAVE;
  const int kk = lane >> 3;
  for (int tok = __builtin_amdgcn_readfirstlane(blockIdx.x * NWAVE + (threadIdx.x >> 6)); tok < NTOK; tok += nw) {
    float hn[16], acc[16];
    {
      const uint4 h0 = *(const uint4*)(HN + (size_t)tok * 1024 + 16 * lane), h1 = *(const uint4*)(HN + (size_t)tok * 1024 + 16 * lane + 8);
      hn[0] = bflo(h0.x); hn[1] = bfhi(h0.x); hn[2] = bflo(h0.y); hn[3] = bfhi(h0.y); hn[4] = bflo(h0.z); hn[5] = bfhi(h0.z); hn[6] = bflo(h0.w); hn[7] = bfhi(h0.w);
      hn[8] = bflo(h1.x); hn[9] = bfhi(h1.x); hn[10] = bflo(h1.y); hn[11] = bfhi(h1.y); hn[12] = bflo(h1.z); hn[13] = bfhi(h1.z); hn[14] = bflo(h1.w); hn[15] = bfhi(h1.w);
    }
#pragma unroll
    for (int i = 0; i < 16; ++i) acc[i] = 0.f;
    const int* ep = EXP + (size_t)tok * 128;
    const float* gp = GATE + (size_t)tok * 128;
    uint4 uc[8], vc[8];
#pragma unroll
    for (int k = 0; k < 8; ++k) {
      const int e = __builtin_amdgcn_readfirstlane(ep[k]);
      uc[k] = *(const uint4*)(PU8 + (size_t)e * 1024 + 16 * lane); vc[k] = *(const uint4*)(PV8 + (size_t)e * 1024 + 16 * lane);
    }
#pragma unroll 1
    for (int bt = 0; bt < 16; ++bt) {
      uint4 un[8], vn[8];
      const int nb = (bt < 15) ? bt + 1 : bt;
#pragma unroll
      for (int k = 0; k < 8; ++k) {
        const int e = __builtin_amdgcn_readfirstlane(ep[nb * 8 + k]);
        un[k] = *(const uint4*)(PU8 + (size_t)e * 1024 + 16 * lane); vn[k] = *(const uint4*)(PV8 + (size_t)e * 1024 + 16 * lane);
      }
      const float gk = gp[bt * 8 + kk];
      float d[8];
#pragma unroll
      for (int k = 0; k < 8; ++k) d[k] = dot16_fp8(uc[k], hn, 0.f);
      const bool b5 = lane & 32, b4 = lane & 16, b3 = lane & 8;
      float r4[4];
#pragma unroll
      for (int k = 0; k < 4; ++k) { const float keep = b5 ? d[k + 4] : d[k], send = b5 ? d[k] : d[k + 4]; r4[k] = keep + __shfl_xor(send, 32); }
      float r2[2];
#pragma unroll
      for (int k = 0; k < 2; ++k) { const float keep = b4 ? r4[k + 2] : r4[k], send = b4 ? r4[k] : r4[k + 2]; r2[k] = keep + __shfl_xor(send, 16); }
      float r1;
      { const float keep = b3 ? r2[1] : r2[0], send = b3 ? r2[0] : r2[1]; r1 = keep + __shfl_xor(send, 8); }
      r1 += __shfl_xor(r1, 4); r1 += __shfl_xor(r1, 2); r1 += __shfl_xor(r1, 1);
      const float wl = gk * gelu_tanh(r1 * (1.0f / PU_SCALE));
#pragma unroll
      for (int k = 0; k < 8; ++k) axpy16_fp8(vc[k], __shfl(wl, 8 * k), acc);
#pragma unroll
      for (int k = 0; k < 8; ++k) { uc[k] = un[k]; vc[k] = vn[k]; }
    }
    const float* hp = H + (size_t)tok * 1024 + 16 * lane; float* hq = Hout + (size_t)tok * 1024 + 16 * lane;
    float4 a[4]; float ss = 0.f;
#pragma unroll
    for (int q = 0; q < 4; ++q) {
      a[q] = *(const float4*)(hp + 4 * q);
      a[q].x += acc[4 * q] * (1.0f / PV_SCALE); a[q].y += acc[4 * q + 1] * (1.0f / PV_SCALE); a[q].z += acc[4 * q + 2] * (1.0f / PV_SCALE); a[q].w += acc[4 * q + 3] * (1.0f / PV_SCALE);
      ss += a[q].x * a[q].x + a[q].y * a[q].y + a[q].z * a[q].z + a[q].w * a[q].w;
    }
    ss = wave_sum(ss);
    const float r = rsqrtf(ss / 1024.f + 1e-6f);
#pragma unroll
    for (int q = 0; q < 4; ++q) {
      const float4 g = *(const float4*)(gfin + 16 * lane + 4 * q);
      a[q].x *= r * g.x; a[q].y *= r * g.y; a[q].z *= r * g.z; a[q].w *= r * g.w;
      *(float4*)(hq + 4 * q) = a[q];
    }
  }
}

#ifndef RES_BF16
#define RES_BF16 1
#endif
__device__ __forceinline__ unsigned bsort_step(unsigned v, unsigned pv, bool keep_min) { return keep_min ? min(v, pv) : max(v, pv); }
__device__ __forceinline__ void wave_sort128(unsigned& k0, unsigned& k1, int lane) {
#pragma unroll
  for (int k = 2; k <= 128; k <<= 1) {
#pragma unroll
    for (int j = k >> 1; j > 0; j >>= 1) {
      if (j == 64) {
        const unsigned lo = min(k0, k1), hi = max(k0, k1); k0 = lo; k1 = hi;
      } else {
        const unsigned p0 = __shfl_xor(k0, j), p1 = __shfl_xor(k1, j);
        const bool lower = (lane & j) == 0;
        const bool asc0 = ((lane & k) == 0) || (k == 128), asc1 = (((64 + lane) & k) == 0) || (k == 128);
        k0 = bsort_step(k0, p0, lower == asc0); k1 = bsort_step(k1, p1, lower == asc1);
      }
    }
  }
}

template <int N, int BIT>
__device__ __forceinline__ float treduce_lvl(const float (&c)[N], int lane) {
  if constexpr (N == 1) {
    float r = c[0];
#pragma unroll
    for (int b = BIT; b >= 1; b >>= 1) r += __shfl_xor(r, b);
    return r;
  } else {
    const bool hi = (lane & BIT) != 0;
    float nx[N / 2];
#pragma unroll
    for (int k = 0; k < N / 2; ++k) { const float keep = hi ? c[k + N / 2] : c[k], send = hi ? c[k] : c[k + N / 2]; nx[k] = keep + __shfl_xor(send, BIT); }
    return treduce_lvl<N / 2, BIT / 2>(nx, lane);
  }
}
template <int NB>
__device__ __forceinline__ float treduce(const float (&d)[NB], int lane) { return treduce_lvl<NB, 32>(d, lane); }

template <int NS, int NB>
__device__ void ph_gather9(const bf16_t* __restrict__ HN, const int* __restrict__ EXP, const float* __restrict__ GATE,
                           const unsigned char* __restrict__ PU8, const unsigned char* __restrict__ PV8,
                           const float* __restrict__ gfin, const float* H, float* Hout, unsigned char* lds,
                           const float* __restrict__ ss2, const float* __restrict__ gffn) {
  int tid_ = threadIdx.x; asm volatile("" : "+v"(tid_));
  const int wv = tid_ >> 6, lane = tid_ & 63;
  unsigned* se = (unsigned*)(lds + wv * (NS * 1024));
  float* sw = (float*)(lds + wv * (NS * 1024) + NS * 512);
  constexpr int STEP = NB / NS;
  constexpr int LPG = 64 / NB;
  for (int base = (blockIdx.x * NWAVE + wv) * NS; base < NTOK; base += gridDim.x * NWAVE * NS) {
#pragma unroll 1
    for (int s = 0; s < NS; ++s) {
      const int tok = base + s;
      unsigned k0 = ((unsigned)EXP[(size_t)tok * 128 + lane] << 7) | (unsigned)lane;
      unsigned k1 = ((unsigned)EXP[(size_t)tok * 128 + 64 + lane] << 7) | (unsigned)(64 + lane);
      wave_sort128(k0, k1, lane);
      se[s * 128 + lane] = k0 >> 7; se[s * 128 + 64 + lane] = k1 >> 7;
      sw[s * 128 + lane] = GATE[(size_t)tok * 128 + (k0 & 127u)]; sw[s * 128 + 64 + lane] = GATE[(size_t)tok * 128 + (k1 & 127u)];
    }
    wave_lds_sync();
    {
      f32x2_t hn[NS][8];
      f32x2_t gf[8];
#pragma unroll
      for (int q = 0; q < 8; ++q) gf[q] = *(const f32x2_t*)(gffn + 16 * lane + 2 * q);
#pragma unroll
      for (int s = 0; s < NS; ++s) {
        const uint4 h0 = *(const uint4*)(HN + (size_t)(base + s) * 1024 + 16 * lane), h1 = *(const uint4*)(HN + (size_t)(base + s) * 1024 + 16 * lane + 8);
        hn[s][0] = (f32x2_t){bflo(h0.x), bfhi(h0.x)}; hn[s][1] = (f32x2_t){bflo(h0.y), bfhi(h0.y)}; hn[s][2] = (f32x2_t){bflo(h0.z), bfhi(h0.z)}; hn[s][3] = (f32x2_t){bflo(h0.w), bfhi(h0.w)};
        hn[s][4] = (f32x2_t){bflo(h1.x), bfhi(h1.x)}; hn[s][5] = (f32x2_t){bflo(h1.y), bfhi(h1.y)}; hn[s][6] = (f32x2_t){bflo(h1.z), bfhi(h1.z)}; hn[s][7] = (f32x2_t){bflo(h1.w), bfhi(h1.w)};
        const float rs2 = rsqrtf(ss2[base + s] * (1.0f / 1024.f) + 1e-6f);
#pragma unroll
        for (int q = 0; q < 8; ++q) hn[s][q] = hn[s][q] * gf[q] * rs2;
      }
      uint4 uc[NB];
#pragma unroll
      for (int k = 0; k < NB; ++k) { const unsigned e = __builtin_amdgcn_readfirstlane(se[(k % NS) * 128 + (k / NS)]); uc[k] = *(const uint4*)(PU8 + (size_t)e * 1024 + 16 * lane); }
#pragma unroll 1
      for (int i = 0; i < 128; i += STEP) {
        uint4 un[NB];
        const int ni = (i + STEP < 128) ? i + STEP : i;
#pragma unroll
        for (int k = 0; k < NB; ++k) { const unsigned e = __builtin_amdgcn_readfirstlane(se[(k % NS) * 128 + ni + (k / NS)]); un[k] = *(const uint4*)(PU8 + (size_t)e * 1024 + 16 * lane); }
        float d[NB];
#pragma unroll
        for (int k = 0; k < NB; ++k) {
          d[k] = dot16_fp8_pk(uc[k], hn[k % NS]);
#ifdef PROBE_UVALU2
          { uint4 t = uc[k]; asm volatile("" : "+v"(t.x), "+v"(t.y), "+v"(t.z), "+v"(t.w)); d[k] = (d[k] + dot16_fp8_pk(t, hn[k % NS])) * 0.5f; }
#endif
        }
        const float r1 = treduce<NB>(d, lane);
        const int kk = lane / LPG;
        const int pos = (kk % NS) * 128 + i + (kk / NS);
        const float wgt = sw[pos] * gelu_tanh(r1 * (1.0f / PU_SCALE));
        if ((lane % LPG) == 0) sw[pos] = wgt;
#pragma unroll
        for (int k = 0; k < NB; ++k) uc[k] = un[k];
      }
    }
    wave_lds_sync();
    f32x2_t acc[NS][8];
#pragma unroll
    for (int s = 0; s < NS; ++s)
#pragma unroll
      for (int q = 0; q < 8; ++q) acc[s][q] = (f32x2_t){0.f, 0.f};
    {
      uint4 vc[NB];
#pragma unroll
      for (int k = 0; k < NB; ++k) { const unsigned e = __builtin_amdgcn_readfirstlane(se[(k % NS) * 128 + (k / NS)]); vc[k] = *(const uint4*)(PV8 + (size_t)e * 1024 + 16 * lane); }
#pragma unroll 1
      for (int i = 0; i < 128; i += STEP) {
        uint4 vn[NB];
        const int ni = (i + STEP < 128) ? i + STEP : i;
#pragma unroll
        for (int k = 0; k < NB; ++k) { const unsigned e = __builtin_amdgcn_readfirstlane(se[(k % NS) * 128 + ni + (k / NS)]); vn[k] = *(const uint4*)(PV8 + (size_t)e * 1024 + 16 * lane); }
#pragma unroll
        for (int k = 0; k < NB; ++k) axpy16_fp8_pk(vc[k], sw[(k % NS) * 128 + i + (k / NS)], acc[k % NS]);
#pragma unroll
        for (int k = 0; k < NB; ++k) vc[k] = vn[k];
      }
    }
#pragma unroll
    for (int s = 0; s < NS; ++s) {
      float* hq = Hout + (size_t)(base + s) * 1024 + 16 * lane;
      float4 a[4]; float ss = 0.f;
#if RES_BF16
      const uint4 r0 = *(const uint4*)(HN + (size_t)(base + s) * 1024 + 16 * lane), r1 = *(const uint4*)(HN + (size_t)(base + s) * 1024 + 16 * lane + 8);
      a[0] = make_float4(bflo(r0.x), bfhi(r0.x), bflo(r0.y), bfhi(r0.y)); a[1] = make_float4(bflo(r0.z), bfhi(r0.z), bflo(r0.w), bfhi(r0.w));
      a[2] = make_float4(bflo(r1.x), bfhi(r1.x), bflo(r1.y), bfhi(r1.y)); a[3] = make_float4(bflo(r1.z), bfhi(r1.z), bflo(r1.w), bfhi(r1.w));
#else
      const float* hp = H + (size_t)(base + s) * 1024 + 16 * lane;
#endif
#pragma unroll
      for (int q = 0; q < 4; ++q) {
#if !RES_BF16
        a[q] = *(const float4*)(hp + 4 * q);
#endif
        a[q].x += acc[s][2 * q].x * (1.0f / PV_SCALE); a[q].y += acc[s][2 * q].y * (1.0f / PV_SCALE); a[q].z += acc[s][2 * q + 1].x * (1.0f / PV_SCALE); a[q].w += acc[s][2 * q + 1].y * (1.0f / PV_SCALE);
        ss += a[q].x * a[q].x + a[q].y * a[q].y + a[q].z * a[q].z + a[q].w * a[q].w;
      }
      ss = wave_sum(ss);
      const float r = rsqrtf(ss / 1024.f + 1e-6f);
#pragma unroll
      for (int q = 0; q < 4; ++q) {
        const float4 g = *(const float4*)(gfin + 16 * lane + 4 * q);
        a[q].x *= r * g.x; a[q].y *= r * g.y; a[q].z *= r * g.z; a[q].w *= r * g.w;
        *(float4*)(hq + 4 * q) = a[q];
      }
    }
    wave_lds_sync();
  }
}

#ifndef PX_SCALE
#define PX_SCALE 16.0f
#endif
template <int NS, int NB, int NBU>
__device__ void ph_gather10(const bf16_t* __restrict__ HN, const int* __restrict__ EXP, const float* __restrict__ GATE,
                           const unsigned char* __restrict__ PU8, const unsigned char* __restrict__ PV8,
                           const float* __restrict__ gfin, const float* H, float* Hout, unsigned char* lds,
                           const float* __restrict__ ss2, const float* __restrict__ gffn) {
  int tid_ = threadIdx.x; asm volatile("" : "+v"(tid_));
  const int wv = tid_ >> 6, lane = tid_ & 63;
  unsigned* se = (unsigned*)(lds + wv * (NS * 1024));
  float* sw = (float*)(lds + wv * (NS * 1024) + NS * 512);
  constexpr int STEP = NB / NS;
  constexpr int LPG = 64 / NB;
  for (int base = (blockIdx.x * NWAVE + wv) * NS; base < NTOK; base += gridDim.x * NWAVE * NS) {
#pragma unroll 1
    for (int s = 0; s < NS; ++s) {
      const int tok = base + s;
      unsigned k0 = ((unsigned)EXP[(size_t)tok * 128 + lane] << 7) | (unsigned)lane;
      unsigned k1 = ((unsigned)EXP[(size_t)tok * 128 + 64 + lane] << 7) | (unsigned)(64 + lane);
      wave_sort128(k0, k1, lane);
      se[s * 128 + lane] = k0 >> 7; se[s * 128 + 64 + lane] = k1 >> 7;
      sw[s * 128 + lane] = GATE[(size_t)tok * 128 + (k0 & 127u)]; sw[s * 128 + 64 + lane] = GATE[(size_t)tok * 128 + (k1 & 127u)];
    }
    wave_lds_sync();
    {
      long xb0[NS], xb1[NS];
      {
        f32x2_t gf[8];
#pragma unroll
        for (int q = 0; q < 8; ++q) gf[q] = *(const f32x2_t*)(gffn + 16 * lane + 2 * q);
#pragma unroll
        for (int s = 0; s < NS; ++s) {
          const uint4 h0 = *(const uint4*)(HN + (size_t)(base + s) * 1024 + 16 * lane), h1 = *(const uint4*)(HN + (size_t)(base + s) * 1024 + 16 * lane + 8);
          f32x2_t hn[8];
          hn[0] = (f32x2_t){bflo(h0.x), bfhi(h0.x)}; hn[1] = (f32x2_t){bflo(h0.y), bfhi(h0.y)}; hn[2] = (f32x2_t){bflo(h0.z), bfhi(h0.z)}; hn[3] = (f32x2_t){bflo(h0.w), bfhi(h0.w)};
          hn[4] = (f32x2_t){bflo(h1.x), bfhi(h1.x)}; hn[5] = (f32x2_t){bflo(h1.y), bfhi(h1.y)}; hn[6] = (f32x2_t){bflo(h1.z), bfhi(h1.z)}; hn[7] = (f32x2_t){bflo(h1.w), bfhi(h1.w)};
          const float rs2 = rsqrtf(ss2[base + s] * (1.0f / 1024.f) + 1e-6f) * PX_SCALE;
#pragma unroll
          for (int q = 0; q < 8; ++q) hn[q] = hn[q] * gf[q] * rs2;
          int w0 = 0, w1 = 0, w2 = 0, w3 = 0;
          w0 = __builtin_amdgcn_cvt_pk_fp8_f32(hn[0].x, hn[0].y, w0, false); w0 = __builtin_amdgcn_cvt_pk_fp8_f32(hn[1].x, hn[1].y, w0, true);
          w1 = __builtin_amdgcn_cvt_pk_fp8_f32(hn[2].x, hn[2].y, w1, false); w1 = __builtin_amdgcn_cvt_pk_fp8_f32(hn[3].x, hn[3].y, w1, true);
          w2 = __builtin_amdgcn_cvt_pk_fp8_f32(hn[4].x, hn[4].y, w2, false); w2 = __builtin_amdgcn_cvt_pk_fp8_f32(hn[5].x, hn[5].y, w2, true);
          w3 = __builtin_amdgcn_cvt_pk_fp8_f32(hn[6].x, hn[6].y, w3, false); w3 = __builtin_amdgcn_cvt_pk_fp8_f32(hn[7].x, hn[7].y, w3, true);
          xb0[s] = (long)(((unsigned long)(unsigned)w1 << 32) | (unsigned long)(unsigned)w0);
          xb1[s] = (long)(((unsigned long)(unsigned)w3 << 32) | (unsigned long)(unsigned)w2);
        }
      }
      const bool dg = (lane >> 4) == ((lane >> 2) & 3);
      const f32x2_t m01 = {(dg && (lane & 3) == 0) ? 1.f : 0.f, (dg && (lane & 3) == 1) ? 1.f : 0.f}, m23 = {(dg && (lane & 3) == 2) ? 1.f : 0.f, (dg && (lane & 3) == 3) ? 1.f : 0.f};
      constexpr int STEPU = NBU / NS, LPGU = 64 / NBU;
      uint4 uc[NBU];
#pragma unroll
      for (int k = 0; k < NBU; ++k) { const unsigned e = __builtin_amdgcn_readfirstlane(se[(k % NS) * 128 + (k / NS)]); uc[k] = *(const uint4*)(PU8 + (size_t)e * 1024 + 16 * lane); }
#pragma unroll 1
      for (int i = 0; i < 128; i += STEPU) {
        uint4 un[NBU];
        const int ni = (i + STEPU < 128) ? i + STEPU : i;
#pragma unroll
        for (int k = 0; k < NBU; ++k) { const unsigned e = __builtin_amdgcn_readfirstlane(se[(k % NS) * 128 + ni + (k / NS)]); un[k] = *(const uint4*)(PU8 + (size_t)e * 1024 + 16 * lane); }
        float d[NBU];
#pragma unroll
        for (int k = 0; k < NBU; ++k) {
          const long a0 = (long)(((unsigned long)uc[k].y << 32) | (unsigned long)uc[k].x), a1 = (long)(((unsigned long)uc[k].w << 32) | (unsigned long)uc[k].z);
          f32x4 acc = {0.f, 0.f, 0.f, 0.f};
          acc = __builtin_amdgcn_mfma_f32_16x16x32_fp8_fp8(a0, xb0[k % NS], acc, 0, 0, 0);
          acc = __builtin_amdgcn_mfma_f32_16x16x32_fp8_fp8(a1, xb1[k % NS], acc, 0, 0, 0);
          const f32x2_t t = (f32x2_t){acc[0], acc[1]} * m01 + (f32x2_t){acc[2], acc[3]} * m23;
          d[k] = t.x + t.y;
        }
        const float r1 = treduce<NBU>(d, lane);
        const int kk = lane / LPGU;
        const int pos = (kk % NS) * 128 + i + (kk / NS);
        const float wgt = sw[pos] * gelu_tanh(r1 * (1.0f / (PU_SCALE * PX_SCALE)));
        if ((lane % LPGU) == 0) sw[pos] = wgt;
#pragma unroll
        for (int k = 0; k < NBU; ++k) uc[k] = un[k];
      }
    }
    wave_lds_sync();
    f32x2_t acc[NS][8];
#pragma unroll
    for (int s = 0; s < NS; ++s)
#pragma unroll
      for (int q = 0; q < 8; ++q) acc[s][q] = (f32x2_t){0.f, 0.f};
    {
      uint4 vc[NB];
#pragma unroll
      for (int k = 0; k < NB; ++k) { const unsigned e = __builtin_amdgcn_readfirstlane(se[(k % NS) * 128 + (k / NS)]); vc[k] = *(const uint4*)(PV8 + (size_t)e * 1024 + 16 * lane); }
#pragma unroll 1
      for (int i = 0; i < 128; i += STEP) {
        uint4 vn[NB];
        const int ni = (i + STEP < 128) ? i + STEP : i;
#pragma unroll
        for (int k = 0; k < NB; ++k) { const unsigned e = __builtin_amdgcn_readfirstlane(se[(k % NS) * 128 + ni + (k / NS)]); vn[k] = *(const uint4*)(PV8 + (size_t)e * 1024 + 16 * lane); }
#pragma unroll
        for (int k = 0; k < NB; ++k) axpy16_fp8_pk(vc[k], sw[(k % NS) * 128 + i + (k / NS)], acc[k % NS]);
#pragma unroll
        for (int k = 0; k < NB; ++k) vc[k] = vn[k];
      }
    }
#pragma unroll
    for (int s = 0; s < NS; ++s) {
      float* hq = Hout + (size_t)(base + s) * 1024 + 16 * lane;
      float4 a[4]; float ss = 0.f;
#if RES_BF16
      const uint4 r0 = *(const uint4*)(HN + (size_t)(base + s) * 1024 + 16 * lane), r1 = *(const uint4*)(HN + (size_t)(base + s) * 1024 + 16 * lane + 8);
      a[0] = make_float4(bflo(r0.x), bfhi(r0.x), bflo(r0.y), bfhi(r0.y)); a[1] = make_float4(bflo(r0.z), bfhi(r0.z), bflo(r0.w), bfhi(r0.w));
      a[2] = make_float4(bflo(r1.x), bfhi(r1.x), bflo(r1.y), bfhi(r1.y)); a[3] = make_float4(bflo(r1.z), bfhi(r1.z), bflo(r1.w), bfhi(r1.w));
#else
      const float* hp = H + (size_t)(base + s) * 1024 + 16 * lane;
#endif
#pragma unroll
      for (int q = 0; q < 4; ++q) {
#if !RES_BF16
        a[q] = *(const float4*)(hp + 4 * q);
#endif
        a[q].x += acc[s][2 * q].x * (1.0f / PV_SCALE); a[q].y += acc[s][2 * q].y * (1.0f / PV_SCALE); a[q].z += acc[s][2 * q + 1].x * (1.0f / PV_SCALE); a[q].w += acc[s][2 * q + 1].y * (1.0f / PV_SCALE);
        ss += a[q].x * a[q].x + a[q].y * a[q].y + a[q].z * a[q].z + a[q].w * a[q].w;
      }
      ss = wave_sum(ss);
      const float r = rsqrtf(ss / 1024.f + 1e-6f);
#pragma unroll
      for (int q = 0; q < 4; ++q) {
        const float4 g = *(const float4*)(gfin + 16 * lane + 4 * q);
        a[q].x *= r * g.x; a[q].y *= r * g.y; a[q].z *= r * g.z; a[q].w *= r * g.w;
        *(float4*)(hq + 4 * q) = a[q];
      }
    }
    wave_lds_sync();
  }
}

#ifndef PX_SCALE
#define PX_SCALE 16.0f
#endif
template <int NS, int NB, int NBU>
__device__ void ph_gather11(const bf16_t* __restrict__ HN, const int* __restrict__ EXP, const float* __restrict__ GATE,
                           const unsigned char* __restrict__ PU8, const unsigned char* __restrict__ PV8,
                           const float* __restrict__ gfin, const float* H, float* Hout, unsigned char* lds,
                           const float* __restrict__ ss2, const float* __restrict__ gffn) {
  int tid_ = threadIdx.x; asm volatile("" : "+v"(tid_));
  const int wv = tid_ >> 6, lane = tid_ & 63;
  unsigned* se = (unsigned*)(lds + wv * (NS * 1024));
  float* sw = (float*)(lds + wv * (NS * 1024) + NS * 512);
  constexpr int STEP = NB / NS;
  constexpr int LPG = 64 / NB;
  for (int base = (blockIdx.x * NWAVE + wv) * NS; base < NTOK; base += gridDim.x * NWAVE * NS) {
#pragma unroll 1
    for (int s = 0; s < NS; ++s) {
      const int tok = base + s;
      unsigned k0 = ((unsigned)EXP[(size_t)tok * 128 + lane] << 7) | (unsigned)lane;
      unsigned k1 = ((unsigned)EXP[(size_t)tok * 128 + 64 + lane] << 7) | (unsigned)(64 + lane);
      wave_sort128(k0, k1, lane);
      se[s * 128 + lane] = k0 >> 7; se[s * 128 + 64 + lane] = k1 >> 7;
      sw[s * 128 + lane] = GATE[(size_t)tok * 128 + (k0 & 127u)]; sw[s * 128 + 64 + lane] = GATE[(size_t)tok * 128 + (k1 & 127u)];
    }
    wave_lds_sync();
    {
      long xb0[NS], xb1[NS];
      {
        f32x2_t gf[8];
#pragma unroll
        for (int q = 0; q < 8; ++q) gf[q] = *(const f32x2_t*)(gffn + 16 * lane + 2 * q);
#pragma unroll
        for (int s = 0; s < NS; ++s) {
          const uint4 h0 = *(const uint4*)(HN + (size_t)(base + s) * 1024 + 16 * lane), h1 = *(const uint4*)(HN + (size_t)(base + s) * 1024 + 16 * lane + 8);
          f32x2_t hn[8];
          hn[0] = (f32x2_t){bflo(h0.x), bfhi(h0.x)}; hn[1] = (f32x2_t){bflo(h0.y), bfhi(h0.y)}; hn[2] = (f32x2_t){bflo(h0.z), bfhi(h0.z)}; hn[3] = (f32x2_t){bflo(h0.w), bfhi(h0.w)};
          hn[4] = (f32x2_t){bflo(h1.x), bfhi(h1.x)}; hn[5] = (f32x2_t){bflo(h1.y), bfhi(h1.y)}; hn[6] = (f32x2_t){bflo(h1.z), bfhi(h1.z)}; hn[7] = (f32x2_t){bflo(h1.w), bfhi(h1.w)};
          const float rs2 = rsqrtf(ss2[base + s] * (1.0f / 1024.f) + 1e-6f) * PX_SCALE;
#pragma unroll
          for (int q = 0; q < 8; ++q) hn[q] = hn[q] * gf[q] * rs2;
          int w0 = 0, w1 = 0, w2 = 0, w3 = 0;
          w0 = __builtin_amdgcn_cvt_pk_fp8_f32(hn[0].x, hn[0].y, w0, false); w0 = __builtin_amdgcn_cvt_pk_fp8_f32(hn[1].x, hn[1].y, w0, true);
          w1 = __builtin_amdgcn_cvt_pk_fp8_f32(hn[2].x, hn[2].y, w1, false); w1 = __builtin_amdgcn_cvt_pk_fp8_f32(hn[3].x, hn[3].y, w1, true);
          w2 = __builtin_amdgcn_cvt_pk_fp8_f32(hn[4].x, hn[4].y, w2, false); w2 = __builtin_amdgcn_cvt_pk_fp8_f32(hn[5].x, hn[5].y, w2, true);
          w3 = __builtin_amdgcn_cvt_pk_fp8_f32(hn[6].x, hn[6].y, w3, false); w3 = __builtin_amdgcn_cvt_pk_fp8_f32(hn[7].x, hn[7].y, w3, true);
          xb0[s] = (long)(((unsigned long)(unsigned)w1 << 32) | (unsigned long)(unsigned)w0);
          xb1[s] = (long)(((unsigned long)(unsigned)w3 << 32) | (unsigned long)(unsigned)w2);
        }
      }
      const bool dg = (lane >> 4) == ((lane >> 2) & 3);
      const f32x2_t m01 = {(dg && (lane & 3) == 0) ? 1.f : 0.f, (dg && (lane & 3) == 1) ? 1.f : 0.f}, m23 = {(dg && (lane & 3) == 2) ? 1.f : 0.f, (dg && (lane & 3) == 3) ? 1.f : 0.f};
      constexpr int STEPU = NBU / NS, LPGU = 64 / NBU;
      const unsigned lo16 = (unsigned)lane << 4;
#define U_LOAD(buf, ii) _Pragma("unroll") for (int k = 0; k < NBU; ++k) { const unsigned e = se[(k % NS) * 128 + (ii) + (k / NS)]; buf[k] = *(const uint4*)(PU8 + ((e << 10) | lo16)); }
#define U_COMP(buf, ii) { float d[NBU]; \
        _Pragma("unroll") for (int k = 0; k < NBU; ++k) { \
          const long a0 = (long)(((unsigned long)buf[k].y << 32) | (unsigned long)buf[k].x), a1 = (long)(((unsigned long)buf[k].w << 32) | (unsigned long)buf[k].z); \
          f32x4 acc = {0.f, 0.f, 0.f, 0.f}; \
          acc = __builtin_amdgcn_mfma_f32_16x16x32_fp8_fp8(a0, xb0[k % NS], acc, 0, 0, 0); \
          acc = __builtin_amdgcn_mfma_f32_16x16x32_fp8_fp8(a1, xb1[k % NS], acc, 0, 0, 0); \
          const f32x2_t t = (f32x2_t){acc[0], acc[1]} * m01 + (f32x2_t){acc[2], acc[3]} * m23; \
          d[k] = t.x + t.y; } \
        const float r1 = treduce<NBU>(d, lane); \
        const int kk = lane / LPGU; \
        const int pos = (kk % NS) * 128 + (ii) + (kk / NS); \
        const float wgt = sw[pos] * gelu_tanh(r1 * (1.0f / (PU_SCALE * PX_SCALE))); \
        if ((lane % LPGU) == 0) sw[pos] = wgt; }
      uint4 ua[NBU], ub[NBU];
      U_LOAD(ua, 0)
#pragma unroll 1
      for (int i = 0; i < 128; i += 2 * STEPU) {
        U_LOAD(ub, i + STEPU)
        __builtin_amdgcn_sched_barrier(0);
        U_COMP(ua, i)
        __builtin_amdgcn_sched_barrier(0);
        const int ni = (i + 2 * STEPU < 128) ? i + 2 * STEPU : i;
        U_LOAD(ua, ni)
        __builtin_amdgcn_sched_barrier(0);
        U_COMP(ub, i + STEPU)
        __builtin_amdgcn_sched_barrier(0);
      }
#undef U_LOAD
#undef U_COMP
    }
    wave_lds_sync();
    f32x2_t acc[NS][8];
#pragma unroll
    for (int s = 0; s < NS; ++s)
#pragma unroll
      for (int q = 0; q < 8; ++q) acc[s][q] = (f32x2_t){0.f, 0.f};
    {
      const unsigned lo16 = (unsigned)lane << 4;
#define V_LOAD(buf, ii) _Pragma("unroll") for (int k = 0; k < NB; ++k) { const unsigned e = se[(k % NS) * 128 + (ii) + (k / NS)]; buf[k] = *(const uint4*)(PV8 + ((e << 10) | lo16)); }
#define V_COMP(buf, ii) _Pragma("unroll") for (int k = 0; k < NB; ++k) axpy16_fp8_pk(buf[k], sw[(k % NS) * 128 + (ii) + (k / NS)], acc[k % NS]);
      uint4 va[NB], vb[NB];
      V_LOAD(va, 0)
#pragma unroll 1
      for (int i = 0; i < 128; i += 2 * STEP) {
        V_LOAD(vb, i + STEP)
        __builtin_amdgcn_sched_barrier(0);
        V_COMP(va, i)
        __builtin_amdgcn_sched_barrier(0);
        const int ni = (i + 2 * STEP < 128) ? i + 2 * STEP : i;
        V_LOAD(va, ni)
        __builtin_amdgcn_sched_barrier(0);
        V_COMP(vb, i + STEP)
        __builtin_amdgcn_sched_barrier(0);
      }
#undef V_LOAD
#undef V_COMP
    }
#pragma unroll
    for (int s = 0; s < NS; ++s) {
      float* hq = Hout + (size_t)(base + s) * 1024 + 16 * lane;
      float4 a[4]; float ss = 0.f;
#if RES_BF16
      const uint4 r0 = *(const uint4*)(HN + (size_t)(base + s) * 1024 + 16 * lane), r1 = *(const uint4*)(HN + (size_t)(base + s) * 1024 + 16 * lane + 8);
      a[0] = make_float4(bflo(r0.x), bfhi(r0.x), bflo(r0.y), bfhi(r0.y)); a[1] = make_float4(bflo(r0.z), bfhi(r0.z), bflo(r0.w), bfhi(r0.w));
      a[2] = make_float4(bflo(r1.x), bfhi(r1.x), bflo(r1.y), bfhi(r1.y)); a[3] = make_float4(bflo(r1.z), bfhi(r1.z), bflo(r1.w), bfhi(r1.w));
#else
      const float* hp = H + (size_t)(base + s) * 1024 + 16 * lane;
#endif
#pragma unroll
      for (int q = 0; q < 4; ++q) {
#if !RES_BF16
        a[q] = *(const float4*)(hp + 4 * q);
#endif
        a[q].x += acc[s][2 * q].x * (1.0f / PV_SCALE); a[q].y += acc[s][2 * q].y * (1.0f / PV_SCALE); a[q].z += acc[s][2 * q + 1].x * (1.0f / PV_SCALE); a[q].w += acc[s][2 * q + 1].y * (1.0f / PV_SCALE);
        ss += a[q].x * a[q].x + a[q].y * a[q].y + a[q].z * a[q].z + a[q].w * a[q].w;
      }
      ss = wave_sum(ss);
      const float r = rsqrtf(ss / 1024.f + 1e-6f);
#ifdef PROBE_VARRATIO
      float pp = 0.f;
#pragma unroll
      for (int q = 0; q < 8; ++q) pp += acc[s][q].x * acc[s][q].x + acc[s][q].y * acc[s][q].y;
      pp = wave_sum(pp) * (1.0f / (PV_SCALE * PV_SCALE));
      const float cst = 10.0f * sqrtf(pp / ss);
#pragma unroll
      for (int q = 0; q < 4; ++q) *(float4*)(hq + 4 * q) = make_float4(cst, cst, cst, cst);
#else
#pragma unroll
      for (int q = 0; q < 4; ++q) {
        const float4 g = *(const float4*)(gfin + 16 * lane + 4 * q);
        a[q].x *= r * g.x; a[q].y *= r * g.y; a[q].z *= r * g.z; a[q].w *= r * g.w;
        *(float4*)(hq + 4 * q) = a[q];
      }
#endif
    }
    wave_lds_sync();
  }
}

#ifndef PX_SCALE
#define PX_SCALE 16.0f
#endif
#ifndef NT_FP4
#define NT_FP4 0
#endif
#ifndef PV4_SCALE
#define PV4_SCALE 5.65f
#endif
__device__ void prep_cvt_fp4(const float* __restrict__ src, unsigned char* __restrict__ dst, size_t n, float scale, int wg, int nwg) {
#pragma unroll 8
  for (size_t i = ((size_t)wg * NTHR + threadIdx.x) * 8; i < n; i += (size_t)nwg * NTHR * 8) {
    const f32x4 a = __builtin_nontemporal_load((const f32x4*)(src + i)), b = __builtin_nontemporal_load((const f32x4*)(src + i + 4));
    unsigned q = 0;
    q = __builtin_amdgcn_cvt_scalef32_pk_fp4_f32(q, a[0] * scale, a[1] * scale, 1.0f, 0);
    q = __builtin_amdgcn_cvt_scalef32_pk_fp4_f32(q, a[2] * scale, a[3] * scale, 1.0f, 1);
    q = __builtin_amdgcn_cvt_scalef32_pk_fp4_f32(q, b[0] * scale, b[1] * scale, 1.0f, 2);
    q = __builtin_amdgcn_cvt_scalef32_pk_fp4_f32(q, b[2] * scale, b[3] * scale, 1.0f, 3);
#if NT_FP4
    __builtin_nontemporal_store(q, (unsigned*)(dst + (i >> 1)));
#else
    *(unsigned*)(dst + (i >> 1)) = q;
#endif
  }
}
typedef unsigned u32x2_t __attribute__((ext_vector_type(2)));
__device__ __forceinline__ void axpy16_fp4_pk(const u32x2_t& v, float w_, f32x2_t (&acc2)[8]) {
  const f32x2_t ww = {w_, w_};
  acc2[0] = __builtin_elementwise_fma(__builtin_amdgcn_cvt_scalef32_pk_f32_fp4(v.x, 1.0f, 0), ww, acc2[0]);
  acc2[1] = __builtin_elementwise_fma(__builtin_amdgcn_cvt_scalef32_pk_f32_fp4(v.x, 1.0f, 1), ww, acc2[1]);
  acc2[2] = __builtin_elementwise_fma(__builtin_amdgcn_cvt_scalef32_pk_f32_fp4(v.x, 1.0f, 2), ww, acc2[2]);
  acc2[3] = __builtin_elementwise_fma(__builtin_amdgcn_cvt_scalef32_pk_f32_fp4(v.x, 1.0f, 3), ww, acc2[3]);
  acc2[4] = __builtin_elementwise_fma(__builtin_amdgcn_cvt_scalef32_pk_f32_fp4(v.y, 1.0f, 0), ww, acc2[4]);
  acc2[5] = __builtin_elementwise_fma(__builtin_amdgcn_cvt_scalef32_pk_f32_fp4(v.y, 1.0f, 1), ww, acc2[5]);
  acc2[6] = __builtin_elementwise_fma(__builtin_amdgcn_cvt_scalef32_pk_f32_fp4(v.y, 1.0f, 2), ww, acc2[6]);
  acc2[7] = __builtin_elementwise_fma(__builtin_amdgcn_cvt_scalef32_pk_f32_fp4(v.y, 1.0f, 3), ww, acc2[7]);
}
template <int NS, int NB, int NBU>
__device__ void ph_gather13(const bf16_t* __restrict__ HN, const int* __restrict__ EXP, const float* __restrict__ GATE,
                           const unsigned char* __restrict__ PU8, const unsigned char* __restrict__ PV8,
                           const float* __restrict__ gfin, const float* H, float* Hout, unsigned char* lds,
                           const float* __restrict__ ss2, const float* __restrict__ gffn) {
  int tid_ = threadIdx.x; asm volatile("" : "+v"(tid_));
  const int wv = tid_ >> 6, lane = tid_ & 63;
  unsigned* se = (unsigned*)(lds + wv * (NS * 1024));
  float* sw = (float*)(lds + wv * (NS * 1024) + NS * 512);
  constexpr int STEP = NB / NS;
  constexpr int LPG = 64 / NB;
  for (int base = (blockIdx.x * NWAVE + wv) * NS; base < NTOK; base += gridDim.x * NWAVE * NS) {
#pragma unroll 1
    for (int s = 0; s < NS; ++s) {
      const int tok = base + s;
      unsigned k0 = ((unsigned)EXP[(size_t)tok * 128 + lane] << 7) | (unsigned)lane;
      unsigned k1 = ((unsigned)EXP[(size_t)tok * 128 + 64 + lane] << 7) | (unsigned)(64 + lane);
      wave_sort128(k0, k1, lane);
      se[s * 128 + lane] = k0 >> 7; se[s * 128 + 64 + lane] = k1 >> 7;
      sw[s * 128 + lane] = GATE[(size_t)tok * 128 + (k0 & 127u)]; sw[s * 128 + 64 + lane] = GATE[(size_t)tok * 128 + (k1 & 127u)];
    }
    wave_lds_sync();
    {
      long xb0[NS], xb1[NS];
      {
        f32x2_t gf[8];
#pragma unroll
        for (int q = 0; q < 8; ++q) gf[q] = *(const f32x2_t*)(gffn + 16 * lane + 2 * q);
#pragma unroll
        for (int s = 0; s < NS; ++s) {
          const uint4 h0 = *(const uint4*)(HN + (size_t)(base + s) * 1024 + 16 * lane), h1 = *(const uint4*)(HN + (size_t)(base + s) * 1024 + 16 * lane + 8);
          f32x2_t hn[8];
          hn[0] = (f32x2_t){bflo(h0.x), bfhi(h0.x)}; hn[1] = (f32x2_t){bflo(h0.y), bfhi(h0.y)}; hn[2] = (f32x2_t){bflo(h0.z), bfhi(h0.z)}; hn[3] = (f32x2_t){bflo(h0.w), bfhi(h0.w)};
          hn[4] = (f32x2_t){bflo(h1.x), bfhi(h1.x)}; hn[5] = (f32x2_t){bflo(h1.y), bfhi(h1.y)}; hn[6] = (f32x2_t){bflo(h1.z), bfhi(h1.z)}; hn[7] = (f32x2_t){bflo(h1.w), bfhi(h1.w)};
          const float rs2 = rsqrtf(ss2[base + s] * (1.0f / 1024.f) + 1e-6f) * PX_SCALE;
#pragma unroll
          for (int q = 0; q < 8; ++q) hn[q] = hn[q] * gf[q] * rs2;
          int w0 = 0, w1 = 0, w2 = 0, w3 = 0;
          w0 = __builtin_amdgcn_cvt_pk_fp8_f32(hn[0].x, hn[0].y, w0, false); w0 = __builtin_amdgcn_cvt_pk_fp8_f32(hn[1].x, hn[1].y, w0, true);
          w1 = __builtin_amdgcn_cvt_pk_fp8_f32(hn[2].x, hn[2].y, w1, false); w1 = __builtin_amdgcn_cvt_pk_fp8_f32(hn[3].x, hn[3].y, w1, true);
          w2 = __builtin_amdgcn_cvt_pk_fp8_f32(hn[4].x, hn[4].y, w2, false); w2 = __builtin_amdgcn_cvt_pk_fp8_f32(hn[5].x, hn[5].y, w2, true);
          w3 = __builtin_amdgcn_cvt_pk_fp8_f32(hn[6].x, hn[6].y, w3, false); w3 = __builtin_amdgcn_cvt_pk_fp8_f32(hn[7].x, hn[7].y, w3, true);
          xb0[s] = (long)(((unsigned long)(unsigned)w1 << 32) | (unsigned long)(unsigned)w0);
          xb1[s] = (long)(((unsigned long)(unsigned)w3 << 32) | (unsigned long)(unsigned)w2);
        }
      }
      const bool dg = (lane >> 4) == ((lane >> 2) & 3);
      const f32x2_t m01 = {(dg && (lane & 3) == 0) ? 1.f : 0.f, (dg && (lane & 3) == 1) ? 1.f : 0.f}, m23 = {(dg && (lane & 3) == 2) ? 1.f : 0.f, (dg && (lane & 3) == 3) ? 1.f : 0.f};
      constexpr int STEPU = NBU / NS, LPGU = 64 / NBU;
      const unsigned lo16 = (unsigned)lane << 4;
#define U_LOAD(buf, ii) _Pragma("unroll") for (int k = 0; k < NBU; ++k) { const unsigned e = se[(k % NS) * 128 + (ii) + (k / NS)]; buf[k] = *(const uint4*)(PU8 + ((e << 10) | lo16)); }
#define U_COMP(buf, ii) { float d[NBU]; \
        _Pragma("unroll") for (int k = 0; k < NBU; ++k) { \
          const long a0 = (long)(((unsigned long)buf[k].y << 32) | (unsigned long)buf[k].x), a1 = (long)(((unsigned long)buf[k].w << 32) | (unsigned long)buf[k].z); \
          f32x4 acc = {0.f, 0.f, 0.f, 0.f}; \
          acc = __builtin_amdgcn_mfma_f32_16x16x32_fp8_fp8(a0, xb0[k % NS], acc, 0, 0, 0); \
          acc = __builtin_amdgcn_mfma_f32_16x16x32_fp8_fp8(a1, xb1[k % NS], acc, 0, 0, 0); \
          const f32x2_t t = (f32x2_t){acc[0], acc[1]} * m01 + (f32x2_t){acc[2], acc[3]} * m23; \
          d[k] = t.x + t.y; } \
        const float r1 = treduce<NBU>(d, lane); \
        const int kk = lane / LPGU; \
        const int pos = (kk % NS) * 128 + (ii) + (kk / NS); \
        const float wgt = sw[pos] * gelu_tanh(r1 * (1.0f / (PU_SCALE * PX_SCALE))); \
        if ((lane % LPGU) == 0) sw[pos] = wgt; }
      uint4 ua[NBU], ub[NBU];
      U_LOAD(ua, 0)
#pragma unroll 1
      for (int i = 0; i < 128; i += 2 * STEPU) {
        U_LOAD(ub, i + STEPU)
        __builtin_amdgcn_sched_barrier(0);
        U_COMP(ua, i)
        __builtin_amdgcn_sched_barrier(0);
        const int ni = (i + 2 * STEPU < 128) ? i + 2 * STEPU : i;
        U_LOAD(ua, ni)
        __builtin_amdgcn_sched_barrier(0);
        U_COMP(ub, i + STEPU)
        __builtin_amdgcn_sched_barrier(0);
      }
#undef U_LOAD
#undef U_COMP
    }
    wave_lds_sync();
    f32x2_t acc[NS][8];
#pragma unroll
    for (int s = 0; s < NS; ++s)
#pragma unroll
      for (int q = 0; q < 8; ++q) acc[s][q] = (f32x2_t){0.f, 0.f};
    {
      const unsigned lo8 = (unsigned)lane << 3;
#define V_LOAD(buf, ii) _Pragma("unroll") for (int k = 0; k < NB; ++k) { const unsigned e = se[(k % NS) * 128 + (ii) + (k / NS)]; buf[k] = *(const u32x2_t*)(PV8 + ((e << 9) | lo8)); }
#define V_COMP(buf, ii) _Pragma("unroll") for (int k = 0; k < NB; ++k) axpy16_fp4_pk(buf[k], sw[(k % NS) * 128 + (ii) + (k / NS)], acc[k % NS]);
      u32x2_t va[NB], vb[NB];
      V_LOAD(va, 0)
#pragma unroll 1
      for (int i = 0; i < 128; i += 2 * STEP) {
        V_LOAD(vb, i + STEP)
        __builtin_amdgcn_sched_barrier(0);
        V_COMP(va, i)
        __builtin_amdgcn_sched_barrier(0);
        const int ni = (i + 2 * STEP < 128) ? i + 2 * STEP : i;
        V_LOAD(va, ni)
        __builtin_amdgcn_sched_barrier(0);
        V_COMP(vb, i + STEP)
        __builtin_amdgcn_sched_barrier(0);
      }
#undef V_LOAD
#undef V_COMP
    }
#pragma unroll
    for (int s = 0; s < NS; ++s) {
      float* hq = Hout + (size_t)(base + s) * 1024 + 16 * lane;
      float4 a[4]; float ss = 0.f;
#if RES_BF16
      const uint4 r0 = *(const uint4*)(HN + (size_t)(base + s) * 1024 + 16 * lane), r1 = *(const uint4*)(HN + (size_t)(base + s) * 1024 + 16 * lane + 8);
      a[0] = make_float4(bflo(r0.x), bfhi(r0.x), bflo(r0.y), bfhi(r0.y)); a[1] = make_float4(bflo(r0.z), bfhi(r0.z), bflo(r0.w), bfhi(r0.w));
      a[2] = make_float4(bflo(r1.x), bfhi(r1.x), bflo(r1.y), bfhi(r1.y)); a[3] = make_float4(bflo(r1.z), bfhi(r1.z), bflo(r1.w), bfhi(r1.w));
#else
      const float* hp = H + (size_t)(base + s) * 1024 + 16 * lane;
#endif
#pragma unroll
      for (int q = 0; q < 4; ++q) {
#if !RES_BF16
        a[q] = *(const float4*)(hp + 4 * q);
#endif
        a[q].x += acc[s][2 * q].x * (1.0f / PV4_SCALE); a[q].y += acc[s][2 * q].y * (1.0f / PV4_SCALE); a[q].z += acc[s][2 * q + 1].x * (1.0f / PV4_SCALE); a[q].w += acc[s][2 * q + 1].y * (1.0f / PV4_SCALE);
        ss += a[q].x * a[q].x + a[q].y * a[q].y + a[q].z * a[q].z + a[q].w * a[q].w;
      }
      ss = wave_sum(ss);
      const float r = rsqrtf(ss / 1024.f + 1e-6f);
#ifdef PROBE_VARRATIO
      float pp = 0.f;
#pragma unroll
      for (int q = 0; q < 8; ++q) pp += acc[s][q].x * acc[s][q].x + acc[s][q].y * acc[s][q].y;
      pp = wave_sum(pp) * (1.0f / (PV4_SCALE * PV4_SCALE));
      const float cst = 10.0f * sqrtf(pp / ss);
#pragma unroll
      for (int q = 0; q < 4; ++q) *(float4*)(hq + 4 * q) = make_float4(cst, cst, cst, cst);
#else
#pragma unroll
      for (int q = 0; q < 4; ++q) {
        const float4 g = *(const float4*)(gfin + 16 * lane + 4 * q);
        a[q].x *= r * g.x; a[q].y *= r * g.y; a[q].z *= r * g.z; a[q].w *= r * g.w;
        *(float4*)(hq + 4 * q) = a[q];
      }
#endif
    }
    wave_lds_sync();
  }
}

#ifndef PU4_SCALE
#define PU4_SCALE 64.0f
#endif
typedef int i32x8_t __attribute__((ext_vector_type(8)));
typedef unsigned u32x4_t __attribute__((ext_vector_type(4)));
template <int NS, int NB, int NBU>
__device__ void ph_gather14(const bf16_t* __restrict__ HN, const int* __restrict__ EXP, const float* __restrict__ GATE,
                           const unsigned char* __restrict__ PU8, const unsigned char* __restrict__ PV8,
                           const float* __restrict__ gfin, const float* H, float* Hout, unsigned char* lds,
                           const float* __restrict__ ss2, const float* __restrict__ gffn) {
  int tid_ = threadIdx.x; asm volatile("" : "+v"(tid_));
  const int wv = tid_ >> 6, lane = tid_ & 63;
  unsigned* se = (unsigned*)(lds + wv * (NS * 1024));
  float* sw = (float*)(lds + wv * (NS * 1024) + NS * 512);
  constexpr int STEP = NB / NS;
  constexpr int LPG = 64 / NB;
  for (int base = (blockIdx.x * NWAVE + wv) * NS; base < NTOK; base += gridDim.x * NWAVE * NS) {
#pragma unroll 1
    for (int s = 0; s < NS; ++s) {
      const int tok = base + s;
      unsigned k0 = ((unsigned)EXP[(size_t)tok * 128 + lane] << 7) | (unsigned)lane;
      unsigned k1 = ((unsigned)EXP[(size_t)tok * 128 + 64 + lane] << 7) | (unsigned)(64 + lane);
      wave_sort128(k0, k1, lane);
      se[s * 128 + lane] = k0 >> 7; se[s * 128 + 64 + lane] = k1 >> 7;
      sw[s * 128 + lane] = GATE[(size_t)tok * 128 + (k0 & 127u)]; sw[s * 128 + 64 + lane] = GATE[(size_t)tok * 128 + (k1 & 127u)];
    }
    wave_lds_sync();
    {
      static_assert(NS == 4, "layout");
      const int tc = lane & 7, tg = lane >> 4, th = (lane >> 3) & 1;
      const unsigned l32 = 8u * tg + tc;
      i32x8_t xb[NS];
      {
        const int e0 = 256 * (tg >> 1) + 32 * tc + 16 * (tg & 1);
        const float* gfp = gffn + e0; asm volatile("" : "+v"(gfp));
        f32x4 gq[8];
#pragma unroll
        for (int q = 0; q < 4; ++q) { gq[2 * q] = *(const f32x4*)(gfp + (q >> 1) * 512 + (q & 1) * 8); gq[2 * q + 1] = *(const f32x4*)(gfp + (q >> 1) * 512 + (q & 1) * 8 + 4); }
#pragma unroll
        for (int s = 0; s < NS; ++s) {
          const bf16_t* hp = HN + (size_t)(base + s) * 1024 + e0;
          const float rs2 = rsqrtf(ss2[base + s] * (1.0f / 1024.f) + 1e-6f) * PX_SCALE;
#pragma unroll
          for (int q = 0; q < 4; ++q) {
            const uint4 h = *(const uint4*)(hp + (q >> 1) * 512 + (q & 1) * 8);
            const float v0 = bflo(h.x) * gq[2 * q][0] * rs2, v1 = bfhi(h.x) * gq[2 * q][1] * rs2, v2 = bflo(h.y) * gq[2 * q][2] * rs2, v3 = bfhi(h.y) * gq[2 * q][3] * rs2;
            const float v4 = bflo(h.z) * gq[2 * q + 1][0] * rs2, v5 = bfhi(h.z) * gq[2 * q + 1][1] * rs2, v6 = bflo(h.w) * gq[2 * q + 1][2] * rs2, v7 = bfhi(h.w) * gq[2 * q + 1][3] * rs2;
            int w0 = 0, w1 = 0;
            w0 = __builtin_amdgcn_cvt_pk_fp8_f32(v0, v1, w0, false); w0 = __builtin_amdgcn_cvt_pk_fp8_f32(v2, v3, w0, true);
            w1 = __builtin_amdgcn_cvt_pk_fp8_f32(v4, v5, w1, false); w1 = __builtin_amdgcn_cvt_pk_fp8_f32(v6, v7, w1, true);
            xb[s][2 * q] = w0; xb[s][2 * q + 1] = w1;
          }
        }
      }
      const bool dg = (lane >> 4) == ((lane >> 2) & 3);
      const f32x2_t m01 = {(dg && (lane & 3) == 0) ? 1.f : 0.f, (dg && (lane & 3) == 1) ? 1.f : 0.f}, m23 = {(dg && (lane & 3) == 2) ? 1.f : 0.f, (dg && (lane & 3) == 3) ? 1.f : 0.f};
      const unsigned lo16 = 16u * l32;
      const unsigned* seh = se + th;
#define U_LOAD(buf, ii) _Pragma("unroll") for (int k = 0; k < 8; ++k) { const unsigned e = seh[(k % NS) * 128 + (ii) + 2 * (k / NS)]; buf[k] = *(const u32x4_t*)(PU8 + ((e << 9) | lo16)); }
#define U_COMP(buf, ii) { float d[8]; \
        _Pragma("unroll") for (int k = 0; k < 8; ++k) { \
          const i32x8_t a = {(int)buf[k][0], (int)buf[k][1], (int)buf[k][2], (int)buf[k][3], 0, 0, 0, 0}; \
          f32x4 acc = {0.f, 0.f, 0.f, 0.f}; \
          acc = __builtin_amdgcn_mfma_scale_f32_16x16x128_f8f6f4(a, xb[k % NS], acc, 4, 0, 0, 0, 0, 0); \
          const f32x2_t t = (f32x2_t){acc[0], acc[1]} * m01 + (f32x2_t){acc[2], acc[3]} * m23; \
          d[k] = t.x + t.y; } \
        const float r1 = treduce_lvl<8, 16>(d, lane);             \
        const int kk = (lane >> 2) & 7; \
        const int pos = (kk % NS) * 128 + (ii) + 2 * (kk / NS) + (lane >> 5); \
        const float wgt = sw[pos] * gelu_tanh(r1 * (1.0f / (PU4_SCALE * PX_SCALE))); \
        if ((lane & 3) == 0) sw[pos] = wgt; }
      u32x4_t ua[8], ub[8];
      U_LOAD(ua, 0)
#pragma unroll 1
      for (int i = 0; i < 128; i += 8) {
        U_LOAD(ub, i + 4)
        __builtin_amdgcn_sched_barrier(0);
        U_COMP(ua, i)
        __builtin_amdgcn_sched_barrier(0);
        const int ni = (i + 8 < 128) ? i + 8 : i;
        U_LOAD(ua, ni)
        __builtin_amdgcn_sched_barrier(0);
        U_COMP(ub, i + 4)
        __builtin_amdgcn_sched_barrier(0);
      }
#undef U_LOAD
#undef U_COMP
    }
    wave_lds_sync();
    f32x2_t acc[NS][8];
#pragma unroll
    for (int s = 0; s < NS; ++s)
#pragma unroll
      for (int q = 0; q < 8; ++q) acc[s][q] = (f32x2_t){0.f, 0.f};
    {
      const unsigned lo8 = (unsigned)lane << 3;
#define V_LOAD(buf, ii) _Pragma("unroll") for (int k = 0; k < NB; ++k) { const unsigned e = se[(k % NS) * 128 + (ii) + (k / NS)]; buf[k] = *(const u32x2_t*)(PV8 + ((e << 9) | lo8)); }
#define V_COMP(buf, ii) _Pragma("unroll") for (int k = 0; k < NB; ++k) axpy16_fp4_pk(buf[k], sw[(k % NS) * 128 + (ii) + (k / NS)], acc[k % NS]);
      u32x2_t va[NB], vb[NB];
      V_LOAD(va, 0)
#pragma unroll 1
      for (int i = 0; i < 128; i += 2 * STEP) {
        V_LOAD(vb, i + STEP)
        __builtin_amdgcn_sched_barrier(0);
        V_COMP(va, i)
        __builtin_amdgcn_sched_barrier(0);
        const int ni = (i + 2 * STEP < 128) ? i + 2 * STEP : i;
        V_LOAD(va, ni)
        __builtin_amdgcn_sched_barrier(0);
        V_COMP(vb, i + STEP)
        __builtin_amdgcn_sched_barrier(0);
      }
#undef V_LOAD
#undef V_COMP
    }
#pragma unroll
    for (int s = 0; s < NS; ++s) {
      float* hq = Hout + (size_t)(base + s) * 1024 + 16 * lane;
      float4 a[4]; float ss = 0.f;
#if RES_BF16
      const uint4 r0 = *(const uint4*)(HN + (size_t)(base + s) * 1024 + 16 * lane), r1 = *(const uint4*)(HN + (size_t)(base + s) * 1024 + 16 * lane + 8);
      a[0] = make_float4(bflo(r0.x), bfhi(r0.x), bflo(r0.y), bfhi(r0.y)); a[1] = make_float4(bflo(r0.z), bfhi(r0.z), bflo(r0.w), bfhi(r0.w));
      a[2] = make_float4(bflo(r1.x), bfhi(r1.x), bflo(r1.y), bfhi(r1.y)); a[3] = make_float4(bflo(r1.z), bfhi(r1.z), bflo(r1.w), bfhi(r1.w));
#else
      const float* hp = H + (size_t)(base + s) * 1024 + 16 * lane;
#endif
#pragma unroll
      for (int q = 0; q < 4; ++q) {
#if !RES_BF16
        a[q] = *(const float4*)(hp + 4 * q);
#endif
        a[q].x += acc[s][2 * q].x * (1.0f / PV4_SCALE); a[q].y += acc[s][2 * q].y * (1.0f / PV4_SCALE); a[q].z += acc[s][2 * q + 1].x * (1.0f / PV4_SCALE); a[q].w += acc[s][2 * q + 1].y * (1.0f / PV4_SCALE);
        ss += a[q].x * a[q].x + a[q].y * a[q].y + a[q].z * a[q].z + a[q].w * a[q].w;
      }
      ss = wave_sum(ss);
      const float r = rsqrtf(ss / 1024.f + 1e-6f);
#ifdef PROBE_VARRATIO
      float pp = 0.f;
#pragma unroll
      for (int q = 0; q < 8; ++q) pp += acc[s][q].x * acc[s][q].x + acc[s][q].y * acc[s][q].y;
      pp = wave_sum(pp) * (1.0f / (PV4_SCALE * PV4_SCALE));
#ifdef PROBE_MFMA4
      const float cst = (float)__hip_atomic_load(DBG_CNT_PTR, __ATOMIC_RELAXED, __HIP_MEMORY_SCOPE_AGENT) + 0.f * pp;
#else
      const float cst = 10.0f * sqrtf(pp / ss);
#endif
#pragma unroll
      for (int q = 0; q < 4; ++q) *(float4*)(hq + 4 * q) = make_float4(cst, cst, cst, cst);
#else
#pragma unroll
      for (int q = 0; q < 4; ++q) {
        const float4 g = *(const float4*)(gfin + 16 * lane + 4 * q);
        a[q].x *= r * g.x; a[q].y *= r * g.y; a[q].z *= r * g.z; a[q].w *= r * g.w;
        *(float4*)(hq + 4 * q) = a[q];
      }
#endif
    }
    wave_lds_sync();
  }
}

#ifdef PROBE_MFMA4
__device__ unsigned probe_mfma4(unsigned char* lds) {
  const int lane = threadIdx.x & 63;
  unsigned* LA = (unsigned*)lds; unsigned* LB = (unsigned*)lds + 256;
  unsigned a[4], b[8];
  unsigned st = (unsigned)lane * 2654435761u + 12345u;
#pragma unroll
  for (int r = 0; r < 4; ++r) { unsigned w = 0; for (int nb = 0; nb < 8; ++nb) { st = st * 1664525u + 1013904223u; const unsigned v = (st >> 24) % 3u; w |= (v * 2u) << (4 * nb); } a[r] = w; LA[lane * 4 + r] = w; }
#pragma unroll
  for (int r = 0; r < 8; ++r) { unsigned w = 0; for (int bb = 0; bb < 4; ++bb) { st = st * 1664525u + 1013904223u; const unsigned v = (st >> 24) & 3u; const unsigned code = v == 0 ? 0u : v == 1 ? 0x38u : v == 2 ? 0x40u : 0x44u; w |= code << (8 * bb); } b[r] = w; LB[lane * 8 + r] = w; }
  wave_lds_sync();
  const i32x8_t A = {(int)a[0], (int)a[1], (int)a[2], (int)a[3], 0, 0, 0, 0}, B = {(int)b[0], (int)b[1], (int)b[2], (int)b[3], (int)b[4], (int)b[5], (int)b[6], (int)b[7]};
  f32x4 D = {0.f, 0.f, 0.f, 0.f};
  D = __builtin_amdgcn_mfma_scale_f32_16x16x128_f8f6f4(A, B, D, 4, 0, 0, 0, 0, 0);
  const int n = lane & 15, q = lane >> 4;
  unsigned code = 0;
#pragma unroll 1
  for (int h = 6; h >= 1; --h) {
    const bool aswap = (h == 2 || h == 6), ahalf = (h == 4 || h == 5), bhalf = (h == 3 || h == 5 || h == 6);
    bool ok = true;
#pragma unroll
    for (int jj = 0; jj < 4; ++jj) {
      const int row = 4 * q + jj;
      float E = 0.f;
#pragma unroll 1
      for (int gj = 0; gj < 128; ++gj) {
        const int g = gj >> 5, j = gj & 31;
        const unsigned wa = LA[(16 * g + row) * 4 + (j >> 3)];
        const float av = 0.5f * (float)((wa >> (4 * (j & 7))) & 15u);
        const int je = aswap ? (j ^ 1) : j;
        const int k = ahalf ? (je < 16 ? 16 * g + je : 64 + 16 * g + (je - 16)) : 32 * g + je;
        int g2, j2;
        if (bhalf) { if (k < 64) { g2 = k >> 4; j2 = k & 15; } else { g2 = (k - 64) >> 4; j2 = 16 + ((k - 64) & 15); } }
        else { g2 = k >> 5; j2 = k & 31; }
        const unsigned wb = LB[(16 * g2 + n) * 8 + (j2 >> 2)];
        const unsigned by = (wb >> (8 * (j2 & 3))) & 255u;
        const float bv = by == 0u ? 0.f : by == 0x38u ? 1.f : by == 0x40u ? 2.f : 3.f;
        E += av * bv;
      }
      ok = ok && (E == D[jj]);
    }
    if (__all(ok)) code = (unsigned)h;
  }
  if (code == 0u && __all(D[0] == 0.f && D[1] == 0.f && D[2] == 0.f && D[3] == 0.f)) code = 7u;
  return code;
}
#endif

#ifndef PW_SCALE
#define PW_SCALE 64.0f
#endif
typedef float f32x16_t __attribute__((ext_vector_type(16)));
template <int NS, int NB, int NBU>
__device__ void ph_gather17(const bf16_t* __restrict__ HN, const int* __restrict__ EXP, const float* __restrict__ GATE,
                           const unsigned char* __restrict__ PU8, const unsigned char* __restrict__ PV8,
                           const float* __restrict__ gfin, const float* H, float* Hout, unsigned char* lds,
                           const float* __restrict__ ss2, const float* __restrict__ gffn) {
  int tid_ = threadIdx.x; asm volatile("" : "+v"(tid_));
  const int wv = tid_ >> 6, lane = tid_ & 63;
  unsigned* se = (unsigned*)(lds + wv * 8192);
  float* sw = (float*)(lds + wv * 8192 + 2048);
  float* stg = (float*)(lds + wv * 8192 + 4096);
  constexpr int STEP = NB / NS;
  constexpr int LPG = 64 / NB;
  for (int base = (blockIdx.x * NWAVE + wv) * NS; base < NTOK; base += gridDim.x * NWAVE * NS) {
#pragma unroll 1
    for (int s = 0; s < NS; ++s) {
      const int tok = base + s;
      unsigned k0 = ((unsigned)EXP[(size_t)tok * 128 + lane] << 7) | (unsigned)lane;
      unsigned k1 = ((unsigned)EXP[(size_t)tok * 128 + 64 + lane] << 7) | (unsigned)(64 + lane);
      wave_sort128(k0, k1, lane);
      se[s * 128 + lane] = k0 >> 7; se[s * 128 + 64 + lane] = k1 >> 7;
      sw[s * 128 + lane] = GATE[(size_t)tok * 128 + (k0 & 127u)]; sw[s * 128 + 64 + lane] = GATE[(size_t)tok * 128 + (k1 & 127u)];
    }
    wave_lds_sync();
    {
      static_assert(NS == 4, "layout");
      const int tc = lane & 7, tg = lane >> 4, th = (lane >> 3) & 1;
      const unsigned l32 = 8u * tg + tc;
      i32x8_t xb[NS];
      {
        const int e0 = 256 * (tg >> 1) + 32 * tc + 16 * (tg & 1);
        const float* gfp = gffn + e0; asm volatile("" : "+v"(gfp));
        f32x4 gq[8];
#pragma unroll
        for (int q = 0; q < 4; ++q) { gq[2 * q] = *(const f32x4*)(gfp + (q >> 1) * 512 + (q & 1) * 8); gq[2 * q + 1] = *(const f32x4*)(gfp + (q >> 1) * 512 + (q & 1) * 8 + 4); }
#pragma unroll
        for (int s = 0; s < NS; ++s) {
          const bf16_t* hp = HN + (size_t)(base + s) * 1024 + e0;
          const float rs2 = rsqrtf(ss2[base + s] * (1.0f / 1024.f) + 1e-6f) * PX_SCALE;
#pragma unroll
          for (int q = 0; q < 4; ++q) {
            const uint4 h = *(const uint4*)(hp + (q >> 1) * 512 + (q & 1) * 8);
            const float v0 = bflo(h.x) * gq[2 * q][0] * rs2, v1 = bfhi(h.x) * gq[2 * q][1] * rs2, v2 = bflo(h.y) * gq[2 * q][2] * rs2, v3 = bfhi(h.y) * gq[2 * q][3] * rs2;
            const float v4 = bflo(h.z) * gq[2 * q + 1][0] * rs2, v5 = bfhi(h.z) * gq[2 * q + 1][1] * rs2, v6 = bflo(h.w) * gq[2 * q + 1][2] * rs2, v7 = bfhi(h.w) * gq[2 * q + 1][3] * rs2;
            int w0 = 0, w1 = 0;
            w0 = __builtin_amdgcn_cvt_pk_fp8_f32(v0, v1, w0, false); w0 = __builtin_amdgcn_cvt_pk_fp8_f32(v2, v3, w0, true);
            w1 = __builtin_amdgcn_cvt_pk_fp8_f32(v4, v5, w1, false); w1 = __builtin_amdgcn_cvt_pk_fp8_f32(v6, v7, w1, true);
            xb[s][2 * q] = w0; xb[s][2 * q + 1] = w1;
          }
        }
      }
      const bool dg = (lane >> 4) == ((lane >> 2) & 3);
      const f32x2_t m01 = {(dg && (lane & 3) == 0) ? 1.f : 0.f, (dg && (lane & 3) == 1) ? 1.f : 0.f}, m23 = {(dg && (lane & 3) == 2) ? 1.f : 0.f, (dg && (lane & 3) == 3) ? 1.f : 0.f};
      const unsigned lo16 = 16u * l32;
      const unsigned* seh = se + th;
#define U_LOAD(buf, ii) _Pragma("unroll") for (int k = 0; k < 8; ++k) { const unsigned e = seh[(k % NS) * 128 + (ii) + 2 * (k / NS)]; buf[k] = *(const u32x4_t*)(PU8 + ((e << 9) | lo16)); }
#define U_COMP(buf, ii) { float d[8]; \
        _Pragma("unroll") for (int k = 0; k < 8; ++k) { \
          const i32x8_t a = {(int)buf[k][0], (int)buf[k][1], (int)buf[k][2], (int)buf[k][3], 0, 0, 0, 0}; \
          f32x4 acc = {0.f, 0.f, 0.f, 0.f}; \
          acc = __builtin_amdgcn_mfma_scale_f32_16x16x128_f8f6f4(a, xb[k % NS], acc, 4, 0, 0, 0, 0, 0); \
          const f32x2_t t = (f32x2_t){acc[0], acc[1]} * m01 + (f32x2_t){acc[2], acc[3]} * m23; \
          d[k] = t.x + t.y; } \
        const float r1 = treduce_lvl<8, 16>(d, lane);             \
        const int kk = (lane >> 2) & 7; \
        const int pos = (kk % NS) * 128 + (ii) + 2 * (kk / NS) + (lane >> 5); \
        const float wgt = sw[pos] * gelu_tanh(r1 * (1.0f / (PU4_SCALE * PX_SCALE))); \
        const unsigned w8 = (unsigned)__builtin_amdgcn_cvt_pk_fp8_f32(wgt * PW_SCALE, 0.f, 0, false) & 255u; \
        if ((lane & 3) == 0) ((unsigned*)sw)[pos] = w8 * 0x01010101u; }
      u32x4_t ua[8], ub[8];
      U_LOAD(ua, 0)
#pragma unroll 1
      for (int i = 0; i < 128; i += 8) {
        U_LOAD(ub, i + 4)
        __builtin_amdgcn_sched_barrier(0);
        U_COMP(ua, i)
        __builtin_amdgcn_sched_barrier(0);
        const int ni = (i + 8 < 128) ? i + 8 : i;
        U_LOAD(ua, ni)
        __builtin_amdgcn_sched_barrier(0);
        U_COMP(ub, i + 4)
        __builtin_amdgcn_sched_barrier(0);
      }
#undef U_LOAD
#undef U_COMP
    }
    wave_lds_sync();
    f32x16_t acc[NS];
#pragma unroll
    for (int s = 0; s < NS; ++s)
#pragma unroll
      for (int r = 0; r < 16; ++r) acc[s][r] = 0.f;
    {
      const int vn = lane & 31, vg = lane >> 5;
      const bool act = vg == (vn >> 4);
      unsigned M[4];
#pragma unroll
      for (int d = 0; d < 4; ++d) M[d] = (act && d == ((lane & 15) >> 2)) ? (0xFFu << (8 * (lane & 3))) : 0u;
      const unsigned lo16v = 16u * vn;
      const unsigned* sev = se + vg;
      const unsigned* swr = (const unsigned*)sw;
#define V_LOAD(buf, ii) _Pragma("unroll") for (int k = 0; k < 8; ++k) { const unsigned e = sev[(k & 3) * 128 + (ii) + 2 * (k >> 2)]; buf[k] = *(const u32x4_t*)(PV8 + ((e << 9) | lo16v)); }
#define V_COMP(buf, ii) _Pragma("unroll") for (int k = 0; k < 8; ++k) { \
        const unsigned w0 = swr[(k & 3) * 128 + (ii) + 2 * (k >> 2)], w1 = swr[(k & 3) * 128 + (ii) + 2 * (k >> 2) + 1]; \
        const i32x8_t A = {(int)(w0 & M[0]), (int)(w0 & M[1]), (int)(w0 & M[2]), (int)(w0 & M[3]), (int)(w1 & M[0]), (int)(w1 & M[1]), (int)(w1 & M[2]), (int)(w1 & M[3])}; \
        const i32x8_t B = {(int)buf[k][0], (int)buf[k][1], (int)buf[k][2], (int)buf[k][3], 0, 0, 0, 0}; \
        acc[k & 3] = __builtin_amdgcn_mfma_scale_f32_32x32x64_f8f6f4(A, B, acc[k & 3], 0, 4, 0, 0, 0, 0); }
      u32x4_t va[8], vb[8];
      V_LOAD(va, 0)
#pragma unroll 1
      for (int i = 0; i < 128; i += 8) {
        V_LOAD(vb, i + 4)
        __builtin_amdgcn_sched_barrier(0);
        V_COMP(va, i)
        __builtin_amdgcn_sched_barrier(0);
        const int ni = (i + 8 < 128) ? i + 8 : i;
        V_LOAD(va, ni)
        __builtin_amdgcn_sched_barrier(0);
        V_COMP(vb, i + 4)
        __builtin_amdgcn_sched_barrier(0);
      }
#undef V_LOAD
#undef V_COMP
    }
#pragma unroll
    for (int s = 0; s < NS; ++s) {
      {
        const int vn = lane & 31, vg = lane >> 5;
#pragma unroll
        for (int c = 0; c < 4; ++c) *(float4*)(stg + 32 * vn + 8 * c + 4 * vg) = make_float4(acc[s][4 * c], acc[s][4 * c + 1], acc[s][4 * c + 2], acc[s][4 * c + 3]);
      }
      wave_lds_sync();
      float4 o[4];
#pragma unroll
      for (int q = 0; q < 4; ++q) o[q] = *(const float4*)(stg + 16 * lane + 4 * q);
      wave_lds_sync();
      float* hq = Hout + (size_t)(base + s) * 1024 + 16 * lane;
      float4 a[4]; float ss = 0.f;
      const uint4 r0 = *(const uint4*)(HN + (size_t)(base + s) * 1024 + 16 * lane), r1 = *(const uint4*)(HN + (size_t)(base + s) * 1024 + 16 * lane + 8);
      a[0] = make_float4(bflo(r0.x), bfhi(r0.x), bflo(r0.y), bfhi(r0.y)); a[1] = make_float4(bflo(r0.z), bfhi(r0.z), bflo(r0.w), bfhi(r0.w));
      a[2] = make_float4(bflo(r1.x), bfhi(r1.x), bflo(r1.y), bfhi(r1.y)); a[3] = make_float4(bflo(r1.z), bfhi(r1.z), bflo(r1.w), bfhi(r1.w));
      constexpr float osc = 1.0f / (PV4_SCALE * PW_SCALE);
#pragma unroll
      for (int q = 0; q < 4; ++q) {
        a[q].x += o[q].x * osc; a[q].y += o[q].y * osc; a[q].z += o[q].z * osc; a[q].w += o[q].w * osc;
        ss += a[q].x * a[q].x + a[q].y * a[q].y + a[q].z * a[q].z + a[q].w * a[q].w;
      }
      ss = wave_sum(ss);
      const float r = rsqrtf(ss / 1024.f + 1e-6f);
#pragma unroll
      for (int q = 0; q < 4; ++q) {
        const float4 gg = *(const float4*)(gfin + 16 * lane + 4 * q);
        a[q].x *= r * gg.x; a[q].y *= r * gg.y; a[q].z *= r * gg.z; a[q].w *= r * gg.w;
        *(float4*)(hq + 4 * q) = a[q];
      }
    }
    wave_lds_sync();
  }
}

#ifndef GATH_NU
#define GATH_NU 16
#endif
template <int NS, int NB, int NBU>
__device__ void ph_gather18(const bf16_t* __restrict__ HN, const int* __restrict__ EXP, const float* __restrict__ GATE,
                           const unsigned char* __restrict__ PU8, const unsigned char* __restrict__ PV8,
                           const float* __restrict__ gfin, const float* H, float* Hout, unsigned char* lds,
                           const float* __restrict__ ss2, const float* __restrict__ gffn) {
  int tid_ = threadIdx.x; asm volatile("" : "+v"(tid_));
  const int wv = tid_ >> 6, lane = tid_ & 63;
  unsigned* se = (unsigned*)(lds + wv * 8192);
  float* sw = (float*)(lds + wv * 8192 + 2048);
  float* stg = (float*)(lds + wv * 8192 + 4096);
  constexpr int STEP = NB / NS;
  constexpr int LPG = 64 / NB;
  for (int base = (blockIdx.x * NWAVE + wv) * NS; base < NTOK; base += gridDim.x * NWAVE * NS) {
#pragma unroll 1
    for (int s = 0; s < NS; ++s) {
      const int tok = base + s;
      unsigned k0 = ((unsigned)EXP[(size_t)tok * 128 + lane] << 7) | (unsigned)lane;
      unsigned k1 = ((unsigned)EXP[(size_t)tok * 128 + 64 + lane] << 7) | (unsigned)(64 + lane);
      wave_sort128(k0, k1, lane);
      se[s * 128 + lane] = k0 >> 7; se[s * 128 + 64 + lane] = k1 >> 7;
      sw[s * 128 + lane] = GATE[(size_t)tok * 128 + (k0 & 127u)]; sw[s * 128 + 64 + lane] = GATE[(size_t)tok * 128 + (k1 & 127u)];
    }
    wave_lds_sync();
    {
      static_assert(NS == 4, "layout");
      const int tc = lane & 7, tg = lane >> 4, th = (lane >> 3) & 1;
      const unsigned l32 = 8u * tg + tc;
      i32x8_t xb[NS];
      {
        const int e0 = 256 * (tg >> 1) + 32 * tc + 16 * (tg & 1);
        const float* gfp = gffn + e0; asm volatile("" : "+v"(gfp));
        f32x4 gq[8];
#pragma unroll
        for (int q = 0; q < 4; ++q) { gq[2 * q] = *(const f32x4*)(gfp + (q >> 1) * 512 + (q & 1) * 8); gq[2 * q + 1] = *(const f32x4*)(gfp + (q >> 1) * 512 + (q & 1) * 8 + 4); }
#pragma unroll
        for (int s = 0; s < NS; ++s) {
          const bf16_t* hp = HN + (size_t)(base + s) * 1024 + e0;
          const float rs2 = rsqrtf(ss2[base + s] * (1.0f / 1024.f) + 1e-6f) * PX_SCALE;
#pragma unroll
          for (int q = 0; q < 4; ++q) {
            const uint4 h = *(const uint4*)(hp + (q >> 1) * 512 + (q & 1) * 8);
#define XCL(v) __builtin_amdgcn_fmed3f((v), -440.f, 440.f)
            const float v0 = XCL(bflo(h.x) * gq[2 * q][0] * rs2), v1 = XCL(bfhi(h.x) * gq[2 * q][1] * rs2), v2 = XCL(bflo(h.y) * gq[2 * q][2] * rs2), v3 = XCL(bfhi(h.y) * gq[2 * q][3] * rs2);
            const float v4 = XCL(bflo(h.z) * gq[2 * q + 1][0] * rs2), v5 = XCL(bfhi(h.z) * gq[2 * q + 1][1] * rs2), v6 = XCL(bflo(h.w) * gq[2 * q + 1][2] * rs2), v7 = XCL(bfhi(h.w) * gq[2 * q + 1][3] * rs2);
#undef XCL
            int w0 = 0, w1 = 0;
            w0 = __builtin_amdgcn_cvt_pk_fp8_f32(v0, v1, w0, false); w0 = __builtin_amdgcn_cvt_pk_fp8_f32(v2, v3, w0, true);
            w1 = __builtin_amdgcn_cvt_pk_fp8_f32(v4, v5, w1, false); w1 = __builtin_amdgcn_cvt_pk_fp8_f32(v6, v7, w1, true);
            xb[s][2 * q] = w0; xb[s][2 * q + 1] = w1;
          }
        }
      }
      const bool dg = (lane >> 4) == ((lane >> 2) & 3);
      const f32x2_t m01 = {(dg && (lane & 3) == 0) ? 1.f : 0.f, (dg && (lane & 3) == 1) ? 1.f : 0.f}, m23 = {(dg && (lane & 3) == 2) ? 1.f : 0.f, (dg && (lane & 3) == 3) ? 1.f : 0.f};
      const unsigned lo16 = 16u * l32;
      const unsigned* seh = se + th;
#define U_LOAD(buf, ii) _Pragma("unroll") for (int k = 0; k < NU; ++k) { const unsigned e = seh[(k % NS) * 128 + (ii) + 2 * (k / NS)]; buf[k] = *(const u32x4_t*)(PU8 + ((e << 9) | lo16)); }
#define U_COMP(buf, ii) { float d[NU]; \
        _Pragma("unroll") for (int k = 0; k < NU; ++k) { \
          const i32x8_t a = {(int)buf[k][0], (int)buf[k][1], (int)buf[k][2], (int)buf[k][3], 0, 0, 0, 0}; \
          f32x4 acc = {0.f, 0.f, 0.f, 0.f}; \
          acc = __builtin_amdgcn_mfma_scale_f32_16x16x128_f8f6f4(a, xb[k % NS], acc, 4, 0, 0, 0, 0, 0); \
          const f32x2_t t = (f32x2_t){acc[0], acc[1]} * m01 + (f32x2_t){acc[2], acc[3]} * m23; \
          d[k] = t.x + t.y; } \
        const float r1 = treduce_lvl<NU, 16>(d, lane);            \
        const int kk = (lane & 31) / LPGU2; \
        const int pos = (kk % NS) * 128 + (ii) + 2 * (kk / NS) + (lane >> 5); \
        const float wgt = sw[pos] * gelu_tanh(r1 * (1.0f / (PU4_SCALE * PX_SCALE))); \
        const unsigned w8 = (unsigned)__builtin_amdgcn_cvt_pk_fp8_f32(__builtin_amdgcn_fmed3f(wgt * PW_SCALE, -440.f, 440.f), 0.f, 0, false) & 255u; \
        if ((lane % LPGU2) == 0) ((unsigned*)sw)[pos] = w8 * 0x01010101u; }
      constexpr int NU = GATH_NU, LPGU2 = 32 / NU, PSTEP = NU / 2;
      u32x4_t ua[NU], ub[NU];
      U_LOAD(ua, 0)
#pragma unroll 1
      for (int i = 0; i < 128; i += 2 * PSTEP) {
        U_LOAD(ub, i + PSTEP)
        __builtin_amdgcn_sched_barrier(0);
        U_COMP(ua, i)
        __builtin_amdgcn_sched_barrier(0);
        const int ni = (i + 2 * PSTEP < 128) ? i + 2 * PSTEP : i;
        U_LOAD(ua, ni)
        __builtin_amdgcn_sched_barrier(0);
        U_COMP(ub, i + PSTEP)
        __builtin_amdgcn_sched_barrier(0);
      }
#undef U_LOAD
#undef U_COMP
    }
    wave_lds_sync();
    f32x16_t acc[NS];
#pragma unroll
    for (int s = 0; s < NS; ++s)
#pragma unroll
      for (int r = 0; r < 16; ++r) acc[s][r] = 0.f;
    {
      const int vn = lane & 31, vg = lane >> 5;
      const bool act = vg == (vn >> 4);
      unsigned M[4];
#pragma unroll
      for (int d = 0; d < 4; ++d) M[d] = (act && d == ((lane & 15) >> 2)) ? (0xFFu << (8 * (lane & 3))) : 0u;
      const unsigned lo16v = 16u * vn;
      const unsigned* sev = se + vg;
      const unsigned* swr = (const unsigned*)sw;
#define V_LOAD(buf, ii) _Pragma("unroll") for (int k = 0; k < 8; ++k) { const unsigned e = sev[(k & 3) * 128 + (ii) + 2 * (k >> 2)]; buf[k] = *(const u32x4_t*)(PV8 + ((e << 9) | lo16v)); }
#define V_COMP(buf, ii) _Pragma("unroll") for (int k = 0; k < 8; ++k) { \
        const unsigned w0 = swr[(k & 3) * 128 + (ii) + 2 * (k >> 2)], w1 = swr[(k & 3) * 128 + (ii) + 2 * (k >> 2) + 1]; \
        const i32x8_t A = {(int)(w0 & M[0]), (int)(w0 & M[1]), (int)(w0 & M[2]), (int)(w0 & M[3]), (int)(w1 & M[0]), (int)(w1 & M[1]), (int)(w1 & M[2]), (int)(w1 & M[3])}; \
        const i32x8_t B = {(int)buf[k][0], (int)buf[k][1], (int)buf[k][2], (int)buf[k][3], 0, 0, 0, 0}; \
        acc[k & 3] = __builtin_amdgcn_mfma_scale_f32_32x32x64_f8f6f4(A, B, acc[k & 3], 0, 4, 0, 0, 0, 0); }
      u32x4_t va[8], vb[8];
      V_LOAD(va, 0)
#pragma unroll 1
      for (int i = 0; i < 128; i += 8) {
        V_LOAD(vb, i + 4)
        __builtin_amdgcn_sched_barrier(0);
        V_COMP(va, i)
        __builtin_amdgcn_sched_barrier(0);
        const int ni = (i + 8 < 128) ? i + 8 : i;
        V_LOAD(va, ni)
        __builtin_amdgcn_sched_barrier(0);
        V_COMP(vb, i + 4)
        __builtin_amdgcn_sched_barrier(0);
      }
#undef V_LOAD
#undef V_COMP
    }
#pragma unroll
    for (int s = 0; s < NS; ++s) {
      {
        const int vn = lane & 31, vg = lane >> 5;
#pragma unroll
        for (int c = 0; c < 4; ++c) *(float4*)(stg + 32 * vn + 8 * c + 4 * vg) = make_float4(acc[s][4 * c], acc[s][4 * c + 1], acc[s][4 * c + 2], acc[s][4 * c + 3]);
      }
      wave_lds_sync();
      float4 o[4];
#pragma unroll
      for (int q = 0; q < 4; ++q) o[q] = *(const float4*)(stg + 16 * lane + 4 * q);
      wave_lds_sync();
      float* hq = Hout + (size_t)(base + s) * 1024 + 16 * lane;
      float4 a[4]; float ss = 0.f;
      const uint4 r0 = *(const uint4*)(HN + (size_t)(base + s) * 1024 + 16 * lane), r1 = *(const uint4*)(HN + (size_t)(base + s) * 1024 + 16 * lane + 8);
      a[0] = make_float4(bflo(r0.x), bfhi(r0.x), bflo(r0.y), bfhi(r0.y)); a[1] = make_float4(bflo(r0.z), bfhi(r0.z), bflo(r0.w), bfhi(r0.w));
      a[2] = make_float4(bflo(r1.x), bfhi(r1.x), bflo(r1.y), bfhi(r1.y)); a[3] = make_float4(bflo(r1.z), bfhi(r1.z), bflo(r1.w), bfhi(r1.w));
      constexpr float osc = 1.0f / (PV4_SCALE * PW_SCALE);
#pragma unroll
      for (int q = 0; q < 4; ++q) {
        a[q].x += o[q].x * osc; a[q].y += o[q].y * osc; a[q].z += o[q].z * osc; a[q].w += o[q].w * osc;
        ss += a[q].x * a[q].x + a[q].y * a[q].y + a[q].z * a[q].z + a[q].w * a[q].w;
      }
      ss = wave_sum(ss);
      const float r = rsqrtf(ss / 1024.f + 1e-6f);
#pragma unroll
      for (int q = 0; q < 4; ++q) {
        const float4 gg = *(const float4*)(gfin + 16 * lane + 4 * q);
        a[q].x *= r * gg.x; a[q].y *= r * gg.y; a[q].z *= r * gg.z; a[q].w *= r * gg.w;
#ifdef PROBE_CONST
        { const float cst = (float)__hip_atomic_load(DBG_CNT_PTR, __ATOMIC_RELAXED, __HIP_MEMORY_SCOPE_AGENT) * (1.0f / PROBE_CONST); a[q] = make_float4(cst, cst, cst, cst); }
#endif
        *(float4*)(hq + 4 * q) = a[q];
      }
    }
    wave_lds_sync();
  }
}

template <bool DIAG>
__device__ __forceinline__ void attn_block(bf16x8 (&Kf)[4], bf16x8 (&Vf)[2][2], const bf16x8 (&Qf)[4], f32x16& O0, f32x16& O1, float& Rrun,
                                           int qi, int hh, const bf16_t* Kbase, const bf16_t* Vbase, int knext) {
  f32x16 S;
#pragma unroll
  for (int i = 0; i < 16; ++i) S[i] = 0.f;
#pragma unroll
  for (int s = 0; s < 4; ++s) S = __builtin_amdgcn_mfma_f32_32x32x16_bf16(Kf[s], Qf[s], S, 0, 0, 0);
#pragma unroll
  for (int s = 0; s < 4; ++s) Kf[s] = *(const bf16x8*)(Kbase + (size_t)knext * 2048 + 512 * s);
  float beta[16], rp[16];
  float run = 1.f;
#pragma unroll
  for (int i = 15; i >= 0; --i) {
    const float e = __builtin_amdgcn_exp2f(fminf(S[i] * -0.18033688011112042f, 115.4156f));
    const float r = __builtin_amdgcn_rcpf(1.0f + e), er = e * r;
    if (DIAG) {
      const bool vis = 16 * hh + i < qi;
      beta[i] = vis ? r : 0.f;
      rp[i] = run;
      run *= vis ? er : 1.f;
    } else {
      beta[i] = r;
      rp[i] = run;
      run *= er;
    }
  }
  const float Tp = __shfl_xor(run, 32);
  const float off = Rrun * (hh == 0 ? Tp : 1.f);
  Rrun *= run * Tp;
  unsigned pk[8];
#pragma unroll
  for (int i = 0; i < 16; i += 2) pk[i >> 1] = pg8::cvt_pk_bf16(beta[i] * rp[i] * off, beta[i + 1] * rp[i + 1] * off);
  bf16x8 P0, P1;
  { u32x4 t0 = {pk[0], pk[1], pk[2], pk[3]}, t1 = {pk[4], pk[5], pk[6], pk[7]}; P0 = __builtin_bit_cast(bf16x8, t0); P1 = __builtin_bit_cast(bf16x8, t1); }
  O0 = __builtin_amdgcn_mfma_f32_32x32x16_bf16(Vf[0][0], P0, O0, 0, 0, 0);
  O0 = __builtin_amdgcn_mfma_f32_32x32x16_bf16(Vf[0][1], P1, O0, 0, 0, 0);
  O1 = __builtin_amdgcn_mfma_f32_32x32x16_bf16(Vf[1][0], P0, O1, 0, 0, 0);
  O1 = __builtin_amdgcn_mfma_f32_32x32x16_bf16(Vf[1][1], P1, O1, 0, 0, 0);
#pragma unroll
  for (int mb = 0; mb < 2; ++mb)
#pragma unroll
    for (int s2 = 0; s2 < 2; ++s2) Vf[mb][s2] = *(const bf16x8*)(Vbase + (size_t)knext * 2048 + 1024 * mb + 512 * s2);
}
__device__ void ph_attn(const bf16_t* __restrict__ Qfr, const bf16_t* __restrict__ Kfr, const bf16_t* __restrict__ Vfr, const float* __restrict__ ga,
                        bf16_t* __restrict__ MIX, unsigned char* lds) {
  const int h = threadIdx.x >> 6, lane = threadIdx.x & 63, c = lane & 31, hh = lane >> 5;
  float* red = (float*)lds;
  const int kap = 16 * ((c >> 2) & 1) + 4 * (c >> 3) + (c & 3);
  int par = 0;
  for (int unit = blockIdx.x; unit < 512; unit += gridDim.x, par ^= 1) {
    const int b = unit >> 8, ut = unit & 255, qt = (gridDim.x == 256u) ? ((ut & 7) * 32 + (ut >> 3)) : ut, q0 = qt * 32;
    const size_t tb = (size_t)b * SEQ;
    bf16x8 Qf[4];
#pragma unroll
    for (int s = 0; s < 4; ++s) Qf[s] = *(const bf16x8*)(Qfr + (((size_t)(b * 8 + h) * 256 + (q0 >> 5)) * 2048) + 512 * s + 256 * hh + 8 * c);
    f32x16 O0, O1;
#pragma unroll
    for (int i = 0; i < 16; ++i) { O0[i] = 0.f; O1[i] = 0.f; }
    float Rrun = 1.f;
    const bf16_t* Kbase = Kfr + (size_t)(b * 8 + h) * 256 * 2048 + 256 * hh + 8 * c;
    const bf16_t* Vbase = Vfr + (size_t)(b * 8 + h) * 256 * 2048 + 256 * hh + 8 * c;
    bf16x8 KA[4], VA[2][2], KB[4], VB[2][2];
    int kb = q0 >> 5;
    {
      const int k1 = kb > 0 ? kb - 1 : 0;
#pragma unroll
      for (int s = 0; s < 4; ++s) { KA[s] = *(const bf16x8*)(Kbase + (size_t)kb * 2048 + 512 * s); KB[s] = *(const bf16x8*)(Kbase + (size_t)k1 * 2048 + 512 * s); }
#pragma unroll
      for (int mb = 0; mb < 2; ++mb)
#pragma unroll
        for (int s2 = 0; s2 < 2; ++s2) { VA[mb][s2] = *(const bf16x8*)(Vbase + (size_t)kb * 2048 + 1024 * mb + 512 * s2); VB[mb][s2] = *(const bf16x8*)(Vbase + (size_t)k1 * 2048 + 1024 * mb + 512 * s2); }
    }
    attn_block<true>(KA, VA, Qf, O0, O1, Rrun, c, hh, Kbase, Vbase, kb > 1 ? kb - 2 : 0);
    while (!(kb == 0 || __all(Rrun == 0.f))) {
      --kb;
      attn_block<false>(KB, VB, Qf, O0, O1, Rrun, c, hh, Kbase, Vbase, kb > 1 ? kb - 2 : 0);
      if (kb == 0 || __all(Rrun == 0.f)) break;
      --kb;
      attn_block<false>(KA, VA, Qf, O0, O1, Rrun, c, hh, Kbase, Vbase, kb > 1 ? kb - 2 : 0);
    }
    float ss = 0.f;
#pragma unroll
    for (int i = 0; i < 16; ++i) ss += O0[i] * O0[i] + O1[i] * O1[i];
    ss += __shfl_xor(ss, 32);
    if (hh == 0) red[(par * 8 + h) * 32 + c] = ss;
    __syncthreads();
    float tot = 0.f;
#pragma unroll
    for (int k = 0; k < 8; ++k) tot += red[(par * 8 + k) * 32 + c];
    const float rs = rsqrtf(tot * (1.0f / 512.f) + 1e-6f);
    bf16_t* op = MIX + (tb + q0 + c) * 1024 + h * 64 + 4 * hh;
    const float* gp = ga + h * 64 + 4 * hh;
#pragma unroll
    for (int a = 0; a < 4; ++a) {
      const f32x4 g0 = *(const f32x4*)(gp + 8 * a), g1 = *(const f32x4*)(gp + 32 + 8 * a);
      uint2 o0, o1;
      o0.x = pg8::cvt_pk_bf16(O0[4 * a] * rs * g0[0], O0[4 * a + 1] * rs * g0[1]); o0.y = pg8::cvt_pk_bf16(O0[4 * a + 2] * rs * g0[2], O0[4 * a + 3] * rs * g0[3]);
      o1.x = pg8::cvt_pk_bf16(O1[4 * a] * rs * g1[0], O1[4 * a + 1] * rs * g1[1]); o1.y = pg8::cvt_pk_bf16(O1[4 * a + 2] * rs * g1[2], O1[4 * a + 3] * rs * g1[3]);
      *(uint2*)(op + 8 * a) = o0; *(uint2*)(op + 32 + 8 * a) = o1;
    }
  }
  __syncthreads();
}
__device__ void ph_ssmnorm(bf16_t* __restrict__ mix, const float* __restrict__ gs) {
  const int lane = threadIdx.x & 63;
  for (int row = blockIdx.x * NWAVE + (threadIdx.x >> 6); row < NTOK; row += gridDim.x * NWAVE) {
    bf16_t* p = mix + (size_t)row * 1024 + 512 + 8 * lane;
    const uint4 v = *(const uint4*)p;
    float f[8] = {bflo(v.x), bfhi(v.x), bflo(v.y), bfhi(v.y), bflo(v.z), bfhi(v.z), bflo(v.w), bfhi(v.w)};
    float ss = 0.f;
#pragma unroll
    for (int i = 0; i < 8; ++i) ss += f[i] * f[i];
    ss = wave_sum(ss);
    const float r = rsqrtf(ss / 512.f + 1e-6f);
    const float4 g0 = *(const float4*)(gs + 8 * lane), g1 = *(const float4*)(gs + 8 * lane + 4);
    uint4 o;
    o.x = pg8::cvt_pk_bf16(f[0] * r * g0.x, f[1] * r * g0.y); o.y = pg8::cvt_pk_bf16(f[2] * r * g0.z, f[3] * r * g0.w);
    o.z = pg8::cvt_pk_bf16(f[4] * r * g1.x, f[5] * r * g1.y); o.w = pg8::cvt_pk_bf16(f[6] * r * g1.z, f[7] * r * g1.w);
    *(uint4*)p = o;
  }
}

#define XA_ROWB 528
__device__ void ph_xattn(const bf16_t* __restrict__ QX, const bf16_t* __restrict__ KM, const bf16_t* __restrict__ VtM,
                         bf16_t* __restrict__ XO, unsigned char* lds) {
  const int w = threadIdx.x >> 6, lane = threadIdx.x & 63, c = lane & 31, hh = lane >> 5;
  const int kap = 16 * ((c >> 2) & 1) + 4 * (c >> 3) + (c & 3);
  pg8::StaticOrder SO; SO.init(NTOK, 1024, (int)gridDim.x, (int)blockIdx.x);
  pg8::Unit un;
  for (int ui = 0; SO.next(ui, un); ++ui) {
    const int tile = un.pm, h = un.pn, b = tile >> 5;
    const size_t tok = (size_t)tile * 256 + w * 32 + c;
    __syncthreads();
    {
      u32x4 kv[16];
#pragma unroll
      for (int i = 0; i < 16; ++i) { const int ch = threadIdx.x + NTHR * i, row = ch >> 5, c16 = ch & 31; kv[i] = *(const u32x4*)(KM + ((size_t)(b * 256 + row)) * 1024 + h * 256 + c16 * 8); }
      __builtin_amdgcn_sched_barrier(0);
#pragma unroll
      for (int i = 0; i < 16; ++i) { const int ch = threadIdx.x + NTHR * i, row = ch >> 5, c16 = ch & 31; *(u32x4*)(lds + row * XA_ROWB + c16 * 16) = kv[i]; }
    }
    bf16x8 Qf[16];
#pragma unroll
    for (int s = 0; s < 16; ++s) Qf[s] = *(const bf16x8*)(QX + tok * 1024 + h * 256 + 16 * s + 8 * hh);
    __syncthreads();
    f32x16 S[8];
#pragma unroll
    for (int kb = 0; kb < 8; ++kb) {
#pragma unroll
      for (int i = 0; i < 16; ++i) S[kb][i] = 0.f;
#pragma unroll
      for (int s = 0; s < 16; ++s) {
        const bf16x8 kf = *(const bf16x8*)(lds + (32 * kb + kap) * XA_ROWB + (16 * s + 8 * hh) * 2);
        S[kb] = __builtin_amdgcn_mfma_f32_32x32x16_bf16(kf, Qf[s], S[kb], 0, 0, 0);
      }
    }
    float mx = -3.0e38f;
#pragma unroll
    for (int kb = 0; kb < 8; ++kb)
#pragma unroll
      for (int i = 0; i < 16; ++i) mx = fmaxf(mx, S[kb][i]);
    mx = fmaxf(mx, __shfl_xor(mx, 32));
    float sum = 0.f;
    bf16x8 Pf[8][2];
#pragma unroll
    for (int kb = 0; kb < 8; ++kb) {
      unsigned pk[8];
#pragma unroll
      for (int i = 0; i < 16; i += 2) {
        const float p0 = __expf((S[kb][i] - mx) * 0.0625f), p1 = __expf((S[kb][i + 1] - mx) * 0.0625f);
        sum += p0 + p1;
        pk[i >> 1] = pg8::cvt_pk_bf16(p0, p1);
      }
      u32x4 t0 = {pk[0], pk[1], pk[2], pk[3]}, t1 = {pk[4], pk[5], pk[6], pk[7]};
      Pf[kb][0] = __builtin_bit_cast(bf16x8, t0); Pf[kb][1] = __builtin_bit_cast(bf16x8, t1);
    }
    sum += __shfl_xor(sum, 32);
    const float inv = 1.0f / sum;
    __syncthreads();
    {
      u32x4 kv[16];
#pragma unroll
      for (int i = 0; i < 16; ++i) { const int ch = threadIdx.x + NTHR * i, row = ch >> 5, c16 = ch & 31; kv[i] = *(const u32x4*)(VtM + ((size_t)(b * 1024 + h * 256 + row)) * 256 + c16 * 8); }
      __builtin_amdgcn_sched_barrier(0);
#pragma unroll
      for (int i = 0; i < 16; ++i) { const int ch = threadIdx.x + NTHR * i, row = ch >> 5, c16 = ch & 31; *(u32x4*)(lds + row * XA_ROWB + c16 * 16) = kv[i]; }
    }
    __syncthreads();
    bf16_t* op = XO + tok * 1024 + h * 256 + 4 * hh;
#pragma unroll
    for (int mb = 0; mb < 8; ++mb) {
      f32x16 O;
#pragma unroll
      for (int i = 0; i < 16; ++i) O[i] = 0.f;
#pragma unroll
      for (int kb = 0; kb < 8; ++kb)
#pragma unroll
        for (int s2 = 0; s2 < 2; ++s2) {
          const bf16x8 vf = *(const bf16x8*)(lds + (32 * mb + c) * XA_ROWB + (32 * kb + 16 * hh + 8 * s2) * 2);
          O = __builtin_amdgcn_mfma_f32_32x32x16_bf16(vf, Pf[kb][s2], O, 0, 0, 0);
        }
#pragma unroll
      for (int a = 0; a < 4; ++a) {
        uint2 o;
        o.x = pg8::cvt_pk_bf16(O[4 * a] * inv, O[4 * a + 1] * inv); o.y = pg8::cvt_pk_bf16(O[4 * a + 2] * inv, O[4 * a + 3] * inv);
        *(uint2*)(op + 32 * mb + 8 * a) = o;
      }
    }
  }
  __syncthreads();
}
struct GEpiXkv {
  static constexpr bool PERM = true, AFTER_DRAIN = false;
  bf16_t* km; bf16_t* vtm;
  __device__ __forceinline__ void operator()(const f32x4 (&acc)[2][2][4][2], const pg8::Unit& un, int wr, int wc, int fr, int fq) const {
    const int row0 = un.pm * 256 + wr * 64 + fr, col0 = un.pn * 256 + wc * 32 + 8 * fq;
#pragma unroll
    for (int ai = 0; ai < 2; ++ai)
#pragma unroll
      for (int m = 0; m < 4; ++m) {
        const int row = row0 + ai * 128 + m * 16;
#pragma unroll
        for (int bj = 0; bj < 2; ++bj) *(u32x4*)(km + (size_t)row * 1024 + col0 + bj * 128) = pack8(acc[ai][bj][m][0], acc[ai][bj][m][1]);
      }
  }
};
struct GEpiXvT {
  static constexpr bool PERM = true, AFTER_DRAIN = false;
  bf16_t* vtm;
  __device__ __forceinline__ void operator()(const f32x4 (&acc)[2][2][4][2], const pg8::Unit& un, int wr, int wc, int fr, int fq) const {
    const int row0 = un.pm * 256 + wr * 64 + fr, col0 = un.pn * 256 + wc * 32 + 8 * fq;
#pragma unroll
    for (int ai = 0; ai < 2; ++ai)
#pragma unroll
      for (int m = 0; m < 4; ++m) {
        const int vc = row0 + ai * 128 + m * 16;
#pragma unroll
        for (int bj = 0; bj < 2; ++bj) {
          const int cn = col0 + bj * 128, b = cn >> 8, key = cn & 255;
          *(u32x4*)(vtm + ((size_t)(b * 1024 + vc)) * 256 + key) = pack8(acc[ai][bj][m][0], acc[ai][bj][m][1]);
        }
      }
  }
};


__device__ __forceinline__ float pkid(float v, unsigned id, unsigned mask) { return __uint_as_float((__float_as_uint(v) & ~mask) | id); }
__device__ __forceinline__ void sort16_desc(float (&v)[16]) {
  float hi, lo;
  hi = fmaxf(v[0], v[1]); lo = fminf(v[0], v[1]); v[0] = hi; v[1] = lo;
  hi = fmaxf(v[2], v[3]); lo = fminf(v[2], v[3]); v[2] = lo; v[3] = hi;
  hi = fmaxf(v[4], v[5]); lo = fminf(v[4], v[5]); v[4] = hi; v[5] = lo;
  hi = fmaxf(v[6], v[7]); lo = fminf(v[6], v[7]); v[6] = lo; v[7] = hi;
  hi = fmaxf(v[8], v[9]); lo = fminf(v[8], v[9]); v[8] = hi; v[9] = lo;
  hi = fmaxf(v[10], v[11]); lo = fminf(v[10], v[11]); v[10] = lo; v[11] = hi;
  hi = fmaxf(v[12], v[13]); lo = fminf(v[12], v[13]); v[12] = hi; v[13] = lo;
  hi = fmaxf(v[14], v[15]); lo = fminf(v[14], v[15]); v[14] = lo; v[15] = hi;
  hi = fmaxf(v[0], v[2]); lo = fminf(v[0], v[2]); v[0] = hi; v[2] = lo;
  hi = fmaxf(v[1], v[3]); lo = fminf(v[1], v[3]); v[1] = hi; v[3] = lo;
  hi = fmaxf(v[4], v[6]); lo = fminf(v[4], v[6]); v[4] = lo; v[6] = hi;
  hi = fmaxf(v[5], v[7]); lo = fminf(v[5], v[7]); v[5] = lo; v[7] = hi;
  hi = fmaxf(v[8], v[10]); lo = fminf(v[8], v[10]); v[8] = hi; v[10] = lo;
  hi = fmaxf(v[9], v[11]); lo = fminf(v[9], v[11]); v[9] = hi; v[11] = lo;
  hi = fmaxf(v[12], v[14]); lo = fminf(v[12], v[14]); v[12] = lo; v[14] = hi;
  hi = fmaxf(v[13], v[15]); lo = fminf(v[13], v[15]); v[13] = lo; v[15] = hi;
  hi = fmaxf(v[0], v[1]); lo = fminf(v[0], v[1]); v[0] = hi; v[1] = lo;
  hi = fmaxf(v[2], v[3]); lo = fminf(v[2], v[3]); v[2] = hi; v[3] = lo;
  hi = fmaxf(v[4], v[5]); lo = fminf(v[4], v[5]); v[4] = lo; v[5] = hi;
  hi = fmaxf(v[6], v[7]); lo = fminf(v[6], v[7]); v[6] = lo; v[7] = hi;
  hi = fmaxf(v[8], v[9]); lo = fminf(v[8], v[9]); v[8] = hi; v[9] = lo;
  hi = fmaxf(v[10], v[11]); lo = fminf(v[10], v[11]); v[10] = hi; v[11] = lo;
  hi = fmaxf(v[12], v[13]); lo = fminf(v[12], v[13]); v[12] = lo; v[13] = hi;
  hi = fmaxf(v[14], v[15]); lo = fminf(v[14], v[15]); v[14] = lo; v[15] = hi;
  hi = fmaxf(v[0], v[4]); lo = fminf(v[0], v[4]); v[0] = hi; v[4] = lo;
  hi = fmaxf(v[1], v[5]); lo = fminf(v[1], v[5]); v[1] = hi; v[5] = lo;
  hi = fmaxf(v[2], v[6]); lo = fminf(v[2], v[6]); v[2] = hi; v[6] = lo;
  hi = fmaxf(v[3], v[7]); lo = fminf(v[3], v[7]); v[3] = hi; v[7] = lo;
  hi = fmaxf(v[8], v[12]); lo = fminf(v[8], v[12]); v[8] = lo; v[12] = hi;
  hi = fmaxf(v[9], v[13]); lo = fminf(v[9], v[13]); v[9] = lo; v[13] = hi;
  hi = fmaxf(v[10], v[14]); lo = fminf(v[10], v[14]); v[10] = lo; v[14] = hi;
  hi = fmaxf(v[11], v[15]); lo = fminf(v[11], v[15]); v[11] = lo; v[15] = hi;
  hi = fmaxf(v[0], v[2]); lo = fminf(v[0], v[2]); v[0] = hi; v[2] = lo;
  hi = fmaxf(v[1], v[3]); lo = fminf(v[1], v[3]); v[1] = hi; v[3] = lo;
  hi = fmaxf(v[4], v[6]); lo = fminf(v[4], v[6]); v[4] = hi; v[6] = lo;
  hi = fmaxf(v[5], v[7]); lo = fminf(v[5], v[7]); v[5] = hi; v[7] = lo;
  hi = fmaxf(v[8], v[10]); lo = fminf(v[8], v[10]); v[8] = lo; v[10] = hi;
  hi = fmaxf(v[9], v[11]); lo = fminf(v[9], v[11]); v[9] = lo; v[11] = hi;
  hi = fmaxf(v[12], v[14]); lo = fminf(v[12], v[14]); v[12] = lo; v[14] = hi;
  hi = fmaxf(v[13], v[15]); lo = fminf(v[13], v[15]); v[13] = lo; v[15] = hi;
  hi = fmaxf(v[0], v[1]); lo = fminf(v[0], v[1]); v[0] = hi; v[1] = lo;
  hi = fmaxf(v[2], v[3]); lo = fminf(v[2], v[3]); v[2] = hi; v[3] = lo;
  hi = fmaxf(v[4], v[5]); lo = fminf(v[4], v[5]); v[4] = hi; v[5] = lo;
  hi = fmaxf(v[6], v[7]); lo = fminf(v[6], v[7]); v[6] = hi; v[7] = lo;
  hi = fmaxf(v[8], v[9]); lo = fminf(v[8], v[9]); v[8] = lo; v[9] = hi;
  hi = fmaxf(v[10], v[11]); lo = fminf(v[10], v[11]); v[10] = lo; v[11] = hi;
  hi = fmaxf(v[12], v[13]); lo = fminf(v[12], v[13]); v[12] = lo; v[13] = hi;
  hi = fmaxf(v[14], v[15]); lo = fminf(v[14], v[15]); v[14] = lo; v[15] = hi;
  hi = fmaxf(v[0], v[8]); lo = fminf(v[0], v[8]); v[0] = hi; v[8] = lo;
  hi = fmaxf(v[1], v[9]); lo = fminf(v[1], v[9]); v[1] = hi; v[9] = lo;
  hi = fmaxf(v[2], v[10]); lo = fminf(v[2], v[10]); v[2] = hi; v[10] = lo;
  hi = fmaxf(v[3], v[11]); lo = fminf(v[3], v[11]); v[3] = hi; v[11] = lo;
  hi = fmaxf(v[4], v[12]); lo = fminf(v[4], v[12]); v[4] = hi; v[12] = lo;
  hi = fmaxf(v[5], v[13]); lo = fminf(v[5], v[13]); v[5] = hi; v[13] = lo;
  hi = fmaxf(v[6], v[14]); lo = fminf(v[6], v[14]); v[6] = hi; v[14] = lo;
  hi = fmaxf(v[7], v[15]); lo = fminf(v[7], v[15]); v[7] = hi; v[15] = lo;
  hi = fmaxf(v[0], v[4]); lo = fminf(v[0], v[4]); v[0] = hi; v[4] = lo;
  hi = fmaxf(v[1], v[5]); lo = fminf(v[1], v[5]); v[1] = hi; v[5] = lo;
  hi = fmaxf(v[2], v[6]); lo = fminf(v[2], v[6]); v[2] = hi; v[6] = lo;
  hi = fmaxf(v[3], v[7]); lo = fminf(v[3], v[7]); v[3] = hi; v[7] = lo;
  hi = fmaxf(v[8], v[12]); lo = fminf(v[8], v[12]); v[8] = hi; v[12] = lo;
  hi = fmaxf(v[9], v[13]); lo = fminf(v[9], v[13]); v[9] = hi; v[13] = lo;
  hi = fmaxf(v[10], v[14]); lo = fminf(v[10], v[14]); v[10] = hi; v[14] = lo;
  hi = fmaxf(v[11], v[15]); lo = fminf(v[11], v[15]); v[11] = hi; v[15] = lo;
  hi = fmaxf(v[0], v[2]); lo = fminf(v[0], v[2]); v[0] = hi; v[2] = lo;
  hi = fmaxf(v[1], v[3]); lo = fminf(v[1], v[3]); v[1] = hi; v[3] = lo;
  hi = fmaxf(v[4], v[6]); lo = fminf(v[4], v[6]); v[4] = hi; v[6] = lo;
  hi = fmaxf(v[5], v[7]); lo = fminf(v[5], v[7]); v[5] = hi; v[7] = lo;
  hi = fmaxf(v[8], v[10]); lo = fminf(v[8], v[10]); v[8] = hi; v[10] = lo;
  hi = fmaxf(v[9], v[11]); lo = fminf(v[9], v[11]); v[9] = hi; v[11] = lo;
  hi = fmaxf(v[12], v[14]); lo = fminf(v[12], v[14]); v[12] = hi; v[14] = lo;
  hi = fmaxf(v[13], v[15]); lo = fminf(v[13], v[15]); v[13] = hi; v[15] = lo;
  hi = fmaxf(v[0], v[1]); lo = fminf(v[0], v[1]); v[0] = hi; v[1] = lo;
  hi = fmaxf(v[2], v[3]); lo = fminf(v[2], v[3]); v[2] = hi; v[3] = lo;
  hi = fmaxf(v[4], v[5]); lo = fminf(v[4], v[5]); v[4] = hi; v[5] = lo;
  hi = fmaxf(v[6], v[7]); lo = fminf(v[6], v[7]); v[6] = hi; v[7] = lo;
  hi = fmaxf(v[8], v[9]); lo = fminf(v[8], v[9]); v[8] = hi; v[9] = lo;
  hi = fmaxf(v[10], v[11]); lo = fminf(v[10], v[11]); v[10] = hi; v[11] = lo;
  hi = fmaxf(v[12], v[13]); lo = fminf(v[12], v[13]); v[12] = hi; v[13] = lo;
  hi = fmaxf(v[14], v[15]); lo = fminf(v[14], v[15]); v[14] = hi; v[15] = lo;
}
__device__ __forceinline__ void sort32_desc(float (&v)[32]) {
  float hi, lo;
  hi = fmaxf(v[0], v[1]); lo = fminf(v[0], v[1]); v[0] = hi; v[1] = lo;
  hi = fmaxf(v[2], v[3]); lo = fminf(v[2], v[3]); v[2] = lo; v[3] = hi;
  hi = fmaxf(v[4], v[5]); lo = fminf(v[4], v[5]); v[4] = hi; v[5] = lo;
  hi = fmaxf(v[6], v[7]); lo = fminf(v[6], v[7]); v[6] = lo; v[7] = hi;
  hi = fmaxf(v[8], v[9]); lo = fminf(v[8], v[9]); v[8] = hi; v[9] = lo;
  hi = fmaxf(v[10], v[11]); lo = fminf(v[10], v[11]); v[10] = lo; v[11] = hi;
  hi = fmaxf(v[12], v[13]); lo = fminf(v[12], v[13]); v[12] = hi; v[13] = lo;
  hi = fmaxf(v[14], v[15]); lo = fminf(v[14], v[15]); v[14] = lo; v[15] = hi;
  hi = fmaxf(v[16], v[17]); lo = fminf(v[16], v[17]); v[16] = hi; v[17] = lo;
  hi = fmaxf(v[18], v[19]); lo = fminf(v[18], v[19]); v[18] = lo; v[19] = hi;
  hi = fmaxf(v[20], v[21]); lo = fminf(v[20], v[21]); v[20] = hi; v[21] = lo;
  hi = fmaxf(v[22], v[23]); lo = fminf(v[22], v[23]); v[22] = lo; v[23] = hi;
  hi = fmaxf(v[24], v[25]); lo = fminf(v[24], v[25]); v[24] = hi; v[25] = lo;
  hi = fmaxf(v[26], v[27]); lo = fminf(v[26], v[27]); v[26] = lo; v[27] = hi;
  hi = fmaxf(v[28], v[29]); lo = fminf(v[28], v[29]); v[28] = hi; v[29] = lo;
  hi = fmaxf(v[30], v[31]); lo = fminf(v[30], v[31]); v[30] = lo; v[31] = hi;
  hi = fmaxf(v[0], v[2]); lo = fminf(v[0], v[2]); v[0] = hi; v[2] = lo;
  hi = fmaxf(v[1], v[3]); lo = fminf(v[1], v[3]); v[1] = hi; v[3] = lo;
  hi = fmaxf(v[4], v[6]); lo = fminf(v[4], v[6]); v[4] = lo; v[6] = hi;
  hi = fmaxf(v[5], v[7]); lo = fminf(v[5], v[7]); v[5] = lo; v[7] = hi;
  hi = fmaxf(v[8], v[10]); lo = fminf(v[8], v[10]); v[8] = hi; v[10] = lo;
  hi = fmaxf(v[9], v[11]); lo = fminf(v[9], v[11]); v[9] = hi; v[11] = lo;
  hi = fmaxf(v[12], v[14]); lo = fminf(v[12], v[14]); v[12] = lo; v[14] = hi;
  hi = fmaxf(v[13], v[15]); lo = fminf(v[13], v[15]); v[13] = lo; v[15] = hi;
  hi = fmaxf(v[16], v[18]); lo = fminf(v[16], v[18]); v[16] = hi; v[18] = lo;
  hi = fmaxf(v[17], v[19]); lo = fminf(v[17], v[19]); v[17] = hi; v[19] = lo;
  hi = fmaxf(v[20], v[22]); lo = fminf(v[20], v[22]); v[20] = lo; v[22] = hi;
  hi = fmaxf(v[21], v[23]); lo = fminf(v[21], v[23]); v[21] = lo; v[23] = hi;
  hi = fmaxf(v[24], v[26]); lo = fminf(v[24], v[26]); v[24] = hi; v[26] = lo;
  hi = fmaxf(v[25], v[27]); lo = fminf(v[25], v[27]); v[25] = hi; v[27] = lo;
  hi = fmaxf(v[28], v[30]); lo = fminf(v[28], v[30]); v[28] = lo; v[30] = hi;
  hi = fmaxf(v[29], v[31]); lo = fminf(v[29], v[31]); v[29] = lo; v[31] = hi;
  hi = fmaxf(v[0], v[1]); lo = fminf(v[0], v[1]); v[0] = hi; v[1] = lo;
  hi = fmaxf(v[2], v[3]); lo = fminf(v[2], v[3]); v[2] = hi; v[3] = lo;
  hi = fmaxf(v[4], v[5]); lo = fminf(v[4], v[5]); v[4] = lo; v[5] = hi;
  hi = fmaxf(v[6], v[7]); lo = fminf(v[6], v[7]); v[6] = lo; v[7] = hi;
  hi = fmaxf(v[8], v[9]); lo = fminf(v[8], v[9]); v[8] = hi; v[9] = lo;
  hi = fmaxf(v[10], v[11]); lo = fminf(v[10], v[11]); v[10] = hi; v[11] = lo;
  hi = fmaxf(v[12], v[13]); lo = fminf(v[12], v[13]); v[12] = lo; v[13] = hi;
  hi = fmaxf(v[14], v[15]); lo = fminf(v[14], v[15]); v[14] = lo; v[15] = hi;
  hi = fmaxf(v[16], v[17]); lo = fminf(v[16], v[17]); v[16] = hi; v[17] = lo;
  hi = fmaxf(v[18], v[19]); lo = fminf(v[18], v[19]); v[18] = hi; v[19] = lo;
  hi = fmaxf(v[20], v[21]); lo = fminf(v[20], v[21]); v[20] = lo; v[21] = hi;
  hi = fmaxf(v[22], v[23]); lo = fminf(v[22], v[23]); v[22] = lo; v[23] = hi;
  hi = fmaxf(v[24], v[25]); lo = fminf(v[24], v[25]); v[24] = hi; v[25] = lo;
  hi = fmaxf(v[26], v[27]); lo = fminf(v[26], v[27]); v[26] = hi; v[27] = lo;
  hi = fmaxf(v[28], v[29]); lo = fminf(v[28], v[29]); v[28] = lo; v[29] = hi;
  hi = fmaxf(v[30], v[31]); lo = fminf(v[30], v[31]); v[30] = lo; v[31] = hi;
  hi = fmaxf(v[0], v[4]); lo = fminf(v[0], v[4]); v[0] = hi; v[4] = lo;
  hi = fmaxf(v[1], v[5]); lo = fminf(v[1], v[5]); v[1] = hi; v[5] = lo;
  hi = fmaxf(v[2], v[6]); lo = fminf(v[2], v[6]); v[2] = hi; v[6] = lo;
  hi = fmaxf(v[3], v[7]); lo = fminf(v[3], v[7]); v[3] = hi; v[7] = lo;
  hi = fmaxf(v[8], v[12]); lo = fminf(v[8], v[12]); v[8] = lo; v[12] = hi;
  hi = fmaxf(v[9], v[13]); lo = fminf(v[9], v[13]); v[9] = lo; v[13] = hi;
  hi = fmaxf(v[10], v[14]); lo = fminf(v[10], v[14]); v[10] = lo; v[14] = hi;
  hi = fmaxf(v[11], v[15]); lo = fminf(v[11], v[15]); v[11] = lo; v[15] = hi;
  hi = fmaxf(v[16], v[20]); lo = fminf(v[16], v[20]); v[16] = hi; v[20] = lo;
  hi = fmaxf(v[17], v[21]); lo = fminf(v[17], v[21]); v[17] = hi; v[21] = lo;
  hi = fmaxf(v[18], v[22]); lo = fminf(v[18], v[22]); v[18] = hi; v[22] = lo;
  hi = fmaxf(v[19], v[23]); lo = fminf(v[19], v[23]); v[19] = hi; v[23] = lo;
  hi = fmaxf(v[24], v[28]); lo = fminf(v[24], v[28]); v[24] = lo; v[28] = hi;
  hi = fmaxf(v[25], v[29]); lo = fminf(v[25], v[29]); v[25] = lo; v[29] = hi;
  hi = fmaxf(v[26], v[30]); lo = fminf(v[26], v[30]); v[26] = lo; v[30] = hi;
  hi = fmaxf(v[27], v[31]); lo = fminf(v[27], v[31]); v[27] = lo; v[31] = hi;
  hi = fmaxf(v[0], v[2]); lo = fminf(v[0], v[2]); v[0] = hi; v[2] = lo;
  hi = fmaxf(v[1], v[3]); lo = fminf(v[1], v[3]); v[1] = hi; v[3] = lo;
  hi = fmaxf(v[4], v[6]); lo = fminf(v[4], v[6]); v[4] = hi; v[6] = lo;
  hi = fmaxf(v[5], v[7]); lo = fminf(v[5], v[7]); v[5] = hi; v[7] = lo;
  hi = fmaxf(v[8], v[10]); lo = fminf(v[8], v[10]); v[8] = lo; v[10] = hi;
  hi = fmaxf(v[9], v[11]); lo = fminf(v[9], v[11]); v[9] = lo; v[11] = hi;
  hi = fmaxf(v[12], v[14]); lo = fminf(v[12], v[14]); v[12] = lo; v[14] = hi;
  hi = fmaxf(v[13], v[15]); lo = fminf(v[13], v[15]); v[13] = lo; v[15] = hi;
  hi = fmaxf(v[16], v[18]); lo = fminf(v[16], v[18]); v[16] = hi; v[18] = lo;
  hi = fmaxf(v[17], v[19]); lo = fminf(v[17], v[19]); v[17] = hi; v[19] = lo;
  hi = fmaxf(v[20], v[22]); lo = fminf(v[20], v[22]); v[20] = hi; v[22] = lo;
  hi = fmaxf(v[21], v[23]); lo = fminf(v[21], v[23]); v[21] = hi; v[23] = lo;
  hi = fmaxf(v[24], v[26]); lo = fminf(v[24], v[26]); v[24] = lo; v[26] = hi;
  hi = fmaxf(v[25], v[27]); lo = fminf(v[25], v[27]); v[25] = lo; v[27] = hi;
  hi = fmaxf(v[28], v[30]); lo = fminf(v[28], v[30]); v[28] = lo; v[30] = hi;
  hi = fmaxf(v[29], v[31]); lo = fminf(v[29], v[31]); v[29] = lo; v[31] = hi;
  hi = fmaxf(v[0], v[1]); lo = fminf(v[0], v[1]); v[0] = hi; v[1] = lo;
  hi = fmaxf(v[2], v[3]); lo = fminf(v[2], v[3]); v[2] = hi; v[3] = lo;
  hi = fmaxf(v[4], v[5]); lo = fminf(v[4], v[5]); v[4] = hi; v[5] = lo;
  hi = fmaxf(v[6], v[7]); lo = fminf(v[6], v[7]); v[6] = hi; v[7] = lo;
  hi = fmaxf(v[8], v[9]); lo = fminf(v[8], v[9]); v[8] = lo; v[9] = hi;
  hi = fmaxf(v[10], v[11]); lo = fminf(v[10], v[11]); v[10] = lo; v[11] = hi;
  hi = fmaxf(v[12], v[13]); lo = fminf(v[12], v[13]); v[12] = lo; v[13] = hi;
  hi = fmaxf(v[14], v[15]); lo = fminf(v[14], v[15]); v[14] = lo; v[15] = hi;
  hi = fmaxf(v[16], v[17]); lo = fminf(v[16], v[17]); v[16] = hi; v[17] = lo;
  hi = fmaxf(v[18], v[19]); lo = fminf(v[18], v[19]); v[18] = hi; v[19] = lo;
  hi = fmaxf(v[20], v[21]); lo = fminf(v[20], v[21]); v[20] = hi; v[21] = lo;
  hi = fmaxf(v[22], v[23]); lo = fminf(v[22], v[23]); v[22] = hi; v[23] = lo;
  hi = fmaxf(v[24], v[25]); lo = fminf(v[24], v[25]); v[24] = lo; v[25] = hi;
  hi = fmaxf(v[26], v[27]); lo = fminf(v[26], v[27]); v[26] = lo; v[27] = hi;
  hi = fmaxf(v[28], v[29]); lo = fminf(v[28], v[29]); v[28] = lo; v[29] = hi;
  hi = fmaxf(v[30], v[31]); lo = fminf(v[30], v[31]); v[30] = lo; v[31] = hi;
  hi = fmaxf(v[0], v[8]); lo = fminf(v[0], v[8]); v[0] = hi; v[8] = lo;
  hi = fmaxf(v[1], v[9]); lo = fminf(v[1], v[9]); v[1] = hi; v[9] = lo;
  hi = fmaxf(v[2], v[10]); lo = fminf(v[2], v[10]); v[2] = hi; v[10] = lo;
  hi = fmaxf(v[3], v[11]); lo = fminf(v[3], v[11]); v[3] = hi; v[11] = lo;
  hi = fmaxf(v[4], v[12]); lo = fminf(v[4], v[12]); v[4] = hi; v[12] = lo;
  hi = fmaxf(v[5], v[13]); lo = fminf(v[5], v[13]); v[5] = hi; v[13] = lo;
  hi = fmaxf(v[6], v[14]); lo = fminf(v[6], v[14]); v[6] = hi; v[14] = lo;
  hi = fmaxf(v[7], v[15]); lo = fminf(v[7], v[15]); v[7] = hi; v[15] = lo;
  hi = fmaxf(v[16], v[24]); lo = fminf(v[16], v[24]); v[16] = lo; v[24] = hi;
  hi = fmaxf(v[17], v[25]); lo = fminf(v[17], v[25]); v[17] = lo; v[25] = hi;
  hi = fmaxf(v[18], v[26]); lo = fminf(v[18], v[26]); v[18] = lo; v[26] = hi;
  hi = fmaxf(v[19], v[27]); lo = fminf(v[19], v[27]); v[19] = lo; v[27] = hi;
  hi = fmaxf(v[20], v[28]); lo = fminf(v[20], v[28]); v[20] = lo; v[28] = hi;
  hi = fmaxf(v[21], v[29]); lo = fminf(v[21], v[29]); v[21] = lo; v[29] = hi;
  hi = fmaxf(v[22], v[30]); lo = fminf(v[22], v[30]); v[22] = lo; v[30] = hi;
  hi = fmaxf(v[23], v[31]); lo = fminf(v[23], v[31]); v[23] = lo; v[31] = hi;
  hi = fmaxf(v[0], v[4]); lo = fminf(v[0], v[4]); v[0] = hi; v[4] = lo;
  hi = fmaxf(v[1], v[5]); lo = fminf(v[1], v[5]); v[1] = hi; v[5] = lo;
  hi = fmaxf(v[2], v[6]); lo = fminf(v[2], v[6]); v[2] = hi; v[6] = lo;
  hi = fmaxf(v[3], v[7]); lo = fminf(v[3], v[7]); v[3] = hi; v[7] = lo;
  hi = fmaxf(v[8], v[12]); lo = fminf(v[8], v[12]); v[8] = hi; v[12] = lo;
  hi = fmaxf(v[9], v[13]); lo = fminf(v[9], v[13]); v[9] = hi; v[13] = lo;
  hi = fmaxf(v[10], v[14]); lo = fminf(v[10], v[14]); v[10] = hi; v[14] = lo;
  hi = fmaxf(v[11], v[15]); lo = fminf(v[11], v[15]); v[11] = hi; v[15] = lo;
  hi = fmaxf(v[16], v[20]); lo = fminf(v[16], v[20]); v[16] = lo; v[20] = hi;
  hi = fmaxf(v[17], v[21]); lo = fminf(v[17], v[21]); v[17] = lo; v[21] = hi;
  hi = fmaxf(v[18], v[22]); lo = fminf(v[18], v[22]); v[18] = lo; v[22] = hi;
  hi = fmaxf(v[19], v[23]); lo = fminf(v[19], v[23]); v[19] = lo; v[23] = hi;
  hi = fmaxf(v[24], v[28]); lo = fminf(v[24], v[28]); v[24] = lo; v[28] = hi;
  hi = fmaxf(v[25], v[29]); lo = fminf(v[25], v[29]); v[25] = lo; v[29] = hi;
  hi = fmaxf(v[26], v[30]); lo = fminf(v[26], v[30]); v[26] = lo; v[30] = hi;
  hi = fmaxf(v[27], v[31]); lo = fminf(v[27], v[31]); v[27] = lo; v[31] = hi;
  hi = fmaxf(v[0], v[2]); lo = fminf(v[0], v[2]); v[0] = hi; v[2] = lo;
  hi = fmaxf(v[1], v[3]); lo = fminf(v[1], v[3]); v[1] = hi; v[3] = lo;
  hi = fmaxf(v[4], v[6]); lo = fminf(v[4], v[6]); v[4] = hi; v[6] = lo;
  hi = fmaxf(v[5], v[7]); lo = fminf(v[5], v[7]); v[5] = hi; v[7] = lo;
  hi = fmaxf(v[8], v[10]); lo = fminf(v[8], v[10]); v[8] = hi; v[10] = lo;
  hi = fmaxf(v[9], v[11]); lo = fminf(v[9], v[11]); v[9] = hi; v[11] = lo;
  hi = fmaxf(v[12], v[14]); lo = fminf(v[12], v[14]); v[12] = hi; v[14] = lo;
  hi = fmaxf(v[13], v[15]); lo = fminf(v[13], v[15]); v[13] = hi; v[15] = lo;
  hi = fmaxf(v[16], v[18]); lo = fminf(v[16], v[18]); v[16] = lo; v[18] = hi;
  hi = fmaxf(v[17], v[19]); lo = fminf(v[17], v[19]); v[17] = lo; v[19] = hi;
  hi = fmaxf(v[20], v[22]); lo = fminf(v[20], v[22]); v[20] = lo; v[22] = hi;
  hi = fmaxf(v[21], v[23]); lo = fminf(v[21], v[23]); v[21] = lo; v[23] = hi;
  hi = fmaxf(v[24], v[26]); lo = fminf(v[24], v[26]); v[24] = lo; v[26] = hi;
  hi = fmaxf(v[25], v[27]); lo = fminf(v[25], v[27]); v[25] = lo; v[27] = hi;
  hi = fmaxf(v[28], v[30]); lo = fminf(v[28], v[30]); v[28] = lo; v[30] = hi;
  hi = fmaxf(v[29], v[31]); lo = fminf(v[29], v[31]); v[29] = lo; v[31] = hi;
  hi = fmaxf(v[0], v[1]); lo = fminf(v[0], v[1]); v[0] = hi; v[1] = lo;
  hi = fmaxf(v[2], v[3]); lo = fminf(v[2], v[3]); v[2] = hi; v[3] = lo;
  hi = fmaxf(v[4], v[5]); lo = fminf(v[4], v[5]); v[4] = hi; v[5] = lo;
  hi = fmaxf(v[6], v[7]); lo = fminf(v[6], v[7]); v[6] = hi; v[7] = lo;
  hi = fmaxf(v[8], v[9]); lo = fminf(v[8], v[9]); v[8] = hi; v[9] = lo;
  hi = fmaxf(v[10], v[11]); lo = fminf(v[10], v[11]); v[10] = hi; v[11] = lo;
  hi = fmaxf(v[12], v[13]); lo = fminf(v[12], v[13]); v[12] = hi; v[13] = lo;
  hi = fmaxf(v[14], v[15]); lo = fminf(v[14], v[15]); v[14] = hi; v[15] = lo;
  hi = fmaxf(v[16], v[17]); lo = fminf(v[16], v[17]); v[16] = lo; v[17] = hi;
  hi = fmaxf(v[18], v[19]); lo = fminf(v[18], v[19]); v[18] = lo; v[19] = hi;
  hi = fmaxf(v[20], v[21]); lo = fminf(v[20], v[21]); v[20] = lo; v[21] = hi;
  hi = fmaxf(v[22], v[23]); lo = fminf(v[22], v[23]); v[22] = lo; v[23] = hi;
  hi = fmaxf(v[24], v[25]); lo = fminf(v[24], v[25]); v[24] = lo; v[25] = hi;
  hi = fmaxf(v[26], v[27]); lo = fminf(v[26], v[27]); v[26] = lo; v[27] = hi;
  hi = fmaxf(v[28], v[29]); lo = fminf(v[28], v[29]); v[28] = lo; v[29] = hi;
  hi = fmaxf(v[30], v[31]); lo = fminf(v[30], v[31]); v[30] = lo; v[31] = hi;
  hi = fmaxf(v[0], v[16]); lo = fminf(v[0], v[16]); v[0] = hi; v[16] = lo;
  hi = fmaxf(v[1], v[17]); lo = fminf(v[1], v[17]); v[1] = hi; v[17] = lo;
  hi = fmaxf(v[2], v[18]); lo = fminf(v[2], v[18]); v[2] = hi; v[18] = lo;
  hi = fmaxf(v[3], v[19]); lo = fminf(v[3], v[19]); v[3] = hi; v[19] = lo;
  hi = fmaxf(v[4], v[20]); lo = fminf(v[4], v[20]); v[4] = hi; v[20] = lo;
  hi = fmaxf(v[5], v[21]); lo = fminf(v[5], v[21]); v[5] = hi; v[21] = lo;
  hi = fmaxf(v[6], v[22]); lo = fminf(v[6], v[22]); v[6] = hi; v[22] = lo;
  hi = fmaxf(v[7], v[23]); lo = fminf(v[7], v[23]); v[7] = hi; v[23] = lo;
  hi = fmaxf(v[8], v[24]); lo = fminf(v[8], v[24]); v[8] = hi; v[24] = lo;
  hi = fmaxf(v[9], v[25]); lo = fminf(v[9], v[25]); v[9] = hi; v[25] = lo;
  hi = fmaxf(v[10], v[26]); lo = fminf(v[10], v[26]); v[10] = hi; v[26] = lo;
  hi = fmaxf(v[11], v[27]); lo = fminf(v[11], v[27]); v[11] = hi; v[27] = lo;
  hi = fmaxf(v[12], v[28]); lo = fminf(v[12], v[28]); v[12] = hi; v[28] = lo;
  hi = fmaxf(v[13], v[29]); lo = fminf(v[13], v[29]); v[13] = hi; v[29] = lo;
  hi = fmaxf(v[14], v[30]); lo = fminf(v[14], v[30]); v[14] = hi; v[30] = lo;
  hi = fmaxf(v[15], v[31]); lo = fminf(v[15], v[31]); v[15] = hi; v[31] = lo;
  hi = fmaxf(v[0], v[8]); lo = fminf(v[0], v[8]); v[0] = hi; v[8] = lo;
  hi = fmaxf(v[1], v[9]); lo = fminf(v[1], v[9]); v[1] = hi; v[9] = lo;
  hi = fmaxf(v[2], v[10]); lo = fminf(v[2], v[10]); v[2] = hi; v[10] = lo;
  hi = fmaxf(v[3], v[11]); lo = fminf(v[3], v[11]); v[3] = hi; v[11] = lo;
  hi = fmaxf(v[4], v[12]); lo = fminf(v[4], v[12]); v[4] = hi; v[12] = lo;
  hi = fmaxf(v[5], v[13]); lo = fminf(v[5], v[13]); v[5] = hi; v[13] = lo;
  hi = fmaxf(v[6], v[14]); lo = fminf(v[6], v[14]); v[6] = hi; v[14] = lo;
  hi = fmaxf(v[7], v[15]); lo = fminf(v[7], v[15]); v[7] = hi; v[15] = lo;
  hi = fmaxf(v[16], v[24]); lo = fminf(v[16], v[24]); v[16] = hi; v[24] = lo;
  hi = fmaxf(v[17], v[25]); lo = fminf(v[17], v[25]); v[17] = hi; v[25] = lo;
  hi = fmaxf(v[18], v[26]); lo = fminf(v[18], v[26]); v[18] = hi; v[26] = lo;
  hi = fmaxf(v[19], v[27]); lo = fminf(v[19], v[27]); v[19] = hi; v[27] = lo;
  hi = fmaxf(v[20], v[28]); lo = fminf(v[20], v[28]); v[20] = hi; v[28] = lo;
  hi = fmaxf(v[21], v[29]); lo = fminf(v[21], v[29]); v[21] = hi; v[29] = lo;
  hi = fmaxf(v[22], v[30]); lo = fminf(v[22], v[30]); v[22] = hi; v[30] = lo;
  hi = fmaxf(v[23], v[31]); lo = fminf(v[23], v[31]); v[23] = hi; v[31] = lo;
  hi = fmaxf(v[0], v[4]); lo = fminf(v[0], v[4]); v[0] = hi; v[4] = lo;
  hi = fmaxf(v[1], v[5]); lo = fminf(v[1], v[5]); v[1] = hi; v[5] = lo;
  hi = fmaxf(v[2], v[6]); lo = fminf(v[2], v[6]); v[2] = hi; v[6] = lo;
  hi = fmaxf(v[3], v[7]); lo = fminf(v[3], v[7]); v[3] = hi; v[7] = lo;
  hi = fmaxf(v[8], v[12]); lo = fminf(v[8], v[12]); v[8] = hi; v[12] = lo;
  hi = fmaxf(v[9], v[13]); lo = fminf(v[9], v[13]); v[9] = hi; v[13] = lo;
  hi = fmaxf(v[10], v[14]); lo = fminf(v[10], v[14]); v[10] = hi; v[14] = lo;
  hi = fmaxf(v[11], v[15]); lo = fminf(v[11], v[15]); v[11] = hi; v[15] = lo;
  hi = fmaxf(v[16], v[20]); lo = fminf(v[16], v[20]); v[16] = hi; v[20] = lo;
  hi = fmaxf(v[17], v[21]); lo = fminf(v[17], v[21]); v[17] = hi; v[21] = lo;
  hi = fmaxf(v[18], v[22]); lo = fminf(v[18], v[22]); v[18] = hi; v[22] = lo;
  hi = fmaxf(v[19], v[23]); lo = fminf(v[19], v[23]); v[19] = hi; v[23] = lo;
  hi = fmaxf(v[24], v[28]); lo = fminf(v[24], v[28]); v[24] = hi; v[28] = lo;
  hi = fmaxf(v[25], v[29]); lo = fminf(v[25], v[29]); v[25] = hi; v[29] = lo;
  hi = fmaxf(v[26], v[30]); lo = fminf(v[26], v[30]); v[26] = hi; v[30] = lo;
  hi = fmaxf(v[27], v[31]); lo = fminf(v[27], v[31]); v[27] = hi; v[31] = lo;
  hi = fmaxf(v[0], v[2]); lo = fminf(v[0], v[2]); v[0] = hi; v[2] = lo;
  hi = fmaxf(v[1], v[3]); lo = fminf(v[1], v[3]); v[1] = hi; v[3] = lo;
  hi = fmaxf(v[4], v[6]); lo = fminf(v[4], v[6]); v[4] = hi; v[6] = lo;
  hi = fmaxf(v[5], v[7]); lo = fminf(v[5], v[7]); v[5] = hi; v[7] = lo;
  hi = fmaxf(v[8], v[10]); lo = fminf(v[8], v[10]); v[8] = hi; v[10] = lo;
  hi = fmaxf(v[9], v[11]); lo = fminf(v[9], v[11]); v[9] = hi; v[11] = lo;
  hi = fmaxf(v[12], v[14]); lo = fminf(v[12], v[14]); v[12] = hi; v[14] = lo;
  hi = fmaxf(v[13], v[15]); lo = fminf(v[13], v[15]); v[13] = hi; v[15] = lo;
  hi = fmaxf(v[16], v[18]); lo = fminf(v[16], v[18]); v[16] = hi; v[18] = lo;
  hi = fmaxf(v[17], v[19]); lo = fminf(v[17], v[19]); v[17] = hi; v[19] = lo;
  hi = fmaxf(v[20], v[22]); lo = fminf(v[20], v[22]); v[20] = hi; v[22] = lo;
  hi = fmaxf(v[21], v[23]); lo = fminf(v[21], v[23]); v[21] = hi; v[23] = lo;
  hi = fmaxf(v[24], v[26]); lo = fminf(v[24], v[26]); v[24] = hi; v[26] = lo;
  hi = fmaxf(v[25], v[27]); lo = fminf(v[25], v[27]); v[25] = hi; v[27] = lo;
  hi = fmaxf(v[28], v[30]); lo = fminf(v[28], v[30]); v[28] = hi; v[30] = lo;
  hi = fmaxf(v[29], v[31]); lo = fminf(v[29], v[31]); v[29] = hi; v[31] = lo;
  hi = fmaxf(v[0], v[1]); lo = fminf(v[0], v[1]); v[0] = hi; v[1] = lo;
  hi = fmaxf(v[2], v[3]); lo = fminf(v[2], v[3]); v[2] = hi; v[3] = lo;
  hi = fmaxf(v[4], v[5]); lo = fminf(v[4], v[5]); v[4] = hi; v[5] = lo;
  hi = fmaxf(v[6], v[7]); lo = fminf(v[6], v[7]); v[6] = hi; v[7] = lo;
  hi = fmaxf(v[8], v[9]); lo = fminf(v[8], v[9]); v[8] = hi; v[9] = lo;
  hi = fmaxf(v[10], v[11]); lo = fminf(v[10], v[11]); v[10] = hi; v[11] = lo;
  hi = fmaxf(v[12], v[13]); lo = fminf(v[12], v[13]); v[12] = hi; v[13] = lo;
  hi = fmaxf(v[14], v[15]); lo = fminf(v[14], v[15]); v[14] = hi; v[15] = lo;
  hi = fmaxf(v[16], v[17]); lo = fminf(v[16], v[17]); v[16] = hi; v[17] = lo;
  hi = fmaxf(v[18], v[19]); lo = fminf(v[18], v[19]); v[18] = hi; v[19] = lo;
  hi = fmaxf(v[20], v[21]); lo = fminf(v[20], v[21]); v[20] = hi; v[21] = lo;
  hi = fmaxf(v[22], v[23]); lo = fminf(v[22], v[23]); v[22] = hi; v[23] = lo;
  hi = fmaxf(v[24], v[25]); lo = fminf(v[24], v[25]); v[24] = hi; v[25] = lo;
  hi = fmaxf(v[26], v[27]); lo = fminf(v[26], v[27]); v[26] = hi; v[27] = lo;
  hi = fmaxf(v[28], v[29]); lo = fminf(v[28], v[29]); v[28] = hi; v[29] = lo;
  hi = fmaxf(v[30], v[31]); lo = fminf(v[30], v[31]); v[30] = hi; v[31] = lo;
}
__device__ __forceinline__ void bmerge16_desc(float (&v)[16]) {
  float hi, lo;
  hi = fmaxf(v[0], v[8]); lo = fminf(v[0], v[8]); v[0] = hi; v[8] = lo;
  hi = fmaxf(v[1], v[9]); lo = fminf(v[1], v[9]); v[1] = hi; v[9] = lo;
  hi = fmaxf(v[2], v[10]); lo = fminf(v[2], v[10]); v[2] = hi; v[10] = lo;
  hi = fmaxf(v[3], v[11]); lo = fminf(v[3], v[11]); v[3] = hi; v[11] = lo;
  hi = fmaxf(v[4], v[12]); lo = fminf(v[4], v[12]); v[4] = hi; v[12] = lo;
  hi = fmaxf(v[5], v[13]); lo = fminf(v[5], v[13]); v[5] = hi; v[13] = lo;
  hi = fmaxf(v[6], v[14]); lo = fminf(v[6], v[14]); v[6] = hi; v[14] = lo;
  hi = fmaxf(v[7], v[15]); lo = fminf(v[7], v[15]); v[7] = hi; v[15] = lo;
  hi = fmaxf(v[0], v[4]); lo = fminf(v[0], v[4]); v[0] = hi; v[4] = lo;
  hi = fmaxf(v[1], v[5]); lo = fminf(v[1], v[5]); v[1] = hi; v[5] = lo;
  hi = fmaxf(v[2], v[6]); lo = fminf(v[2], v[6]); v[2] = hi; v[6] = lo;
  hi = fmaxf(v[3], v[7]); lo = fminf(v[3], v[7]); v[3] = hi; v[7] = lo;
  hi = fmaxf(v[8], v[12]); lo = fminf(v[8], v[12]); v[8] = hi; v[12] = lo;
  hi = fmaxf(v[9], v[13]); lo = fminf(v[9], v[13]); v[9] = hi; v[13] = lo;
  hi = fmaxf(v[10], v[14]); lo = fminf(v[10], v[14]); v[10] = hi; v[14] = lo;
  hi = fmaxf(v[11], v[15]); lo = fminf(v[11], v[15]); v[11] = hi; v[15] = lo;
  hi = fmaxf(v[0], v[2]); lo = fminf(v[0], v[2]); v[0] = hi; v[2] = lo;
  hi = fmaxf(v[1], v[3]); lo = fminf(v[1], v[3]); v[1] = hi; v[3] = lo;
  hi = fmaxf(v[4], v[6]); lo = fminf(v[4], v[6]); v[4] = hi; v[6] = lo;
  hi = fmaxf(v[5], v[7]); lo = fminf(v[5], v[7]); v[5] = hi; v[7] = lo;
  hi = fmaxf(v[8], v[10]); lo = fminf(v[8], v[10]); v[8] = hi; v[10] = lo;
  hi = fmaxf(v[9], v[11]); lo = fminf(v[9], v[11]); v[9] = hi; v[11] = lo;
  hi = fmaxf(v[12], v[14]); lo = fminf(v[12], v[14]); v[12] = hi; v[14] = lo;
  hi = fmaxf(v[13], v[15]); lo = fminf(v[13], v[15]); v[13] = hi; v[15] = lo;
  hi = fmaxf(v[0], v[1]); lo = fminf(v[0], v[1]); v[0] = hi; v[1] = lo;
  hi = fmaxf(v[2], v[3]); lo = fminf(v[2], v[3]); v[2] = hi; v[3] = lo;
  hi = fmaxf(v[4], v[5]); lo = fminf(v[4], v[5]); v[4] = hi; v[5] = lo;
  hi = fmaxf(v[6], v[7]); lo = fminf(v[6], v[7]); v[6] = hi; v[7] = lo;
  hi = fmaxf(v[8], v[9]); lo = fminf(v[8], v[9]); v[8] = hi; v[9] = lo;
  hi = fmaxf(v[10], v[11]); lo = fminf(v[10], v[11]); v[10] = hi; v[11] = lo;
  hi = fmaxf(v[12], v[13]); lo = fminf(v[12], v[13]); v[12] = hi; v[13] = lo;
  hi = fmaxf(v[14], v[15]); lo = fminf(v[14], v[15]); v[14] = hi; v[15] = lo;
}
__device__ __forceinline__ void merge_top16(float (&a)[16], const float (&b)[16]) {
#pragma unroll
  for (int i = 0; i < 16; ++i) a[i] = fmaxf(a[i], b[15 - i]);
  bmerge16_desc(a);
}
__device__ __forceinline__ void partner_merge16(float (&a)[16]) {
  float b[16];
#pragma unroll
  for (int i = 0; i < 16; ++i) b[i] = __shfl_xor(a[i], 32);
  merge_top16(a, b);
}
#define RT_KROWB 272
__device__ __forceinline__ void route_half(const bf16_t* __restrict__ PQ, const unsigned char* klds, size_t tok, int hd, int half, int c, int hh, float (&out)[16]) {
  bf16x8 Qf[8];
#pragma unroll
  for (int s = 0; s < 8; ++s) Qf[s] = *(const bf16x8*)(PQ + tok * 2048 + hd * 256 + half * 128 + 16 * s + 8 * hh);
  const unsigned char* kb0 = klds + (size_t)(half * 128 + c) * RT_KROWB + 16 * hh;
  float T[16];
#pragma unroll
  for (int i = 0; i < 16; ++i) T[i] = -3.0e38f;
#pragma unroll 1
  for (int kb = 0; kb < 4; ++kb) {
    f32x16 S;
#pragma unroll
    for (int i = 0; i < 16; ++i) S[i] = 0.f;
#pragma unroll
    for (int s = 0; s < 8; ++s) {
      const bf16x8 kf = *(const bf16x8*)(kb0 + (size_t)(32 * kb) * RT_KROWB + 32 * s);
      S = __builtin_amdgcn_mfma_f32_32x32x16_bf16(kf, Qf[s], S, 0, 0, 0);
    }
    float L[16];
#pragma unroll
    for (int i = 0; i < 16; ++i) L[i] = pkid(S[i], (unsigned)(32 * kb + (i & 3) + 8 * (i >> 2) + 4 * hh), 127u);
    sort16_desc(L);
    merge_top16(T, L);
  }
  partner_merge16(T);
#pragma unroll
  for (int i = 0; i < 16; ++i) out[i] = T[i];
}
__device__ void ph_route(const bf16_t* __restrict__ PQ, const bf16_t* __restrict__ SKb, int* __restrict__ EXP, float* __restrict__ GATE, unsigned char* lds) {
  const int w = threadIdx.x >> 6, lane = threadIdx.x & 63, c = lane & 31, hh = lane >> 5;
  unsigned char* klds = lds;
  unsigned* tab = (unsigned*)(lds + 2 * 128 * RT_KROWB) + w * (32 * 33);
  pg8::StaticOrder SO; SO.init(NTOK, 2048, (int)gridDim.x, (int)blockIdx.x);
  pg8::Unit un;
  for (int ui = 0; SO.next(ui, un); ++ui) {
    {
      const int hd = un.pn;
      __syncthreads();
      {
        pg8::u32x4 kv[8];
#pragma unroll
        for (int i = 0; i < 8; ++i) { const int ch = threadIdx.x + NTHR * i, row = ch >> 4, c16 = ch & 15; kv[i] = *(const pg8::u32x4*)(SKb + ((size_t)hd * 256 + row) * 128 + c16 * 8); }
        __builtin_amdgcn_sched_barrier(0);
#pragma unroll
        for (int i = 0; i < 8; ++i) { const int ch = threadIdx.x + NTHR * i, row = ch >> 4, c16 = ch & 15; *(pg8::u32x4*)(klds + row * RT_KROWB + c16 * 16) = kv[i]; }
      }
      __syncthreads();
      const size_t tok = (size_t)un.pm * 256 + w * 32 + c;
      float A[16], B[16];
      route_half(PQ, klds, tok, hd, 0, c, hh, A);
      route_half(PQ, klds, tok, hd, 1, c, hh, B);
      wave_lds_sync();
#pragma unroll
      for (int i = 0; i < 16; ++i) { tab[c * 33 + i] = __float_as_uint(A[i]) & 127u; tab[c * 33 + 16 + i] = __float_as_uint(B[i]) & 127u; }
      float cd[32];
    cd[0] = pkid(hh ? A[0] + B[1] : A[0] + B[0], hh ? 1u : 0u, 255u);
    cd[1] = pkid(hh ? A[0] + B[3] : A[0] + B[2], hh ? 3u : 2u, 255u);
    cd[2] = pkid(hh ? A[0] + B[5] : A[0] + B[4], hh ? 5u : 4u, 255u);
    cd[3] = pkid(hh ? A[0] + B[7] : A[0] + B[6], hh ? 7u : 6u, 255u);
    cd[4] = pkid(hh ? A[0] + B[9] : A[0] + B[8], hh ? 9u : 8u, 255u);
    cd[5] = pkid(hh ? A[0] + B[11] : A[0] + B[10], hh ? 11u : 10u, 255u);
    cd[6] = pkid(hh ? A[0] + B[13] : A[0] + B[12], hh ? 13u : 12u, 255u);
    cd[7] = pkid(hh ? A[0] + B[15] : A[0] + B[14], hh ? 15u : 14u, 255u);
    cd[8] = pkid(hh ? A[1] + B[1] : A[1] + B[0], hh ? 17u : 16u, 255u);
    cd[9] = pkid(hh ? A[1] + B[3] : A[1] + B[2], hh ? 19u : 18u, 255u);
    cd[10] = pkid(hh ? A[1] + B[5] : A[1] + B[4], hh ? 21u : 20u, 255u);
    cd[11] = pkid(hh ? A[1] + B[7] : A[1] + B[6], hh ? 23u : 22u, 255u);
    cd[12] = pkid(hh ? A[2] + B[1] : A[2] + B[0], hh ? 33u : 32u, 255u);
    cd[13] = pkid(hh ? A[2] + B[3] : A[2] + B[2], hh ? 35u : 34u, 255u);
    cd[14] = pkid(hh ? A[3] + B[0] : A[2] + B[4], hh ? 48u : 36u, 255u);
    cd[15] = pkid(hh ? A[3] + B[2] : A[3] + B[1], hh ? 50u : 49u, 255u);
    cd[16] = pkid(hh ? A[4] + B[0] : A[3] + B[3], hh ? 64u : 51u, 255u);
    cd[17] = pkid(hh ? A[4] + B[2] : A[4] + B[1], hh ? 66u : 65u, 255u);
    cd[18] = pkid(hh ? A[5] + B[1] : A[5] + B[0], hh ? 81u : 80u, 255u);
    cd[19] = pkid(hh ? A[6] + B[1] : A[6] + B[0], hh ? 97u : 96u, 255u);
    cd[20] = pkid(hh ? A[7] + B[1] : A[7] + B[0], hh ? 113u : 112u, 255u);
    cd[21] = pkid(hh ? A[9] + B[0] : A[8] + B[0], hh ? 144u : 128u, 255u);
    cd[22] = pkid(hh ? A[11] + B[0] : A[10] + B[0], hh ? 176u : 160u, 255u);
    cd[23] = pkid(hh ? A[13] + B[0] : A[12] + B[0], hh ? 208u : 192u, 255u);
    cd[24] = pkid(hh ? A[15] + B[0] : A[14] + B[0], hh ? 240u : 224u, 255u);
#pragma unroll
      for (int k = 25; k < 32; ++k) cd[k] = -3.0e38f;
      sort32_desc(cd);
      float F[16];
#pragma unroll
      for (int i = 0; i < 16; ++i) F[i] = cd[i];
      partner_merge16(F);
      wave_lds_sync();
      float ex[16], sum = 0.f;
#pragma unroll
      for (int i = 0; i < 16; ++i) { ex[i] = __expf(F[i] - F[0]); sum += ex[i]; }
      const float inv = 1.0f / sum;
      int eo[8]; float go[8];
#pragma unroll
      for (int j = 0; j < 8; ++j) {
        float fa = F[j], fb = F[8 + j], ea = ex[j], eb = ex[8 + j];
        asm volatile("" : "+v"(fa), "+v"(fb), "+v"(ea), "+v"(eb));
        const float f = hh ? fb : fa;
        const unsigned cid = __float_as_uint(f) & 255u;
        const unsigned i1 = tab[c * 33 + (cid >> 4)], i2 = tab[c * 33 + 16 + (cid & 15u)];
        eo[j] = (int)(i1 * 128u + i2);
        go[j] = (hh ? eb : ea) * inv;
      }
      int* ep = EXP + tok * 128 + hd * 16 + 8 * hh; float* gp = GATE + tok * 128 + hd * 16 + 8 * hh;
      *(int4*)ep = make_int4(eo[0], eo[1], eo[2], eo[3]); *(int4*)(ep + 4) = make_int4(eo[4], eo[5], eo[6], eo[7]);
      *(float4*)gp = make_float4(go[0], go[1], go[2], go[3]); *(float4*)(gp + 4) = make_float4(go[4], go[5], go[6], go[7]);
    }
  }
}

#ifndef XCDMASK
#define XCDMASK 0xffffffffu
#endif
#ifndef R_PREP
#define R_PREP 1
#endif
#ifndef R_GEMM
#define R_GEMM 1
#endif
#ifndef R_ATT
#define R_ATT 1
#endif
#ifndef R_SSM
#define R_SSM 1
#endif
#ifndef R_XAT
#define R_XAT 1
#endif
#ifndef R_RTE
#define R_RTE 1
#endif
#ifndef R_NORM
#define R_NORM 1
#endif
#ifndef R_BAR
#define R_BAR 0
#endif
#ifndef DBG_STAGE
#define DBG_STAGE 0
#endif
#ifndef R_GATH
#define R_GATH 1
#endif
#define LDS_BYTES 163840
#ifndef FIRST_SEAM_XCD
#define FIRST_SEAM_XCD 1
#endif
#ifndef STAG_INP
#define STAG_INP 0
#endif
#ifndef STAG_PQ
#define STAG_PQ 0
#endif
#ifndef R_INP
#define R_INP 1
#endif
#ifndef R_XQ
#define R_XQ 1
#endif
#ifndef R_PQ
#define R_PQ 1
#endif
#ifndef LATE_PREP
#define LATE_PREP 1
#endif
#ifndef LATE_W
#define LATE_W 1
#endif
#ifndef LATE_UF
#define LATE_UF 0
#endif
#ifndef LATE_VF
#define LATE_VF 8
#endif
#ifndef GATH_NS
#define GATH_NS 4
#endif
#ifndef GATH_NBU
#define GATH_NBU 16
#endif
#ifndef GATH_NB
#define GATH_NB 16
#endif
__device__ __forceinline__ SsmC make_ssmc() {
  SsmC SC; char* b = (char*)KP(I_ws) + (size_t)O_SC * 1048576;
  SC.lam = (float2*)b; SC.lamL = (float2*)(b + 16384); SC.Bbar = (bf16_t*)(b + 32768); SC.CmT = (bf16_t*)(b + 32768 + 131072);
  SC.E = (float2*)(b + 1048576); return SC;
}
__device__ __forceinline__ void grid_seam(int k, cg::grid_group& grid, unsigned char* lds) {
  if ((XCDMASK >> k) & 1u) {
    XcdBarrier xb; xb.bar = WSP(unsigned, O_BAR); xb.x = xb_xcc_id(); xb.st = (volatile LAS unsigned*)(lds + LDS_BYTES - 16);
    xcd_barrier(xb);
  } else grid.sync();
}
#define SEAM(k) grid_seam(k, grid, lds)


#define DBG_DUMP_BF16(stage, OFF) if (DBG_STAGE == (stage)) { const bf16_t* s_ = WSP(bf16_t, OFF); float* o_ = (float*)KP(I_H); \
    for (size_t i_ = (size_t)bid * NTHR + threadIdx.x; i_ < (size_t)NTOK * 1024; i_ += (size_t)gridDim.x * NTHR) o_[i_] = bf2f(s_[i_]); return; }

#define DBG_DUMP_HALF(stage, OFF, LD, COL0) if (DBG_STAGE == (stage)) { const bf16_t* s_ = WSP(bf16_t, OFF); float* o_ = (float*)KP(I_H); \
    for (size_t i_ = (size_t)bid * NTHR + threadIdx.x; i_ < (size_t)NTOK * 1024; i_ += (size_t)gridDim.x * NTHR) { const size_t r_ = i_ >> 10, c_ = i_ & 511; o_[i_] = bf2f(s_[r_ * (LD) + (COL0) + c_]); } return; }

#define DBG_DUMP_CYC(stage, PTR, NELEM) if (DBG_STAGE == (stage)) { const bf16_t* s_ = (PTR); float* o_ = (float*)KP(I_H); \
    for (size_t i_ = (size_t)bid * NTHR + threadIdx.x; i_ < (size_t)NTOK * 1024; i_ += (size_t)gridDim.x * NTHR) o_[i_] = bf2f(s_[i_ % (size_t)(NELEM)]); return; }
__global__ void __launch_bounds__(NTHR) fwd_megakernel(Params P) {
  cg::grid_group grid = cg::this_grid();
  extern __shared__ __attribute__((aligned(16))) unsigned char lds[];
  const int bid = blockIdx.x;
  {
    volatile LAS unsigned* xb_st = (volatile LAS unsigned*)(lds + LDS_BYTES - 16);
    if (threadIdx.x == 0) { xb_st[0] = 0u; xb_st[1] = 0u; }
    __syncthreads();
#if FIRST_SEAM_XCD
    if (threadIdx.x == 0) (void)xb_add(&WSP(unsigned, O_BAR)[XB_XCNT(xb_xcc_id())], 1u);
#else
    if (bid == 0) { unsigned* bw = WSP(unsigned, O_BAR); for (int i = threadIdx.x; i < XCD_BAR_WORDS; i += NTHR) bw[i] = 0u; }
#endif
  }
#ifdef PROBE_MFMA4
  if (bid == 0 && threadIdx.x < 64) { const unsigned c = probe_mfma4(lds); if (threadIdx.x == 0) __hip_atomic_store(DBG_CNT_PTR, c, __ATOMIC_RELAXED, __HIP_MEMORY_SCOPE_AGENT); }
  __syncthreads();
#endif
  for (int rep = 0; rep < R_PREP; ++rep) {
    prep_weights<0>(lds, bid, (int)gridDim.x);
    { float* z = SS1_PTR; for (int i = bid * NTHR + threadIdx.x; i < 3 * NTOK + 4096; i += gridDim.x * NTHR) z[i] = 0.f; }
    prep_rmsnorm(KP(I_x), KP(I_g_mix), WSP(bf16_t, O_XN), NTOK);
    prep_rmsnorm(KP(I_mem), KP(I_g_mem), WSP(bf16_t, O_MEMN), 512);
    { SsmIn si{KP(I_a_re), KP(I_a_im), KP(I_log_dt), KP(I_b_re), KP(I_b_im), KP(I_c_re), KP(I_c_im)}; prep_ssm(si, make_ssmc()); }
    prep_cvt_bf16(KP(I_sub_keys), WSP(bf16_t, O_SKB), (size_t)262144);
    { const size_t nlate = (LATE_PREP && gridDim.x > 144u) ? (size_t)LATE_UF * 2048 * 1024 : 0;
      prep_cvt_fp4(KP(I_peer_u), WSP(unsigned char, O_PU8), (size_t)16384 * 1024 - nlate, PU4_SCALE, bid, (int)gridDim.x); }
    if (!(LATE_W && LATE_PREP && gridDim.x > 144u)) prep_weights<1>(lds, bid, (int)gridDim.x);
    { const size_t nlate = (LATE_PREP && gridDim.x > 144u) ? (size_t)LATE_VF * 2048 * 1024 : 0;
      prep_cvt_fp4(KP(I_peer_v), WSP(unsigned char, O_PV8), (size_t)16384 * 1024 - nlate, PV4_SCALE, bid, (int)gridDim.x); }
    if (rep + 1 < R_PREP) grid.sync();
  }
#if FIRST_SEAM_XCD
  if (gridDim.x == 0x7fffffffu) grid.sync();
  SEAM(14);
#else
  grid.sync();
  if (threadIdx.x == 0) (void)xb_add(&WSP(unsigned, O_BAR)[XB_XCNT(xb_xcc_id())], 1u);
#endif
  for (int rep = 0; rep < R_GEMM * R_INP; ++rep) {
#if STAG_INP > 0
    if ((bid >> 3) & 1) { const unsigned long long t0_ = __builtin_amdgcn_s_memrealtime(); while (__builtin_amdgcn_s_memrealtime() - t0_ < (unsigned long long)STAG_INP * 100ull) __builtin_amdgcn_s_sleep(8); }
#endif
    run_gemm(lds, WSP(bf16_t, O_XN), WSP(bf16_t, O_WIN), NTOK, 1536, 1024, bid, GEpiInProj{WSP(bf16_t, O_QK), WSP(bf16_t, O_QK + 16), WSP(bf16_t, O_VT), WSP(bf16_t, O_U16)});
    { const int cv = (gridDim.x >= 256u) ? (int)bid - 128 : (int)bid;
      if (cv >= 0) run_gemm(lds, WSP(bf16_t, O_WIN) + (size_t)1536 * 1024, WSP(bf16_t, O_XN), 512, NTOK, 1024, cv, GEpiVT{WSP(bf16_t, O_VT)}); }
    SEAM(0);
  }
  DBG_DUMP_BF16(1, O_QK)
  DBG_DUMP_CYC(20, WSP(bf16_t, O_WGLU), 262144)
  DBG_DUMP_CYC(21, WSP(bf16_t, O_WOUT), 1048576)
  DBG_DUMP_CYC(22, WSP(bf16_t, O_MEMN), 524288)
  for (int rep = 0; rep < R_ATT; ++rep) {
    ph_attn(WSP(bf16_t, O_QK), WSP(bf16_t, O_QK + 16), WSP(bf16_t, O_VT), KP(I_g_attn_out), WSP(bf16_t, O_MIX), lds);
    if (rep + 1 < R_ATT) SEAM(1);
  }
  for (int rep = 0; rep < R_SSM; ++rep) {
    ph_ssm<false>(KP(I_d_skip), WSP(bf16_t, O_U16), make_ssmc(), WSP(bf16_t, O_Y), lds);
    SEAM(1);
    ph_ssm<true>(KP(I_d_skip), WSP(bf16_t, O_U16), make_ssmc(), WSP(bf16_t, O_Y), lds);
    SEAM(2);
  }
#if defined(DBG_DELAY) && DBG_DELAY > 0
  { const unsigned long long t0_ = __builtin_amdgcn_s_memrealtime(); while (__builtin_amdgcn_s_memrealtime() - t0_ < (unsigned long long)DBG_DELAY * 100ull) __builtin_amdgcn_s_sleep(32); }
  SEAM(2);
#endif
  DBG_DUMP_HALF(2, O_MIX, 1024, 0)
  DBG_DUMP_HALF(3, O_Y, 512, 0)
  DBG_DUMP_HALF(13, O_U16, 512, 0)
  for (int rep = 0; rep < R_GEMM; ++rep) {
#if defined(DBG_INV) && DBG_INV == 1
    asm volatile("buffer_inv sc0 sc1\n\ts_waitcnt vmcnt(0)" ::: "memory"); __syncthreads();
#endif
#if defined(DBG_GLU_A) && DBG_GLU_A == 1
    run_gemm(lds, WSP(bf16_t, O_XN), WSP(bf16_t, O_WGLU), NTOK, 512, 512, bid, GEpiGlu{WSP(bf16_t, O_Y), KP(I_b_glu), WSP(bf16_t, O_MIX)});
#elif defined(DBG_GLU_A) && DBG_GLU_A == 3
    run_gemm(lds, WSP(bf16_t, O_U16), WSP(bf16_t, O_WGLU), NTOK, 512, 512, bid, GEpiGlu{WSP(bf16_t, O_Y), KP(I_b_glu), WSP(bf16_t, O_MIX)});
#elif defined(DBG_GLU_A) && DBG_GLU_A == 2
    run_gemm(lds, WSP(bf16_t, O_Y), WSP(bf16_t, O_WIN), NTOK, 512, 512, bid, GEpiGlu{WSP(bf16_t, O_Y), KP(I_b_glu), WSP(bf16_t, O_MIX)});
#else
    run_gemm_nc(lds, WSP(bf16_t, O_Y), WSP(bf16_t, O_WGLU), NTOK, 512, 512, bid, GEpiGluN{WSP(bf16_t, O_Y), KP(I_b_glu), WSP(bf16_t, O_MIX), KP(I_g_ssm_out), SS3_PTR, CNT3_PTR});
#endif
    if (bid >= 128 && bid < 136) run_gemm(lds, WSP(bf16_t, O_MEMN), WSP(bf16_t, O_WXKV), 512, 1024, 1024, bid - 128, GEpiXkv{WSP(bf16_t, O_KM), WSP(bf16_t, O_VTM)});
    if (bid >= 136 && bid < 144) run_gemm(lds, WSP(bf16_t, O_WXKV) + (size_t)1024 * 1024, WSP(bf16_t, O_MEMN), 1024, 512, 1024, bid - 136, GEpiXvT{WSP(bf16_t, O_VTM)});
    if (LATE_PREP && gridDim.x > 144u && bid >= 144) {
      if (LATE_W) prep_weights<1>(lds, bid - 144, (int)gridDim.x - 144);
      if (LATE_UF > 0) { const size_t nlate = (size_t)LATE_UF * 2048 * 1024, n0 = (size_t)16384 * 1024 - nlate;
        prep_cvt_fp4(KP(I_peer_u) + n0, WSP(unsigned char, O_PU8) + n0 / 2, nlate, PU4_SCALE, bid - 144, (int)gridDim.x - 144); }
      if (LATE_VF > 0) { const size_t nlate = (size_t)LATE_VF * 2048 * 1024, n0 = (size_t)16384 * 1024 - nlate;
        prep_cvt_fp4(KP(I_peer_v) + n0, WSP(unsigned char, O_PV8) + n0 / 2, nlate, PV4_SCALE, bid - 144, (int)gridDim.x - 144); }
    }
    SEAM(3);
  }
  DBG_DUMP_HALF(14, O_MIX, 1024, 512)
  DBG_DUMP_HALF(15, O_Y, 512, 0)
  DBG_DUMP_CYC(16, (const bf16_t*)make_ssmc().E, 1048576)
  DBG_DUMP_BF16(4, O_MIX)
  for (int rep = 0; rep < R_GEMM; ++rep) {
    run_gemm(lds, WSP(bf16_t, O_MIX), WSP(bf16_t, O_WOUT), NTOK, 1024, 1024, bid, GEpiResB<false>{KP(I_x), WSP(bf16_t, O_XN), SS1_PTR});
    SEAM(5);
    DBG_DUMP_BF16(5, O_XN)
    for (int xb_i = 0; xb_i < R_BAR; ++xb_i) SEAM(5);
  }
  for (int rep = 0; rep < R_GEMM * R_XQ; ++rep) {
    run_gemm(lds, WSP(bf16_t, O_XN), WSP(bf16_t, O_WXQ), NTOK, 1024, 1024, bid, GEpiBf16S{WSP(bf16_t, O_QK), 1024, SS1_PTR});
    if (threadIdx.x == 0) { __builtin_amdgcn_fence(__ATOMIC_ACQUIRE, "agent"); asm volatile("s_waitcnt vmcnt(0)" ::: "memory"); }
  __syncthreads();
  }
  for (int rep = 0; rep < R_XAT; ++rep) {
    ph_xattn(WSP(bf16_t, O_QK), WSP(bf16_t, O_KM), WSP(bf16_t, O_VTM), WSP(bf16_t, O_XO), lds);
    SEAM(8);
    DBG_DUMP_BF16(8, O_XO)
  }
  run_gemm(lds, WSP(bf16_t, O_XO), WSP(bf16_t, O_WXO), NTOK, 1024, 1024, bid, GEpiResB<true>{WSP(bf16_t, O_XN), WSP(bf16_t, O_MIX), SS2_PTR});
  SEAM(9);
  DBG_DUMP_BF16(9, O_MIX)
  for (int rep = 0; rep < R_GEMM * R_PQ; ++rep) {
#if STAG_PQ > 0
    if ((bid >> 3) & 1) { const unsigned long long t0_ = __builtin_amdgcn_s_memrealtime(); while (__builtin_amdgcn_s_memrealtime() - t0_ < (unsigned long long)STAG_PQ * 100ull) __builtin_amdgcn_s_sleep(8); }
#endif
    run_gemm(lds, WSP(bf16_t, O_MIX), WSP(bf16_t, O_WPQ), NTOK, 2048, 1024, bid, GEpiBf16S{WSP(bf16_t, O_QK), 2048, SS2_PTR});
    if (threadIdx.x == 0) { __builtin_amdgcn_fence(__ATOMIC_ACQUIRE, "agent"); asm volatile("s_waitcnt vmcnt(0)" ::: "memory"); }
  __syncthreads();
  }
  for (int rep = 0; rep < R_RTE; ++rep) {
    ph_route(WSP(bf16_t, O_QK), WSP(bf16_t, O_SKB), WSP(int, O_EXP), WSP(float, O_GATE), lds);
    SEAM(12);
  }
  for (int rep = 0; rep < R_GATH; ++rep) {
    float* Hout = (rep + 1 < R_GATH) ? WSP(float, O_QK) : (float*)KP(I_H);
    ph_gather18<GATH_NS, GATH_NB, GATH_NBU>(WSP(bf16_t, O_MIX), WSP(int, O_EXP), WSP(float, O_GATE), WSP(unsigned char, O_PU8), WSP(unsigned char, O_PV8), KP(I_g_final), KP(I_H), Hout, lds, SS2_PTR, KP(I_g_ffn));
    if (rep + 1 < R_GATH) SEAM(13);
  }
}

extern "C" void kernel_launch(void* const* d_in, const int* in_sizes, int n_in, void* d_out, int out_size, void* d_ws,
                              size_t ws_size, hipStream_t stream) {
  Params P{};
  const float** pp = (const float**)&P;
  for (int i = 0; i < 28; ++i) pp[i] = (const float*)d_in[i];
  P.H = (float*)d_out; P.ws = (char*)d_ws;
  static int grid_blocks = 0;
  if (!grid_blocks) {
    int dev = 0, cus = 0, per_cu = 0;
    (void)hipGetDevice(&dev);
    (void)hipDeviceGetAttribute(&cus, hipDeviceAttributeMultiprocessorCount, dev);
    (void)hipFuncSetAttribute((const void*)fwd_megakernel, hipFuncAttributeMaxDynamicSharedMemorySize, LDS_BYTES);
    (void)hipOccupancyMaxActiveBlocksPerMultiprocessor(&per_cu, fwd_megakernel, NTHR, LDS_BYTES);
    grid_blocks = per_cu >= 1 ? cus : -1;
  }
  if (grid_blocks < 0) return;
#if FIRST_SEAM_XCD
  (void)hipMemsetAsync((char*)d_ws + (size_t)O_BAR * 1048576, 0, XCD_BAR_WORDS * 4, stream);
#endif
  void* args[] = {&P};
  (void)hipLaunchCooperativeKernel((void*)fwd_megakernel, dim3(grid_blocks), dim3(NTHR), args, LDS_BYTES, stream);
}
```

```cpp
#define LATE_W 0
#include <hip/hip_runtime.h>
#include <stdint.h>
#include <hip/hip_cooperative_groups.h>
namespace cg = cooperative_groups;

typedef unsigned short bf16_t;

#define NTOK 16384
#define SEQ 8192
#define DM 1024

__device__ __forceinline__ bf16_t f2bf(float f) {
  unsigned u = __float_as_uint(f);
  u += 0x7fffu + ((u >> 16) & 1u);
  return (bf16_t)(u >> 16);
}
__device__ __forceinline__ float bf2f(bf16_t h) { return __uint_as_float(((unsigned)h) << 16); }
__device__ __forceinline__ float bflo(unsigned u) { return __uint_as_float(u << 16); }
__device__ __forceinline__ float bfhi(unsigned u) { return __uint_as_float(u & 0xffff0000u); }

__device__ __forceinline__ float wave_sum(float v) {
#pragma unroll
  for (int o = 32; o >= 1; o >>= 1) v += __shfl_xor(v, o);
  return v;
}
__device__ __forceinline__ float wave_max(float v) {
#pragma unroll
  for (int o = 32; o >= 1; o >>= 1) v = fmaxf(v, __shfl_xor(v, o));
  return v;
}
__device__ __forceinline__ float gelu_tanh(float x) {
  float y = 0.7978845608028654f * (x + 0.044715f * x * x * x);
  return x / (1.0f + __expf(-2.0f * y));
}
__device__ __forceinline__ float sigmoidf_(float x) { return 1.0f / (1.0f + __expf(-x)); }
__device__ __forceinline__ float softplusf_(float z) { return fmaxf(z, 0.f) + log1pf(expf(-fabsf(z))); }

__device__ __forceinline__ float ldA(const float* p) { return *p; }
__device__ __forceinline__ float ldA(const bf16_t* p) { return bf2f(*p); }


namespace pg8 {
#define PG8_LAS __attribute__((address_space(3)))
typedef unsigned short bf16_t;
typedef short bf16x8 __attribute__((ext_vector_type(8)));
typedef float f32x4 __attribute__((ext_vector_type(4)));
typedef unsigned u32x4 __attribute__((ext_vector_type(4)));
constexpr int BM = 256, BK = 64, HALF = 128, HTB = HALF * BK * 2  , STAGE_BYTES = 8 * HTB, NXCD = 8, WGM = 8;

__host__ __device__ __forceinline__ int lds_byte(int r, int c) { const int st = (r >> 4) * 2 + (c >> 5), rr = r & 15, cc = c & 31, ob = rr * 64 + cc * 2; return st * 1024 + (ob ^ (((ob >> 9) & 1) << 5)); }
__host__ __device__ __forceinline__ void stage_rc(int b, int& R, int& C) { const int st = b / 1024, sb = b % 1024, swz = sb ^ (((sb >> 9) & 1) << 5); R = (st >> 1) * 16 + swz / 64; C = (st & 1) * 32 + (swz % 64) / 2; }
__host__ __device__ __forceinline__ int perm32(int rho) { const int n = rho >> 4, i = rho & 15; return 8 * (i >> 2) + 4 * n + (i & 3); }

struct Unit { int pm, pn; };
struct Gemm { const bf16_t* A; const bf16_t* Bt; int M, N, K; };

struct StaticOrder {
    int nM, nN, nwg, G, c;
    __host__ __device__ void init(int M, int N, int G_, int c_) { nM = M / BM; nN = N / BM; nwg = nM * nN; G = G_; c = c_; }
    __host__ __device__ bool next(int i, Unit& u) const {
        const long L = (long)i * G + c; if (L >= nwg) return false;
        int wgid = (int)L; { const int q = nwg / NXCD, r = nwg % NXCD, xcd = wgid % NXCD, off = wgid / NXCD; wgid = (xcd < r ? xcd * (q + 1) : r * (q + 1) + (xcd - r) * q) + off; }
        const int nig = WGM * nN, gid = wgid / nig, fm = gid * WGM, gsz = (nM - fm) < WGM ? (nM - fm) : WGM;
        u.pm = fm + ((wgid % nig) % gsz); u.pn = (wgid % nig) / gsz; return true;
    }
    __device__ __forceinline__ void a_ready(const Unit&) const {}
    __device__ __forceinline__ void done(const Unit&) const {}
};
typedef __bf16 bf16x2_cv __attribute__((ext_vector_type(2)));
typedef float f32x2_cv __attribute__((ext_vector_type(2)));
__device__ __forceinline__ unsigned cvt_pk_bf16(float lo, float hi) { const f32x2_cv v = {lo, hi}; return __builtin_bit_cast(unsigned, __builtin_convertvector(v, bf16x2_cv)); }
typedef float f32x2 __attribute__((ext_vector_type(2)));
__device__ __forceinline__ f32x2 gelu_pk(f32x2 v) {
    const f32x2 av = __builtin_elementwise_abs(v), d = av * 0.2316418882f + 1.0f;
    f32x2 t; t.x = __builtin_amdgcn_rcpf(d.x); t.y = __builtin_amdgcn_rcpf(d.y);
    f32x2 q = t * 0.5307027145f + (-0.7265760135f); q = q * t + 0.7107068705f; q = q * t + (-0.142248368f); q = q * t + 0.127414796f; q = q * t;
    const f32x2 s = (v * v) * (-0.72134752044f);
    f32x2 e; e.x = __builtin_amdgcn_exp2f(s.x); e.y = __builtin_amdgcn_exp2f(s.y);
    const f32x2 m = v * (q * e), r = v - m;
    f32x2 o; o.x = v.x < 0.f ? m.x : r.x; o.y = v.y < 0.f ? m.y : r.y; return o;
}

struct EpiF32 {
    static constexpr bool PERM = false, AFTER_DRAIN = false;
    float* C; int ldc; const float* bias;
    __device__ __forceinline__ void operator()(const f32x4 (&acc)[2][2][4][2], const Unit& u, int wr, int wc, int fr, int fq) const {
        const int row0 = u.pm * BM + wr * 64 + fr, col0 = u.pn * BM + wc * 32 + 4 * fq;
        f32x4 bv[2][2];
#pragma unroll
        for (int bj = 0; bj < 2; ++bj)
#pragma unroll
            for (int n = 0; n < 2; ++n) bv[bj][n] = bias ? *(const f32x4*)(bias + col0 + bj * HALF + n * 16) : (f32x4){0.f, 0.f, 0.f, 0.f};
#pragma unroll
        for (int ai = 0; ai < 2; ++ai)
#pragma unroll
            for (int m = 0; m < 4; ++m) { float* rowp = C + (size_t)(row0 + ai * HALF + m * 16) * ldc + col0;
#pragma unroll
                for (int bj = 0; bj < 2; ++bj)
#pragma unroll
                    for (int n = 0; n < 2; ++n) *(f32x4*)(rowp + bj * HALF + n * 16) = acc[ai][bj][m][n] + bv[bj][n]; }
    }
};
template <int ACT  > struct EpiBf16 {
    static constexpr bool PERM = true, AFTER_DRAIN = false;
    bf16_t* O; int ldc; const float* bias; int split_cols; size_t split_stride;
    __device__ __forceinline__ void operator()(const f32x4 (&acc)[2][2][4][2], const Unit& u, int wr, int wc, int fr, int fq) const {
        const int row0 = u.pm * BM + wr * 64 + fr; int colt = u.pn * BM; bf16_t* base = O;
        if (split_cols) { const int t = colt / split_cols; base += (size_t)t * split_stride; colt -= t * split_cols; }
        const int col0 = colt + wc * 32 + 8 * fq, bcol0 = u.pn * BM + wc * 32 + 8 * fq;
        f32x4 bv[2][2];
#pragma unroll
        for (int bj = 0; bj < 2; ++bj)
#pragma unroll
            for (int n = 0; n < 2; ++n) bv[bj][n] = bias ? *(const f32x4*)(bias + bcol0 + bj * HALF + 4 * n) : (f32x4){0.f, 0.f, 0.f, 0.f};
#pragma unroll
        for (int ai = 0; ai < 2; ++ai)
#pragma unroll
            for (int m = 0; m < 4; ++m) { bf16_t* rowp = base + (size_t)(row0 + ai * HALF + m * 16) * ldc + col0;
#pragma unroll
                for (int bj = 0; bj < 2; ++bj) { f32x4 v0 = acc[ai][bj][m][0] + bv[bj][0], v1 = acc[ai][bj][m][1] + bv[bj][1];
                    if (ACT == 1) { f32x2 a = gelu_pk((f32x2){v0[0], v0[1]}), b = gelu_pk((f32x2){v0[2], v0[3]}), c = gelu_pk((f32x2){v1[0], v1[1]}), d = gelu_pk((f32x2){v1[2], v1[3]});
                        v0 = (f32x4){a.x, a.y, b.x, b.y}; v1 = (f32x4){c.x, c.y, d.x, d.y}; }
                    if (ACT == 2) {
#pragma unroll
                        for (int j = 0; j < 4; ++j) { v0[j] = 0.5f * v0[j] * (1.0f + erff(v0[j] * 0.70710678f)); v1[j] = 0.5f * v1[j] * (1.0f + erff(v1[j] * 0.70710678f)); } }
                    u32x4 w; w.x = cvt_pk_bf16(v0[0], v0[1]); w.y = cvt_pk_bf16(v0[2], v0[3]); w.z = cvt_pk_bf16(v1[0], v1[1]); w.w = cvt_pk_bf16(v1[2], v1[3]);
                    *(u32x4*)(rowp + bj * HALF) = w; } }
    }
};

template <class Epi, class Sched, bool STAMP = false>
__device__ __forceinline__ void gemm_phase(PG8_LAS unsigned char* lds, const Gemm g, const Sched& S, const Epi& E, unsigned long long* stamps) {
    int tid_ = threadIdx.x; asm volatile("" : "+v"(tid_));
    const int tid = tid_, wid = __builtin_amdgcn_readfirstlane(tid >> 6), lane = tid & 63, wr = wid >> 2, wc = wid & 3, fr = lane & 15, fq = lane >> 4;
    const int K = g.K, nt = K / BK;
    int ts_lo = 0, ts_hi = 0, nts = 0; const unsigned long long rt_entry = STAMP ? (unsigned long long)wall_clock64() : 0ull;
#define PG8_STAMP() do { if (STAMP && wid == 0 && nts < 64) { const unsigned long long _c = (unsigned long long)clock64(); \
        ts_lo = (lane == nts) ? (int)(unsigned)_c : ts_lo; ts_hi = (lane == nts) ? (int)(unsigned)(_c >> 32) : ts_hi; ++nts; } } while (0)
    PG8_STAMP();
    unsigned voffA[2], voffB[2];
#pragma unroll
    for (int i = 0; i < 2; ++i) { int R, C; stage_rc(tid * 16 + i * 8192, R, C); const int Rb = Epi::PERM ? ((R & ~31) + perm32(R & 31)) : R;
        voffA[i] = (unsigned)(R * K + C) * 2u; voffB[i] = (unsigned)(Rb * K + C) * 2u; }
    const size_t kstep = (size_t)(BK * 2);
    const size_t hstep = (size_t)HALF * K * 2;
    const size_t tstep = 2 * hstep;
    const unsigned ldsw = (unsigned)wid * 1024u;
    const int aoff = lds_byte(wr * 64 + fr, fq * 8), boff = lds_byte(wc * 32 + fr, fq * 8);
#define PG8_SA(b, h) (((b) * 2 + (h)) * HTB)
#define PG8_SB(b, h) ((4 + (b) * 2 + (h)) * HTB)
#define PG8_STAGE(bufoff, gbase, voff) do { _Pragma("unroll") for (int _i = 0; _i < 2; ++_i) \
        __builtin_amdgcn_global_load_lds((const unsigned*)((const char*)(gbase) + (voff)[_i]), (PG8_LAS unsigned*)(lds + (bufoff) + ldsw + _i * 8192), 16, 0, 0); } while (0)
#define PG8_LDA(dst, b, h) do { _Pragma("unroll") for (int m = 0; m < 4; ++m) _Pragma("unroll") for (int k = 0; k < 2; ++k) dst[m][k] = *(const PG8_LAS bf16x8*)(lds + PG8_SA(b, h) + aoff + m * 2048 + k * 1024); } while (0)
#define PG8_LDB(dst, b, h) do { _Pragma("unroll") for (int n = 0; n < 2; ++n) _Pragma("unroll") for (int k = 0; k < 2; ++k) dst[n][k] = *(const PG8_LAS bf16x8*)(lds + PG8_SB(b, h) + boff + n * 2048 + k * 1024); } while (0)
#define PG8_MMA(ai, bj, At, Bt) do { __builtin_amdgcn_s_setprio(1); _Pragma("unroll") for (int m = 0; m < 4; ++m) _Pragma("unroll") for (int n = 0; n < 2; ++n) _Pragma("unroll") for (int k = 0; k < 2; ++k) \
        acc[ai][bj][m][n] = __builtin_amdgcn_mfma_f32_16x16x32_bf16(Bt[n][k], At[m][k], acc[ai][bj][m][n], 0, 0, 0); __builtin_amdgcn_s_setprio(0); } while (0)
#define PG8_WAIT_V(n) asm volatile("s_waitcnt vmcnt(" #n ")" ::: "memory")
#define PG8_WAIT_L(n) asm volatile("s_waitcnt lgkmcnt(" #n ")" ::: "memory")
#define PG8_BAR __builtin_amdgcn_s_barrier()
#define PG8_SCHED __builtin_amdgcn_sched_barrier(0)
    Unit cur, nxt; int ui = 0;
    if (!S.next(0, cur)) return;
    f32x4 acc[2][2][4][2];
#pragma unroll
    for (int a = 0; a < 2; ++a)
#pragma unroll
        for (int b = 0; b < 2; ++b)
#pragma unroll
            for (int m = 0; m < 4; ++m)
#pragma unroll
                for (int n = 0; n < 2; ++n) acc[a][b][m][n] = (f32x4){0.f, 0.f, 0.f, 0.f};
    bf16x8 At[4][2], B0[2][2], B1[2][2];
    const char* cA = (const char*)g.A + (size_t)cur.pm * tstep; const char* cB = (const char*)g.Bt + (size_t)cur.pn * tstep;
    S.a_ready(cur);
    PG8_STAGE(PG8_SB(0, 0), cB, voffB); PG8_STAGE(PG8_SA(0, 0), cA, voffA); PG8_STAGE(PG8_SB(0, 1), cB + hstep, voffB); PG8_STAGE(PG8_SA(0, 1), cA + hstep, voffA);
    if (wr == 1) PG8_BAR;
    PG8_WAIT_V(4); PG8_BAR;
    PG8_STAGE(PG8_SB(1, 0), cB + kstep, voffB); PG8_STAGE(PG8_SA(1, 0), cA + kstep, voffA); PG8_STAGE(PG8_SB(1, 1), cB + hstep + kstep, voffB);
    PG8_WAIT_V(6); PG8_BAR;
    PG8_STAMP();
    for (;;) {
        const bool has_next = S.next(ui + 1, nxt);
        const char* nA = has_next ? (const char*)g.A + (size_t)nxt.pm * tstep : cA; const char* nB = has_next ? (const char*)g.Bt + (size_t)nxt.pn * tstep : cB;
        for (int t = 0; t < nt; t += 2) {
            const bool last = (t == nt - 2);
            const char* a1 = cA + (size_t)(t + 1) * kstep;
            const char* a2 = last ? nA : cA + (size_t)(t + 2) * kstep; const char* b2 = last ? nB : cB + (size_t)(t + 2) * kstep;
            const char* a3 = a2 + kstep; const char* b3 = b2 + kstep;
            if (last && has_next) S.a_ready(nxt);
            PG8_LDB(B0, 0, 0); PG8_SCHED; PG8_LDA(At, 0, 0); PG8_STAGE(PG8_SA(1, 1), a1 + hstep, voffA);
            PG8_WAIT_L(8); PG8_BAR; PG8_WAIT_L(0); PG8_MMA(0, 0, At, B0); PG8_BAR; PG8_SCHED;
            PG8_LDB(B1, 0, 1); PG8_STAGE(PG8_SB(0, 0), b2, voffB);
            PG8_BAR; PG8_WAIT_L(0); PG8_MMA(0, 1, At, B1); PG8_BAR;
            PG8_LDA(At, 0, 1); PG8_STAGE(PG8_SA(0, 0), a2, voffA);
            PG8_BAR; PG8_WAIT_L(0); PG8_MMA(1, 0, At, B0); PG8_BAR; PG8_SCHED;
            PG8_STAGE(PG8_SB(0, 1), b2 + hstep, voffB);
            PG8_WAIT_V(6); PG8_BAR; PG8_MMA(1, 1, At, B1); PG8_BAR;
            PG8_LDB(B0, 1, 0); PG8_SCHED; PG8_LDA(At, 1, 0); PG8_STAGE(PG8_SA(0, 1), a2 + hstep, voffA);
            PG8_WAIT_L(8); PG8_BAR; PG8_WAIT_L(0); PG8_MMA(0, 0, At, B0); PG8_BAR; PG8_SCHED;
            PG8_LDB(B1, 1, 1); PG8_STAGE(PG8_SB(1, 0), b3, voffB);
            PG8_BAR; PG8_WAIT_L(0); PG8_MMA(0, 1, At, B1); PG8_BAR;
            PG8_LDA(At, 1, 1); PG8_STAGE(PG8_SA(1, 0), a3, voffA);
            PG8_BAR; PG8_WAIT_L(0); PG8_MMA(1, 0, At, B0); PG8_BAR; PG8_SCHED;
            PG8_STAGE(PG8_SB(1, 1), b3 + hstep, voffB);
            PG8_WAIT_V(6); PG8_BAR; PG8_MMA(1, 1, At, B1); PG8_BAR;
        }
        PG8_STAMP();
        if constexpr (!Epi::AFTER_DRAIN) { E(acc, cur, wr, wc, fr, fq); S.done(cur); }
        PG8_STAMP();
        if (!has_next) break;
#pragma unroll
        for (int a = 0; a < 2; ++a)
#pragma unroll
            for (int b = 0; b < 2; ++b)
#pragma unroll
                for (int m = 0; m < 4; ++m)
#pragma unroll
                    for (int n = 0; n < 2; ++n) acc[a][b][m][n] = (f32x4){0.f, 0.f, 0.f, 0.f};
        cur = nxt; cA = nA; cB = nB; ++ui;
    }
    PG8_WAIT_V(0);
    if (wr == 0) PG8_BAR;
    PG8_BAR;
    if constexpr (Epi::AFTER_DRAIN) { E.fused(acc, cur, wr, wc, fr, fq, lds, wid, lane); S.done(cur); }
    PG8_STAMP();
    if (STAMP && wid == 0) { stamps[lane] = lane < nts ? (((unsigned long long)(unsigned)ts_hi << 32) | (unsigned)ts_lo) : 0ull;
        if (lane == 62) stamps[62] = rt_entry; if (lane == 63) stamps[63] = (unsigned long long)wall_clock64(); }
#undef PG8_STAMP
#undef PG8_SA
#undef PG8_SB
#undef PG8_STAGE
#undef PG8_LDA
#undef PG8_LDB
#undef PG8_MMA
#undef PG8_WAIT_V
#undef PG8_WAIT_L
#undef PG8_BAR
#undef PG8_SCHED
}
}
#define NTHR 512
#define NWAVE 8
__device__ __forceinline__ void wave_lds_sync() { __builtin_amdgcn_fence(__ATOMIC_ACQ_REL, "workgroup"); __builtin_amdgcn_wave_barrier(); }

struct Params {
  const float *x, *mem, *g_mix, *w_in, *a_re, *a_im, *log_dt, *b_re, *b_im, *c_re, *c_im, *d_skip, *w_glu, *b_glu,
      *g_attn_out, *g_ssm_out, *w_out, *g_xattn, *g_mem, *w_xq, *w_xkv, *w_xo, *g_ffn, *w_pq, *sub_keys, *peer_u, *peer_v, *g_final;
  float* H; char* ws;
};

__device__ void ph_rmsnorm(const float* __restrict__ x, const float* __restrict__ g, bf16_t* __restrict__ out, int rows) {
  int lane = threadIdx.x & 63;
  for (int row = blockIdx.x * NWAVE + (threadIdx.x >> 6); row < rows; row += gridDim.x * NWAVE) {
    const float* xr = x + (size_t)row * 1024;
    float v[16]; float ss = 0.f;
#pragma unroll
    for (int i = 0; i < 16; ++i) { v[i] = xr[lane + 64 * i]; ss += v[i] * v[i]; }
    ss = wave_sum(ss);
    float r = rsqrtf(ss / 1024.f + 1e-6f);
#pragma unroll
    for (int i = 0; i < 16; ++i) out[(size_t)row * 1024 + lane + 64 * i] = f2bf(v[i] * r * g[lane + 64 * i]);
  }
}
__device__ void ph_mixnorm(bf16_t* __restrict__ mix, const float* __restrict__ ga, const float* __restrict__ gs) {
  int lane = threadIdx.x & 63;
  for (int w = blockIdx.x * NWAVE + (threadIdx.x >> 6); w < NTOK * 2; w += gridDim.x * NWAVE) {
    int row = w >> 1, half = w & 1;
    bf16_t* p = mix + (size_t)row * 1024 + half * 512;
    const float* g = half ? gs : ga;
    float v[8]; float ss = 0.f;
#pragma unroll
    for (int i = 0; i < 8; ++i) { v[i] = bf2f(p[lane + 64 * i]); ss += v[i] * v[i]; }
    ss = wave_sum(ss);
    float r = rsqrtf(ss / 512.f + 1e-6f);
#pragma unroll
    for (int i = 0; i < 8; ++i) p[lane + 64 * i] = f2bf(v[i] * r * g[lane + 64 * i]);
  }
}

struct EpiInProj { bf16_t* qkv; float* u;
  __device__ void operator()(int m, int n, float acc) const {
    if (n < 1536) qkv[(size_t)m * 1536 + n] = f2bf(acc); else u[(size_t)m * 512 + (n - 1536)] = acc; } };
struct EpiGlu { const bf16_t* y; const float* b; bf16_t* mix;
  __device__ void operator()(int m, int n, float acc) const {
    float yv = bf2f(y[(size_t)m * 512 + n]);
    mix[(size_t)m * 1024 + 512 + n] = f2bf(yv * sigmoidf_(acc + b[n])); } };
struct EpiResInit { const float* x; float* h;
  __device__ void operator()(int m, int n, float acc) const { h[(size_t)m * 1024 + n] = x[(size_t)m * 1024 + n] + acc; } };
struct EpiResAdd { float* h;
  __device__ void operator()(int m, int n, float acc) const { h[(size_t)m * 1024 + n] += acc; } };
struct EpiBf16 { bf16_t* o; int ld;
  __device__ void operator()(int m, int n, float acc) const { o[(size_t)m * ld + n] = f2bf(acc); } };

template <typename Epi>
__device__ void ph_gemm_naive(const bf16_t* __restrict__ A, int lda, const float* __restrict__ W, int N, int K, int M, Epi epi) {
  long total = (long)(M / 4) * N;
  for (long idx = (long)blockIdx.x * NTHR + threadIdx.x; idx < total; idx += (long)gridDim.x * NTHR) {
    int n = (int)(idx % N); int m0 = (int)(idx / N) * 4;
    float a0 = 0, a1 = 0, a2 = 0, a3 = 0;
    const bf16_t* Ar = A + (size_t)m0 * lda;
    for (int k = 0; k < K; ++k) {
      float w = W[(size_t)k * N + n];
      a0 += bf2f(Ar[k]) * w; a1 += bf2f(Ar[lda + k]) * w; a2 += bf2f(Ar[2 * lda + k]) * w; a3 += bf2f(Ar[3 * lda + k]) * w;
    }
    epi(m0, n, a0); epi(m0 + 1, n, a1); epi(m0 + 2, n, a2); epi(m0 + 3, n, a3);
  }
}

__device__ void ph_attn_naive(const bf16_t* __restrict__ qkv, bf16_t* __restrict__ mix) {
  for (int idx = blockIdx.x * NTHR + threadIdx.x; idx < 2 * 8 * SEQ; idx += gridDim.x * NTHR) {
    int t = idx & (SEQ - 1), h = (idx >> 13) & 7, b = idx >> 16;
    const bf16_t* base = qkv + (size_t)b * SEQ * 1536 + h * 64;
    float q[64], o[64];
    {
      const uint4* qp = (const uint4*)(base + (size_t)t * 1536);
#pragma unroll
      for (int i = 0; i < 8; ++i) {
        uint4 v = qp[i];
        q[8 * i + 0] = bflo(v.x); q[8 * i + 1] = bfhi(v.x); q[8 * i + 2] = bflo(v.y); q[8 * i + 3] = bfhi(v.y);
        q[8 * i + 4] = bflo(v.z); q[8 * i + 5] = bfhi(v.z); q[8 * i + 6] = bflo(v.w); q[8 * i + 7] = bfhi(v.w);
      }
    }
#pragma unroll
    for (int d = 0; d < 64; ++d) o[d] = 0.f;
    float C = 0.f;
    for (int s = t - 1; s >= 0; --s) {
      const uint4* kp = (const uint4*)(base + (size_t)s * 1536 + 512);
      float z = 0.f;
#pragma unroll
      for (int i = 0; i < 8; ++i) {
        uint4 v = kp[i];
        z += q[8 * i + 0] * bflo(v.x) + q[8 * i + 1] * bfhi(v.x) + q[8 * i + 2] * bflo(v.y) + q[8 * i + 3] * bfhi(v.y) +
             q[8 * i + 4] * bflo(v.z) + q[8 * i + 5] * bfhi(v.z) + q[8 * i + 6] * bflo(v.w) + q[8 * i + 7] * bfhi(v.w);
      }
      z *= 0.125f;
      C += softplusf_(z);
      float w = expf(z - C);
      const uint4* vp = (const uint4*)(base + (size_t)s * 1536 + 1024);
#pragma unroll
      for (int i = 0; i < 8; ++i) {
        uint4 v = vp[i];
        o[8 * i + 0] += w * bflo(v.x); o[8 * i + 1] += w * bfhi(v.x); o[8 * i + 2] += w * bflo(v.y); o[8 * i + 3] += w * bfhi(v.y);
        o[8 * i + 4] += w * bflo(v.z); o[8 * i + 5] += w * bfhi(v.z); o[8 * i + 6] += w * bflo(v.w); o[8 * i + 7] += w * bfhi(v.w);
      }
      if (C > 105.f) break;
    }
    bf16_t* op = mix + ((size_t)b * SEQ + t) * 1024 + h * 64;
#pragma unroll
    for (int d = 0; d < 64; d += 2) {
      unsigned pk = (unsigned)f2bf(o[d]) | ((unsigned)f2bf(o[d + 1]) << 16);
      *(unsigned*)(op + d) = pk;
    }
  }
}

__device__ void ph_ssm_naive(const Params& P, const float* __restrict__ U, bf16_t* __restrict__ Y, float* smem) {
  int wv = threadIdx.x >> 6, lane = threadIdx.x & 63, p = lane;
  float* xs = smem + wv * 128;
  for (int bg = blockIdx.x * NWAVE + wv; bg < 64; bg += gridDim.x * NWAVE) {
    int b = bg >> 5, g = bg & 31;
    double are = P.a_re[g * 64 + p], aim = P.a_im[g * 64 + p], dt = exp((double)P.log_dt[g]);
    double er = exp(are * dt), sn, cs; sincos(aim * dt, &sn, &cs);
    double lbr_d = er * cs, lbi_d = er * sn;
    double nr = lbr_d - 1.0, ni = lbi_d, den = are * are + aim * aim;
    double cr = (nr * are + ni * aim) / den, ci = (ni * are - nr * aim) / den;
    float lbr = (float)lbr_d, lbi = (float)lbi_d;
    float bbr[16], bbi[16];
#pragma unroll
    for (int c = 0; c < 16; ++c) {
      double br = P.b_re[(g * 64 + p) * 16 + c], bi = P.b_im[(g * 64 + p) * 16 + c];
      bbr[c] = (float)(cr * br - ci * bi); bbi[c] = (float)(cr * bi + ci * br);
    }
    int c2 = lane & 15, q2 = lane >> 4;
    float cre[16], cim[16];
#pragma unroll
    for (int j = 0; j < 16; ++j) {
      cre[j] = P.c_re[(g * 16 + c2) * 64 + q2 * 16 + j]; cim[j] = P.c_im[(g * 16 + c2) * 64 + q2 * 16 + j];
    }
    float dsk = P.d_skip[g * 16 + c2];
    float xr = 0.f, xi = 0.f;
    const float* Ub = U + (size_t)b * SEQ * 512 + g * 16;
    bf16_t* Yb = Y + (size_t)b * SEQ * 512 + g * 16;
    for (int t = 0; t < SEQ; ++t) {
      const float4* up = (const float4*)(Ub + (size_t)t * 512);
      float u[16];
#pragma unroll
      for (int i = 0; i < 4; ++i) { float4 v = up[i]; u[4 * i] = v.x; u[4 * i + 1] = v.y; u[4 * i + 2] = v.z; u[4 * i + 3] = v.w; }
      float bur = 0.f, bui = 0.f;
#pragma unroll
      for (int c = 0; c < 16; ++c) { bur += bbr[c] * u[c]; bui += bbi[c] * u[c]; }
      float nxr = lbr * xr - lbi * xi + bur, nxi = lbr * xi + lbi * xr + bui;
      xr = nxr; xi = nxi;
      wave_lds_sync();
      xs[p] = xr; xs[64 + p] = xi;
      wave_lds_sync();
      float acc = 0.f;
#pragma unroll
      for (int j = 0; j < 16; ++j) acc += cre[j] * xs[q2 * 16 + j] - cim[j] * xs[64 + q2 * 16 + j];
      acc += __shfl_xor(acc, 16); acc += __shfl_xor(acc, 32);
      if (lane < 16) {
        float y = acc + dsk * Ub[(size_t)t * 512 + c2];
        Yb[(size_t)t * 512 + c2] = f2bf(gelu_tanh(y));
      }
    }
  }
}

__device__ void ph_xattn_naive(const bf16_t* __restrict__ QX, const bf16_t* __restrict__ KV, bf16_t* __restrict__ XO, float* smem) {
  int wv = threadIdx.x >> 6, lane = threadIdx.x & 63;
  float* qs = smem + wv * 512; float* ps = qs + 256;
  for (int item = blockIdx.x * NWAVE + wv; item < NTOK * 4; item += gridDim.x * NWAVE) {
    int tok = item >> 2, h = item & 3, b = tok >> 13;
    wave_lds_sync();
    for (int i = lane; i < 256; i += 64) qs[i] = bf2f(QX[(size_t)tok * 1024 + h * 256 + i]);
    wave_lds_sync();
    float sc[4];
#pragma unroll
    for (int j = 0; j < 4; ++j) {
      int m = lane + 64 * j;
      const uint4* kp = (const uint4*)(KV + ((size_t)b * 256 + m) * 2048 + h * 256);
      float s = 0.f;
      for (int i = 0; i < 32; ++i) {
        uint4 v = kp[i]; const float* qq = &qs[8 * i];
        s += qq[0] * bflo(v.x) + qq[1] * bfhi(v.x) + qq[2] * bflo(v.y) + qq[3] * bfhi(v.y) + qq[4] * bflo(v.z) +
             qq[5] * bfhi(v.z) + qq[6] * bflo(v.w) + qq[7] * bfhi(v.w);
      }
      sc[j] = s * 0.0625f;
    }
    float mx = wave_max(fmaxf(fmaxf(sc[0], sc[1]), fmaxf(sc[2], sc[3])));
    float sum = 0.f;
#pragma unroll
    for (int j = 0; j < 4; ++j) { sc[j] = expf(sc[j] - mx); sum += sc[j]; }
    sum = wave_sum(sum);
    float inv = 1.0f / sum;
#pragma unroll
    for (int j = 0; j < 4; ++j) ps[lane + 64 * j] = sc[j] * inv;
    wave_lds_sync();
    float o0 = 0, o1 = 0, o2 = 0, o3 = 0;
    const bf16_t* vb = KV + (size_t)b * 256 * 2048 + 1024 + h * 256 + lane * 4;
    for (int m = 0; m < 256; ++m) {
      uint2 v = *(const uint2*)(vb + (size_t)m * 2048);
      float pm = ps[m];
      o0 += pm * bflo(v.x); o1 += pm * bfhi(v.x); o2 += pm * bflo(v.y); o3 += pm * bfhi(v.y);
    }
    uint2 pk; pk.x = (unsigned)f2bf(o0) | ((unsigned)f2bf(o1) << 16); pk.y = (unsigned)f2bf(o2) | ((unsigned)f2bf(o3) << 16);
    *(uint2*)(XO + (size_t)tok * 1024 + h * 256 + lane * 4) = pk;
  }
}

#define INS16(val, idx, V, I)                                   \
  {                                                             \
    float nv = (val); int ni = (idx);                           \
    _Pragma("unroll") for (int j = 0; j < 16; ++j) {            \
      bool gt = nv > V[j];                                      \
      float tv = gt ? V[j] : nv; int ti = gt ? I[j] : ni;       \
      V[j] = gt ? nv : V[j]; I[j] = gt ? ni : I[j];             \
      nv = tv; ni = ti;                                         \
    }                                                           \
  }

__device__ void ph_route_naive(const bf16_t* __restrict__ PQ, const float* __restrict__ subk, int* __restrict__ EXP,
                               float* __restrict__ GATE, float* smem) {
  float* qs = smem; float* sc = smem + 2048; float* tv = smem + 4096; int* ti = (int*)(smem + 4096 + 256);
  int tid = threadIdx.x;
  for (int tok = blockIdx.x; tok < NTOK; tok += gridDim.x) {
    __syncthreads();
    for (int i = tid; i < 2048; i += NTHR) qs[i] = bf2f(PQ[(size_t)tok * 2048 + i]);
    __syncthreads();
    for (int j = 0; j < 4; ++j) {
      int si = tid + NTHR * j;
      int hh = si >> 7;
      const float4* kp = (const float4*)(subk + (size_t)si * 128);
      const float* qq = qs + hh * 128;
      float s = 0.f;
      for (int d = 0; d < 32; ++d) { float4 v = kp[d]; s += qq[4 * d] * v.x + qq[4 * d + 1] * v.y + qq[4 * d + 2] * v.z + qq[4 * d + 3] * v.w; }
      sc[si] = s;
    }
    __syncthreads();
    if (tid < 16) {
      float V[16]; int I[16];
#pragma unroll
      for (int j = 0; j < 16; ++j) { V[j] = -3.0e38f; I[j] = 0; }
      for (int k = 0; k < 128; ++k) INS16(sc[tid * 128 + k], k, V, I)
#pragma unroll
      for (int j = 0; j < 16; ++j) { tv[tid * 16 + j] = V[j]; ti[tid * 16 + j] = I[j]; }
    }
    __syncthreads();
    if (tid < 8) {
      float V[16]; int I[16];
#pragma unroll
      for (int j = 0; j < 16; ++j) { V[j] = -3.0e38f; I[j] = 0; }
      for (int a = 0; a < 16; ++a)
        for (int bb = 0; bb < 16; ++bb) INS16(tv[(2 * tid) * 16 + a] + tv[(2 * tid + 1) * 16 + bb], a * 16 + bb, V, I)
      float mx = V[0], sum = 0.f;
      float e[16];
#pragma unroll
      for (int j = 0; j < 16; ++j) { e[j] = expf(V[j] - mx); sum += e[j]; }
      float inv = 1.f / sum;
#pragma unroll
      for (int j = 0; j < 16; ++j) {
        int pos = I[j];
        int i1 = ti[(2 * tid) * 16 + (pos >> 4)], i2 = ti[(2 * tid + 1) * 16 + (pos & 15)];
        EXP[(size_t)tok * 128 + tid * 16 + j] = i1 * 128 + i2;
        GATE[(size_t)tok * 128 + tid * 16 + j] = e[j] * inv;
      }
    }
  }
}

__device__ void ph_gather_naive(const bf16_t* __restrict__ HN, const int* __restrict__ EXP, const float* __restrict__ GATE,
                                const float* __restrict__ PU, const float* __restrict__ PV, const float* __restrict__ gfin,
                                float* __restrict__ H, float* smem) {
  float* part = smem;
  float* red = smem + 8192;
  int w = threadIdx.x >> 6, lane = threadIdx.x & 63;
  for (int tok = blockIdx.x; tok < NTOK; tok += gridDim.x) {
    float hn[16], acc[16];
#pragma unroll
    for (int i = 0; i < 16; ++i) { hn[i] = bf2f(HN[(size_t)tok * 1024 + lane + 64 * i]); acc[i] = 0.f; }
    for (int j = 0; j < 16; ++j) {
      int e = EXP[(size_t)tok * 128 + w * 16 + j];
      float gt = GATE[(size_t)tok * 128 + w * 16 + j];
      const float* ur = PU + (size_t)e * 1024;
      float d = 0.f;
#pragma unroll
      for (int i = 0; i < 16; ++i) d += hn[i] * ur[lane + 64 * i];
      d = wave_sum(d);
      float wgt = gt * gelu_tanh(d);
      const float* vr = PV + (size_t)e * 1024;
#pragma unroll
      for (int i = 0; i < 16; ++i) acc[i] += wgt * vr[lane + 64 * i];
    }
    __syncthreads();
#pragma unroll
    for (int i = 0; i < 16; ++i) part[w * 1024 + lane + 64 * i] = acc[i];
    __syncthreads();
    float v[2]; float ss = 0.f;
#pragma unroll
    for (int i = 0; i < 2; ++i) {
      int c = threadIdx.x + NTHR * i;
      float s = H[(size_t)tok * 1024 + c];
#pragma unroll
      for (int k = 0; k < 8; ++k) s += part[k * 1024 + c];
      v[i] = s; ss += s * s;
    }
    ss = wave_sum(ss);
    if (lane == 0) red[w] = ss;
    __syncthreads();
    float tot = 0.f;
#pragma unroll
    for (int k = 0; k < 8; ++k) tot += red[k];
    float r = rsqrtf(tot / 1024.f + 1e-6f);
#pragma unroll
    for (int i = 0; i < 2; ++i) { int c = threadIdx.x + NTHR * i; H[(size_t)tok * 1024 + c] = v[i] * r * gfin[c]; }
  }
}


#include <cstdint>
#define XB_TMO      128
#define XB_XCNT(j)  (256  + 64 * (j))
#define XB_XSUB(j)  (1280 + 64 * (j))
#define XB_XGEN(j)  (2304 + 64 * (j))
#define XB_TOP      3328
#define XB_TOPGEN   3392
#define XCD_BAR_WORDS 3456
#define XB_SPIN_CAP (1u << 18)
#define LAS __attribute__((address_space(3)))

__device__ __forceinline__ unsigned xb_ld(unsigned* p)              { return __hip_atomic_load(p, __ATOMIC_RELAXED, __HIP_MEMORY_SCOPE_AGENT); }
__device__ __forceinline__ unsigned xb_add(unsigned* p, unsigned v) { return __hip_atomic_fetch_add(p, v, __ATOMIC_RELAXED, __HIP_MEMORY_SCOPE_AGENT); }
__device__ __forceinline__ unsigned xb_xcc_id() { return (unsigned)__builtin_amdgcn_s_getreg((3 << 11) | 20) & 0xFu; }
#define XB_SPIN(cond, bar) do { unsigned _sp = 0; while (cond) { __builtin_amdgcn_s_sleep(1); \
    if ((++_sp & 255u) == 0u) { if (xb_ld(&(bar)[XB_TMO])) break; if (_sp > XB_SPIN_CAP) { atomicAdd(&(bar)[XB_TMO], 1u); break; } } } } while (0)

struct XcdBarrier {
    unsigned* bar; unsigned x;
    volatile LAS unsigned* st;
};

__device__ __forceinline__ XcdBarrier xcd_barrier_post(unsigned* bar, volatile LAS unsigned* st) {
    XcdBarrier b; b.bar = bar; b.x = xb_xcc_id(); b.st = st;
    if (threadIdx.x == 0) (void)xb_add(&bar[XB_XCNT(b.x)], 1u);
    return b;
}
__device__ __forceinline__ void xcd_barrier_complete(unsigned* bar, unsigned x, unsigned& nloc, unsigned& nx) {
    const unsigned G = gridDim.x * gridDim.y * gridDim.z;
    unsigned sum, cnt, mine, sp = 0u;
    for (;;) {
        sum = 0u; cnt = 0u; mine = 0u;
#pragma unroll
        for (unsigned j = 0; j < 16; ++j) { const unsigned c = xb_ld(&bar[XB_XCNT(j)]); sum += c; cnt += (c > 0u) ? 1u : 0u; mine = (j == x) ? c : mine; }
        if (sum == G) break;
        __builtin_amdgcn_s_sleep(1);
        if ((++sp & 255u) == 0u) { if (xb_ld(&bar[XB_TMO])) break; if (sp > XB_SPIN_CAP) { atomicAdd(&bar[XB_TMO], 1u); break; } }
    }
    nloc = mine > 0u ? mine : 1u; nx = cnt > 0u ? cnt : 1u;
}

__device__ __forceinline__ void xcd_barrier(const XcdBarrier& b) {
    asm volatile("s_waitcnt vmcnt(0)" ::: "memory");
    __syncthreads();
    if (threadIdx.x == 0) {
        unsigned* bar = b.bar;
        __builtin_amdgcn_s_waitcnt(0);
        unsigned nloc = b.st[0], nx = b.st[1];
        if (nloc == 0u) { xcd_barrier_complete(bar, b.x, nloc, nx); b.st[0] = nloc; b.st[1] = nx; }
        const unsigned old = xb_add(&bar[XB_XSUB(b.x)], 1u);
        const unsigned gen = old / nloc;
        if (old + 1u == (gen + 1u) * nloc) {
            __builtin_amdgcn_fence(__ATOMIC_RELEASE, "agent");
            asm volatile("s_waitcnt vmcnt(0)" ::: "memory");
            const unsigned og = xb_add(&bar[XB_TOP], 1u);
            const unsigned tg = og / nx;
            asm volatile("buffer_inv sc1" ::: "memory");
            if (og + 1u == (tg + 1u) * nx) xb_add(&bar[XB_TOPGEN], 1u);
            else XB_SPIN(xb_ld(&bar[XB_TOPGEN]) == tg, bar);
            xb_add(&bar[XB_XGEN(b.x)], 1u);
            asm volatile("s_waitcnt vmcnt(0)" ::: "memory");
        } else {
            asm volatile("buffer_inv sc1" ::: "memory");
            XB_SPIN(xb_ld(&bar[XB_XGEN(b.x)]) == gen, bar);
            asm volatile("s_waitcnt vmcnt(0)" ::: "memory");
        }
    }
    __syncthreads();
}


enum { I_x = 0, I_mem, I_g_mix, I_w_in, I_a_re, I_a_im, I_log_dt, I_b_re, I_b_im, I_c_re, I_c_im, I_d_skip, I_w_glu, I_b_glu,
       I_g_attn_out, I_g_ssm_out, I_w_out, I_g_xattn, I_g_mem, I_w_xq, I_w_xkv, I_w_xo, I_g_ffn, I_w_pq, I_sub_keys, I_peer_u,
       I_peer_v, I_g_final, I_H, I_ws };
typedef __attribute__((address_space(4))) const char* kaptr_t;
__device__ __forceinline__ const float* KP(int i) {
  kaptr_t ka = (kaptr_t)__builtin_amdgcn_kernarg_segment_ptr();
  asm volatile("" : "+s"(ka));
  typedef const float* cfptr_t;
  typedef __attribute__((address_space(4))) const cfptr_t* slot_t;
  return *(slot_t)(ka + 8 * i);
}
#define WSP(T, mb) ((T*)((char*)KP(I_ws) + (size_t)(mb) * 1048576))
#define WSB(T, mb, extra) ((T*)((char*)KP(I_ws) + (size_t)(mb) * 1048576 + (extra)))
#define O_XN 0
#define O_QK 32
#define O_VT 64
#define O_U16 80
#define O_XO 80
#define O_MIX 112
#define O_Y 144
#define O_EXP 216
#define O_GATE 224
#define O_MEMN 160
#define O_KM 161
#define O_VTM 162
#define O_WIN 164
#define O_WGLU 168
#define O_WOUT 169
#define O_WXQ 171
#define O_WXKV 173
#define O_WXO 177
#define O_WPQ 179
#define O_PU8 184
#define O_PV8 200
#define O_SC 248
#define O_E 249
#define O_SKB 251
#define SS1_PTR WSB(float, O_SC, 524288)
#define SS2_PTR WSB(float, O_SC, 524288 + 65536)
#define SS3_PTR WSB(float, O_SC, 524288 + 131072)
#define CNT3_PTR WSB(unsigned, O_SC, 524288 + 196608)
#define O_BAR 252

#define DBG_CNT_PTR (WSP(unsigned, O_BAR) + 3400)

typedef float f32x4 __attribute__((ext_vector_type(4)));
typedef unsigned u32x4 __attribute__((ext_vector_type(4)));
__device__ __forceinline__ u32x4 pack8(const f32x4& v0, const f32x4& v1) {
  u32x4 w; w.x = pg8::cvt_pk_bf16(v0[0], v0[1]); w.y = pg8::cvt_pk_bf16(v0[2], v0[3]);
  w.z = pg8::cvt_pk_bf16(v1[0], v1[1]); w.w = pg8::cvt_pk_bf16(v1[2], v1[3]); return w;
}
struct GEpiInProj {
  static constexpr bool PERM = true, AFTER_DRAIN = false;
  bf16_t* qf; bf16_t* kf; bf16_t* vf; bf16_t* u;
  __device__ __forceinline__ void operator()(const f32x4 (&acc)[2][2][4][2], const pg8::Unit& un, int wr, int wc, int fr, int fq) const {
    const int row0 = un.pm * 256 + wr * 64 + fr, colt = un.pn * 256, col0 = colt + wc * 32 + 8 * fq;
#pragma unroll
    for (int ai = 0; ai < 2; ++ai)
#pragma unroll
      for (int m = 0; m < 4; ++m) {
        const int row = row0 + ai * 128 + m * 16;
        const int b = row >> 13, t = row & (SEQ - 1), blk = t >> 5, kk = t & 31;
#pragma unroll
        for (int bj = 0; bj < 2; ++bj) {
          const int col = col0 + bj * 128;
          if (colt >= 1024) *(u32x4*)(u + (size_t)row * 512 + (col - 1024)) = pack8(acc[ai][bj][m][0], acc[ai][bj][m][1]);
          else {
            const bool isk = colt >= 512;
            const int cc = col & 511, h = cc >> 6, d0 = cc & 63, s = d0 >> 4, h2 = (d0 >> 3) & 1;
            const int r = isk ? (8 * ((kk >> 2) & 3) + 4 * (kk >> 4) + (kk & 3)) : kk;
            const size_t idx = (((((size_t)((b * 8 + h) * 256 + blk)) * 4 + s) * 2 + h2) * 32 + r) * 8;
            *(u32x4*)((isk ? kf : qf) + idx) = pack8(acc[ai][bj][m][0], acc[ai][bj][m][1]);
          }
        }
      }
  }
};
struct GEpiVT {
  static constexpr bool PERM = true, AFTER_DRAIN = false;
  bf16_t* vf;
  __device__ __forceinline__ void operator()(const f32x4 (&acc)[2][2][4][2], const pg8::Unit& un, int wr, int wc, int fr, int fq) const {
    const int row0 = un.pm * 256 + wr * 64 + fr, col0 = un.pn * 256 + wc * 32 + 8 * fq;
#pragma unroll
    for (int ai = 0; ai < 2; ++ai)
#pragma unroll
      for (int m = 0; m < 4; ++m) {
        const int vc = row0 + ai * 128 + m * 16, h = vc >> 6, d0 = vc & 63, mb = d0 >> 5, c0 = d0 & 31;
#pragma unroll
        for (int bj = 0; bj < 2; ++bj) {
          const int tokn = col0 + bj * 128, b = tokn >> 13, t = tokn & (SEQ - 1), blk = t >> 5, kk = t & 31, hk = kk >> 4, s2 = (kk >> 3) & 1;
          *(u32x4*)(vf + ((((((size_t)((b * 8 + h) * 256 + blk)) * 2 + mb) * 2 + s2) * 2 + hk) * 32 + c0) * 8) = pack8(acc[ai][bj][m][0], acc[ai][bj][m][1]);
        }
      }
  }
};
struct GEpiGlu {
  static constexpr bool PERM = true, AFTER_DRAIN = false;
  const bf16_t* y; const float* b; bf16_t* mix;
  __device__ __forceinline__ void operator()(const f32x4 (&acc)[2][2][4][2], const pg8::Unit& un, int wr, int wc, int fr, int fq) const {
    const int row0 = un.pm * 256 + wr * 64 + fr, col0 = un.pn * 256 + wc * 32 + 8 * fq;
#pragma unroll
    for (int bj = 0; bj < 2; ++bj) {
      const int col = col0 + bj * 128;
      const f32x4 b0 = *(const f32x4*)(b + col), b1 = *(const f32x4*)(b + col + 4);
#pragma unroll
      for (int ai = 0; ai < 2; ++ai)
#pragma unroll
        for (int m = 0; m < 4; ++m) {
          const int row = row0 + ai * 128 + m * 16;
          const u32x4 yv = *(const u32x4*)(y + (size_t)row * 512 + col);
          f32x4 g0 = acc[ai][bj][m][0] + b0, g1 = acc[ai][bj][m][1] + b1, o0, o1;
          o0[0] = bflo(yv.x) * sigmoidf_(g0[0]); o0[1] = bfhi(yv.x) * sigmoidf_(g0[1]);
          o0[2] = bflo(yv.y) * sigmoidf_(g0[2]); o0[3] = bfhi(yv.y) * sigmoidf_(g0[3]);
          o1[0] = bflo(yv.z) * sigmoidf_(g1[0]); o1[1] = bfhi(yv.z) * sigmoidf_(g1[1]);
          o1[2] = bflo(yv.w) * sigmoidf_(g1[2]); o1[3] = bfhi(yv.w) * sigmoidf_(g1[3]);
#if defined(DBG_GLU) && DBG_GLU == 1
          o0[0] = bflo(yv.x); o0[1] = bfhi(yv.x); o0[2] = bflo(yv.y); o0[3] = bfhi(yv.y); o1[0] = bflo(yv.z); o1[1] = bfhi(yv.z); o1[2] = bflo(yv.w); o1[3] = bfhi(yv.w);
#elif defined(DBG_GLU) && DBG_GLU == 2
          o0 = acc[ai][bj][m][0]; o1 = acc[ai][bj][m][1];
#endif
          *(u32x4*)(mix + (size_t)row * 1024 + 512 + col) = pack8(o0, o1);
        }
    }
  }
};
struct GEpiRes {
  static constexpr bool PERM = false, AFTER_DRAIN = false;
  const float* base; float* h;
  __device__ __forceinline__ void operator()(const f32x4 (&acc)[2][2][4][2], const pg8::Unit& un, int wr, int wc, int fr, int fq) const {
    const int row0 = un.pm * 256 + wr * 64 + fr, col0 = un.pn * 256 + wc * 32 + 4 * fq;
#pragma unroll
    for (int ai = 0; ai < 2; ++ai)
#pragma unroll
      for (int m = 0; m < 4; ++m) {
        const size_t off = (size_t)(row0 + ai * 128 + m * 16) * 1024 + col0;
#pragma unroll
        for (int bj = 0; bj < 2; ++bj)
#pragma unroll
          for (int n = 0; n < 2; ++n) {
            const f32x4 bs = *(const f32x4*)(base + off + bj * 128 + n * 16);
            *(f32x4*)(h + off + bj * 128 + n * 16) = bs + acc[ai][bj][m][n];
          }
      }
  }
};
struct GEpiBf16 {
  static constexpr bool PERM = true, AFTER_DRAIN = false;
  bf16_t* o; int ld;
  __device__ __forceinline__ void operator()(const f32x4 (&acc)[2][2][4][2], const pg8::Unit& un, int wr, int wc, int fr, int fq) const {
    const int row0 = un.pm * 256 + wr * 64 + fr, col0 = un.pn * 256 + wc * 32 + 8 * fq;
#pragma unroll
    for (int ai = 0; ai < 2; ++ai)
#pragma unroll
      for (int m = 0; m < 4; ++m) {
        bf16_t* rowp = o + (size_t)(row0 + ai * 128 + m * 16) * ld + col0;
#pragma unroll
        for (int bj = 0; bj < 2; ++bj) *(u32x4*)(rowp + bj * 128) = pack8(acc[ai][bj][m][0], acc[ai][bj][m][1]);
      }
  }
};

struct GEpiResN {
  static constexpr bool PERM = false, AFTER_DRAIN = false;
  const float* base; float* h; bf16_t* hb; float* ss;
  __device__ __forceinline__ void operator()(const f32x4 (&acc)[2][2][4][2], const pg8::Unit& un, int wr, int wc, int fr, int fq) const {
    const int row0 = un.pm * 256 + wr * 64 + fr, col0 = un.pn * 256 + wc * 32 + 4 * fq;
#pragma unroll
    for (int ai = 0; ai < 2; ++ai)
#pragma unroll
      for (int m = 0; m < 4; ++m) {
        const int row = row0 + ai * 128 + m * 16;
        const size_t off = (size_t)row * 1024 + col0;
        float s = 0.f;
#pragma unroll
        for (int bj = 0; bj < 2; ++bj)
#pragma unroll
          for (int n = 0; n < 2; ++n) {
            const f32x4 v = *(const f32x4*)(base + off + bj * 128 + n * 16) + acc[ai][bj][m][n];
            *(f32x4*)(h + off + bj * 128 + n * 16) = v;
            s += (v[0] * v[0] + v[1] * v[1]) + (v[2] * v[2] + v[3] * v[3]);
            uint2 pk; pk.x = pg8::cvt_pk_bf16(v[0], v[1]); pk.y = pg8::cvt_pk_bf16(v[2], v[3]);
            *(uint2*)(hb + off + bj * 128 + n * 16) = pk;
          }
        s += __shfl_xor(s, 16); s += __shfl_xor(s, 32);
        if (fq == 0) (void)__hip_atomic_fetch_add(ss + row, s, __ATOMIC_RELAXED, __HIP_MEMORY_SCOPE_AGENT);
      }
  }
};

template <bool BASE_BF16>
struct GEpiResB {
  static constexpr bool PERM = true, AFTER_DRAIN = false;
  const void* base; bf16_t* hb; float* ss;
  __device__ __forceinline__ void operator()(const f32x4 (&acc)[2][2][4][2], const pg8::Unit& un, int wr, int wc, int fr, int fq) const {
    const int row0 = un.pm * 256 + wr * 64 + fr, col0 = un.pn * 256 + wc * 32 + 8 * fq;
#pragma unroll
    for (int ai = 0; ai < 2; ++ai)
#pragma unroll
      for (int m = 0; m < 4; ++m) {
        const int row = row0 + ai * 128 + m * 16;
        const size_t off = (size_t)row * 1024 + col0;
        float s = 0.f;
#pragma unroll
        for (int bj = 0; bj < 2; ++bj) {
          f32x4 b0, b1;
          if (BASE_BF16) { const u32x4 t = *(const u32x4*)((const bf16_t*)base + off + bj * 128); b0[0] = bflo(t[0]); b0[1] = bfhi(t[0]); b0[2] = bflo(t[1]); b0[3] = bfhi(t[1]); b1[0] = bflo(t[2]); b1[1] = bfhi(t[2]); b1[2] = bflo(t[3]); b1[3] = bfhi(t[3]); }
          else { b0 = *(const f32x4*)((const float*)base + off + bj * 128); b1 = *(const f32x4*)((const float*)base + off + bj * 128 + 4); }
          const f32x4 v0 = b0 + acc[ai][bj][m][0], v1 = b1 + acc[ai][bj][m][1];
          s += (v0[0] * v0[0] + v0[1] * v0[1]) + (v0[2] * v0[2] + v0[3] * v0[3]) + (v1[0] * v1[0] + v1[1] * v1[1]) + (v1[2] * v1[2] + v1[3] * v1[3]);
          *(u32x4*)(hb + off + bj * 128) = pack8(v0, v1);
        }
        s += __shfl_xor(s, 16); s += __shfl_xor(s, 32);
        if (fq == 0) (void)__hip_atomic_fetch_add(ss + row, s, __ATOMIC_RELAXED, __HIP_MEMORY_SCOPE_AGENT);
      }
  }
};
struct GEpiBf16S {
  static constexpr bool PERM = true, AFTER_DRAIN = false;
  bf16_t* o; int ld; const float* ss;
  __device__ __forceinline__ void operator()(const f32x4 (&acc)[2][2][4][2], const pg8::Unit& un, int wr, int wc, int fr, int fq) const {
    const int row0 = un.pm * 256 + wr * 64 + fr, col0 = un.pn * 256 + wc * 32 + 8 * fq;
#pragma unroll
    for (int ai = 0; ai < 2; ++ai)
#pragma unroll
      for (int m = 0; m < 4; ++m) {
        const int row = row0 + ai * 128 + m * 16;
        const float rs = rsqrtf(ss[row] * (1.0f / 1024.f) + 1e-6f);
        bf16_t* rowp = o + (size_t)row * ld + col0;
#pragma unroll
        for (int bj = 0; bj < 2; ++bj) *(u32x4*)(rowp + bj * 128) = pack8(acc[ai][bj][m][0] * rs, acc[ai][bj][m][1] * rs);
      }
  }
};
template <class Epi>
__device__ __forceinline__ void run_gemm(unsigned char* lds, const bf16_t* A, const bf16_t* Bt, int M, int N, int K, int c, const Epi& E) {
  pg8::Gemm g{A, Bt, M, N, K}; pg8::StaticOrder S; S.init(M, N, (int)gridDim.x, c);
  pg8::gemm_phase<Epi, pg8::StaticOrder, false>((PG8_LAS unsigned char*)lds, g, S, E, nullptr);
}

struct GEpiGluN {
  static constexpr bool PERM = true, AFTER_DRAIN = true;
  const bf16_t* y; const float* b; bf16_t* mix; const float* gs; float* ss3; unsigned* cnt;
  __device__ __forceinline__ void fused(f32x4 (&acc)[2][2][4][2], const pg8::Unit& un, int wr, int wc, int fr, int fq, PG8_LAS unsigned char* lds, int wid, int lane) const {
    const int row0 = un.pm * 256 + wr * 64 + fr, col0 = un.pn * 256 + wc * 32 + 8 * fq;
#pragma unroll
    for (int ai = 0; ai < 2; ++ai)
#pragma unroll
      for (int m = 0; m < 4; ++m) {
        const int row = row0 + ai * 128 + m * 16;
        float s = 0.f;
#pragma unroll
        for (int bj = 0; bj < 2; ++bj) {
          const int col = col0 + bj * 128;
          const f32x4 b0 = *(const f32x4*)(b + col), b1 = *(const f32x4*)(b + col + 4);
          const u32x4 yv = *(const u32x4*)(y + (size_t)row * 512 + col);
          const f32x4 g0 = acc[ai][bj][m][0] + b0, g1 = acc[ai][bj][m][1] + b1;
          f32x4 o0, o1;
          o0[0] = bflo(yv.x) * sigmoidf_(g0[0]); o0[1] = bfhi(yv.x) * sigmoidf_(g0[1]); o0[2] = bflo(yv.y) * sigmoidf_(g0[2]); o0[3] = bfhi(yv.y) * sigmoidf_(g0[3]);
          o1[0] = bflo(yv.z) * sigmoidf_(g1[0]); o1[1] = bfhi(yv.z) * sigmoidf_(g1[1]); o1[2] = bflo(yv.w) * sigmoidf_(g1[2]); o1[3] = bfhi(yv.w) * sigmoidf_(g1[3]);
          acc[ai][bj][m][0] = o0; acc[ai][bj][m][1] = o1;
          s += (o0[0] * o0[0] + o0[1] * o0[1]) + (o0[2] * o0[2] + o0[3] * o0[3]) + (o1[0] * o1[0] + o1[1] * o1[1]) + (o1[2] * o1[2] + o1[3] * o1[3]);
        }
        s += __shfl_xor(s, 16); s += __shfl_xor(s, 32);
        if (fq == 0) (void)__hip_atomic_fetch_add(ss3 + row, s, __ATOMIC_RELAXED, __HIP_MEMORY_SCOPE_AGENT);
      }
    asm volatile("s_waitcnt vmcnt(0)" ::: "memory");
    __syncthreads();
    if (threadIdx.x == 0) {
      unsigned* c = cnt + 64 * un.pm;
      (void)__hip_atomic_fetch_add(c, 1u, __ATOMIC_RELAXED, __HIP_MEMORY_SCOPE_AGENT);
      unsigned spins = 0;
      while (__hip_atomic_load(c, __ATOMIC_RELAXED, __HIP_MEMORY_SCOPE_AGENT) < 2u) { __builtin_amdgcn_s_sleep(1); if (++spins > (1u << 22)) break; }
    }
    __syncthreads();
#pragma unroll
    for (int ai = 0; ai < 2; ++ai)
#pragma unroll
      for (int m = 0; m < 4; ++m) {
        const int row = row0 + ai * 128 + m * 16;
        const float rs = rsqrtf(__hip_atomic_load(ss3 + row, __ATOMIC_RELAXED, __HIP_MEMORY_SCOPE_AGENT) * (1.0f / 512.f) + 1e-6f);
#pragma unroll
        for (int bj = 0; bj < 2; ++bj) {
          const int col = col0 + bj * 128;
          const f32x4 q0 = *(const f32x4*)(gs + col), q1 = *(const f32x4*)(gs + col + 4);
          *(u32x4*)(mix + (size_t)row * 1024 + 512 + col) = pack8(acc[ai][bj][m][0] * rs * q0, acc[ai][bj][m][1] * rs * q1);
        }
      }
  }
};
template <class Epi>
__device__ __forceinline__ void run_gemm_nc(unsigned char* lds, const bf16_t* A, const bf16_t* Bt, int M, int N, int K, int c, const Epi& E) {
  pg8::Gemm g{A, Bt, M, N, K}; pg8::StaticOrder S; S.init(M, N, (int)gridDim.x, c);
  pg8::gemm_phase<Epi, pg8::StaticOrder, false>((PG8_LAS unsigned char*)lds, g, S, E, nullptr);
}

__device__ void prep_transpose_tile(const float* __restrict__ W, int K, int N, bf16_t* __restrict__ Wt, int tk, int tn, bf16_t* tile, const float* __restrict__ gk) {
  const int t = threadIdx.x;
  {
    const int k = t >> 3, n8 = (t & 7) * 8;
    const float* src = W + (size_t)(tk * 64 + k) * N + tn * 64 + n8;
    float4 a = *(const float4*)src, b = *(const float4*)(src + 4);
    if (gk) { const float gg = gk[tk * 64 + k]; a.x *= gg; a.y *= gg; a.z *= gg; a.w *= gg; b.x *= gg; b.y *= gg; b.z *= gg; b.w *= gg; }
    bf16_t* d = tile + k * 66 + n8;
    d[0] = f2bf(a.x); d[1] = f2bf(a.y); d[2] = f2bf(a.z); d[3] = f2bf(a.w);
    d[4] = f2bf(b.x); d[5] = f2bf(b.y); d[6] = f2bf(b.z); d[7] = f2bf(b.w);
  }
  __syncthreads();
  {
    const int n = t >> 3, k8 = (t & 7) * 8;
    const bf16_t* s = tile + k8 * 66 + n;
    uint4 o;
    o.x = (unsigned)s[0] | ((unsigned)s[66] << 16); o.y = (unsigned)s[2 * 66] | ((unsigned)s[3 * 66] << 16);
    o.z = (unsigned)s[4 * 66] | ((unsigned)s[5 * 66] << 16); o.w = (unsigned)s[6 * 66] | ((unsigned)s[7 * 66] << 16);
    *(uint4*)(Wt + (size_t)(tn * 64 + n) * K + tk * 64 + k8) = o;
  }
  __syncthreads();
}
__device__ void prep_mat(const float* __restrict__ W, int K, int N, bf16_t* __restrict__ Wt, bf16_t* tile, int rot, const float* __restrict__ gk = nullptr) {
  const int ntn = N / 64, total = (K / 64) * ntn;
  for (int tix = (blockIdx.x + rot) % gridDim.x; tix < total; tix += gridDim.x) prep_transpose_tile(W, K, N, Wt, tix / ntn, tix % ntn, tile, gk);
}
__device__ void prep_cvt_bf16(const float* __restrict__ src, bf16_t* __restrict__ dst, size_t n) {
  for (size_t i = ((size_t)blockIdx.x * NTHR + threadIdx.x) * 8; i < n; i += (size_t)gridDim.x * NTHR * 8) {
    const float4 a = *(const float4*)(src + i), b = *(const float4*)(src + i + 4);
    uint4 o;
    o.x = (unsigned)f2bf(a.x) | ((unsigned)f2bf(a.y) << 16); o.y = (unsigned)f2bf(a.z) | ((unsigned)f2bf(a.w) << 16);
    o.z = (unsigned)f2bf(b.x) | ((unsigned)f2bf(b.y) << 16); o.w = (unsigned)f2bf(b.z) | ((unsigned)f2bf(b.w) << 16);
    *(uint4*)(dst + i) = o;
  }
}

struct TileSrc { const float* W; bf16_t* Wt; const float* gk; int K, N, r, swp; };
__device__ __forceinline__ TileSrc tile_decode(int tix) {
  TileSrc t; t.swp = 0;
  if (tix < 512)       { t.W = KP(I_w_in);  t.Wt = WSP(bf16_t, O_WIN);  t.gk = nullptr;        t.K = 1024; t.N = 2048; t.r = tix; t.swp = 1; }
  else if (tix < 576)  { t.W = KP(I_w_glu); t.Wt = WSP(bf16_t, O_WGLU); t.gk = nullptr;        t.K = 512;  t.N = 512;  t.r = tix - 512; }
  else if (tix < 832)  { t.W = KP(I_w_out); t.Wt = WSP(bf16_t, O_WOUT); t.gk = nullptr;        t.K = 1024; t.N = 1024; t.r = tix - 576; }
  else if (tix < 1088) { t.W = KP(I_w_xq);  t.Wt = WSP(bf16_t, O_WXQ);  t.gk = KP(I_g_xattn);  t.K = 1024; t.N = 1024; t.r = tix - 832; }
  else if (tix < 1600) { t.W = KP(I_w_xkv); t.Wt = WSP(bf16_t, O_WXKV); t.gk = nullptr;        t.K = 1024; t.N = 2048; t.r = tix - 1088; }
  else if (tix < 1856) { t.W = KP(I_w_xo);  t.Wt = WSP(bf16_t, O_WXO);  t.gk = nullptr;        t.K = 1024; t.N = 1024; t.r = tix - 1600; }
  else                 { t.W = KP(I_w_pq);  t.Wt = WSP(bf16_t, O_WPQ);  t.gk = KP(I_g_ffn);    t.K = 1024; t.N = 2048; t.r = tix - 1856; }
  return t;
}
#define PREP_NTILES 2368
template <int MODE>
__device__ __forceinline__ int prep_tile_map(int i) {
  if (MODE == 0) return i < 832 ? i : i + 256;
  return i < 256 ? 832 + i : (i < 512 ? 1600 + (i - 256) : 1856 + (i - 512));
}
template <int MODE>
__device__ void prep_weights(unsigned char* lds, int wg, int G) {
  constexpr int NT = MODE == 0 ? 1344 : 1024;
  const int t = threadIdx.x, k = t >> 3, n8 = (t & 7) * 8, n = t >> 3, k8 = (t & 7) * 8;
  int tix = wg;
  if (tix >= NT) return;
  float4 a0, b0, a1, b1; float g0, g1 = 1.0f;
  TileSrc c0 = tile_decode(prep_tile_map<MODE>(tix)), c1 = c0;
  {
    const int ntn = c0.N / 64, tk = c0.r / ntn, tn = c0.r % ntn;
    const float* src = c0.W + (size_t)(tk * 64 + k) * c0.N + tn * 64 + n8;
    a0 = *(const float4*)src; b0 = *(const float4*)(src + 4); g0 = c0.gk ? c0.gk[tk * 64 + k] : 1.0f;
  }
  bool have1 = tix + G < NT;
  a1 = a0; b1 = b0;
  if (have1) {
    c1 = tile_decode(prep_tile_map<MODE>(tix + G));
    const int ntn = c1.N / 64, tk = c1.r / ntn, tn = c1.r % ntn;
    const float* src = c1.W + (size_t)(tk * 64 + k) * c1.N + tn * 64 + n8;
    a1 = *(const float4*)src; b1 = *(const float4*)(src + 4); g1 = c1.gk ? c1.gk[tk * 64 + k] : 1.0f;
  }
  int buf = 0;
  for (;;) {
    bf16_t* tile = (bf16_t*)(lds + buf * 8704);
    {
      bf16_t* d = tile + k * 66 + n8;
      d[0] = f2bf(a0.x * g0); d[1] = f2bf(a0.y * g0); d[2] = f2bf(a0.z * g0); d[3] = f2bf(a0.w * g0);
      d[4] = f2bf(b0.x * g0); d[5] = f2bf(b0.y * g0); d[6] = f2bf(b0.z * g0); d[7] = f2bf(b0.w * g0);
    }
    const int ntn = c0.N / 64, tk = c0.r / ntn, tn = c0.r % ntn;
    const int tnd = (c0.swp && tn >= 16) ? (tn ^ 8) : tn;
    bf16_t* dst = c0.Wt + (size_t)(tnd * 64 + n) * c0.K + tk * 64 + k8;
    const bool more = have1;
    a0 = a1; b0 = b1; g0 = g1; c0 = c1;
    have1 = tix + 2 * G < NT;
    if (have1) {
      c1 = tile_decode(prep_tile_map<MODE>(tix + 2 * G));
      const int ntn2 = c1.N / 64, tk2 = c1.r / ntn2, tn2 = c1.r % ntn2;
      const float* src = c1.W + (size_t)(tk2 * 64 + k) * c1.N + tn2 * 64 + n8;
      a1 = *(const float4*)src; b1 = *(const float4*)(src + 4); g1 = c1.gk ? c1.gk[tk2 * 64 + k] : 1.0f;
    }
    __syncthreads();
    {
      const bf16_t* s = tile + k8 * 66 + n;
      uint4 o;
      o.x = (unsigned)s[0] | ((unsigned)s[66] << 16); o.y = (unsigned)s[2 * 66] | ((unsigned)s[3 * 66] << 16);
      o.z = (unsigned)s[4 * 66] | ((unsigned)s[5 * 66] << 16); o.w = (unsigned)s[6 * 66] | ((unsigned)s[7 * 66] << 16);
      *(uint4*)dst = o;
    }
    if (!more) break;
    tix += G; buf ^= 1;
  }
  __syncthreads();
}
__device__ void prep_rmsnorm(const float* __restrict__ x, const float* __restrict__ g, bf16_t* __restrict__ out, int rows) {
  const int lane = threadIdx.x & 63;
  float4 gv[4];
#pragma unroll
  for (int i = 0; i < 4; ++i) gv[i] = *(const float4*)(g + 256 * i + 4 * lane);
#pragma unroll 2
  for (int row = blockIdx.x * NWAVE + (threadIdx.x >> 6); row < rows; row += gridDim.x * NWAVE) {
    const float* xr = x + (size_t)row * 1024;
    f32x4 v[4]; float ss = 0.f;
#pragma unroll
    for (int i = 0; i < 4; ++i) { v[i] = __builtin_nontemporal_load((const f32x4*)(xr + 256 * i + 4 * lane)); ss += v[i][0] * v[i][0] + v[i][1] * v[i][1] + v[i][2] * v[i][2] + v[i][3] * v[i][3]; }
    ss = wave_sum(ss);
    const float r = rsqrtf(ss / 1024.f + 1e-6f);
#pragma unroll
    for (int i = 0; i < 4; ++i) {
      uint2 o; o.x = pg8::cvt_pk_bf16(v[i][0] * r * gv[i].x, v[i][1] * r * gv[i].y); o.y = pg8::cvt_pk_bf16(v[i][2] * r * gv[i].z, v[i][3] * r * gv[i].w);
      *(uint2*)(out + (size_t)row * 1024 + 256 * i + 4 * lane) = o;
    }
  }
}

typedef short bf16x8 __attribute__((ext_vector_type(8)));
typedef float f32x16 __attribute__((ext_vector_type(16)));
#define SSM_L 128
#define SSM_ROWB 528
#define SSM_WBUF (32 * SSM_ROWB)
struct SsmC { float2* lam; float2* lamL; bf16_t* Bbar; bf16_t* CmT; float2* E; };

struct SsmIn { const float *a_re, *a_im, *log_dt, *b_re, *b_im, *c_re, *c_im; };
__device__ void prep_ssm(const SsmIn P, const SsmC C) {
  for (int w = threadIdx.x * gridDim.x + blockIdx.x; w < 32768; w += NTHR * gridDim.x) {
    const int idx = w >> 4, c = w & 15, g = idx >> 6, p = idx & 63;
    const double are = P.a_re[idx], aim = P.a_im[idx], dt = exp((double)P.log_dt[g]);
    double er = exp(are * dt), sn, cs; sincos(aim * dt, &sn, &cs);
    const double lbr = er * cs, lbi = er * sn;
    if (c == 0) {
      C.lam[idx] = make_float2((float)lbr, (float)lbi);
      er = exp(are * dt * SSM_L); sincos(aim * dt * SSM_L, &sn, &cs);
      C.lamL[idx] = make_float2((float)(er * cs), (float)(er * sn));
    }
    const double nr = lbr - 1.0, ni = lbi, den = are * are + aim * aim;
    const double cr = (nr * are + ni * aim) / den, ci = (ni * are - nr * aim) / den;
    const double br = P.b_re[idx * 16 + c], bi = P.b_im[idx * 16 + c];
    C.Bbar[(g * 128 + 2 * p) * 16 + c] = f2bf((float)(cr * br - ci * bi));
    C.Bbar[(g * 128 + 2 * p + 1) * 16 + c] = f2bf((float)(cr * bi + ci * br));
    C.CmT[(g * 16 + c) * 128 + 2 * p] = f2bf(P.c_re[(g * 16 + c) * 64 + p]);
    C.CmT[(g * 16 + c) * 128 + 2 * p + 1] = f2bf(-P.c_im[(g * 16 + c) * 64 + p]);
  }
}

template <bool PASS2>
__device__ void ph_ssm(const float* __restrict__ d_skip, const bf16_t* __restrict__ U16, const SsmC C, bf16_t* __restrict__ Y, unsigned char* lds) {
  const int wv = threadIdx.x >> 6, lane = threadIdx.x & 63;
  unsigned char* buf = lds + wv * SSM_WBUF;
  const int nw = gridDim.x * NWAVE;
  for (int u = blockIdx.x * NWAVE + wv; u < 4096; u += nw) {
    const int g = u & 31, bj = u >> 5, j = bj & 63, b = bj >> 6;
    const float2 lm = C.lam[g * 64 + lane];
    bf16x8 Bf[4];
#pragma unroll
    for (int nt = 0; nt < 4; ++nt) Bf[nt] = *(const bf16x8*)(C.Bbar + (g * 128 + 32 * nt + (lane & 31)) * 16 + 8 * (lane >> 5));
    float xr = 0.f, xi = 0.f;
    bf16x8 Cf[4]; f32x4 dsk;
    if (PASS2) {
      const float2 lL = C.lamL[g * 64 + lane];
      const float2* Eb = C.E + ((size_t)(b * 32 + g) * 64) * 64 + lane;
      for (int i0 = 0; i0 < j; i0 += 16) {
        float2 e[16];
#pragma unroll
        for (int q = 0; q < 16; ++q) { const int i = (i0 + q < j) ? i0 + q : j - 1; e[q] = Eb[i * 64]; }
#pragma unroll
        for (int q = 0; q < 16; ++q) {
          if (i0 + q < j) { const float nxr = lL.x * xr - lL.y * xi + e[q].x, nxi = lL.x * xi + lL.y * xr + e[q].y; xr = nxr; xi = nxi; }
        }
      }
#pragma unroll
      for (int s = 0; s < 4; ++s) Cf[s] = *(const bf16x8*)(C.CmT + (g * 16 + (lane & 15)) * 128 + 32 * s + 8 * (lane >> 4));
      dsk = *(const f32x4*)(d_skip + g * 16 + 4 * (lane >> 4));
    }
    for (int sub = 0; sub < 4; ++sub) {
      const int tok0 = b * SEQ + j * SSM_L + sub * 32;
      const bf16x8 af = *(const bf16x8*)(U16 + (size_t)(tok0 + (lane & 31)) * 512 + g * 16 + 8 * (lane >> 5));
      wave_lds_sync();
#pragma unroll
      for (int nt = 0; nt < 4; ++nt) {
        f32x16 acc;
#pragma unroll
        for (int i = 0; i < 16; ++i) acc[i] = 0.f;
        acc = __builtin_amdgcn_mfma_f32_32x32x16_bf16(af, Bf[nt], acc, 0, 0, 0);
#pragma unroll
        for (int i = 0; i < 16; ++i) {
          const int r = (i & 3) + 8 * (i >> 2) + 4 * (lane >> 5);
          *(float*)(buf + r * SSM_ROWB + (32 * nt + (lane & 31)) * 4) = acc[i];
        }
      }
      wave_lds_sync();
#pragma unroll 1
      for (int t0 = 0; t0 < 32; t0 += 8) {
        float2 bu[8];
#pragma unroll
        for (int q = 0; q < 8; ++q) bu[q] = *(const float2*)(buf + (t0 + q) * SSM_ROWB + lane * 8);
        unsigned xo[8];
#pragma unroll
        for (int q = 0; q < 8; ++q) {
          const float nxr = lm.x * xr - lm.y * xi + bu[q].x, nxi = lm.x * xi + lm.y * xr + bu[q].y;
          xr = nxr; xi = nxi;
          xo[q] = pg8::cvt_pk_bf16(xr, xi);
        }
        if (PASS2) {
          asm volatile("" ::: "memory");
#pragma unroll
          for (int q = 0; q < 8; ++q) *(unsigned*)(buf + (t0 + q) * SSM_ROWB + lane * 4) = xo[q];
        }
      }
      if (PASS2) {
        wave_lds_sync();
#pragma unroll
        for (int mt = 0; mt < 2; ++mt) {
          f32x4 ya = {0.f, 0.f, 0.f, 0.f};
#pragma unroll
          for (int s = 0; s < 4; ++s) {
            const bf16x8 xf = *(const bf16x8*)(buf + (16 * mt + (lane & 15)) * SSM_ROWB + (32 * s + 8 * (lane >> 4)) * 2);
            ya = __builtin_amdgcn_mfma_f32_16x16x32_bf16(Cf[s], xf, ya, 0, 0, 0);
          }
          const size_t off = (size_t)(tok0 + 16 * mt + (lane & 15)) * 512 + g * 16 + 4 * (lane >> 4);
          const uint2 uv = *(const uint2*)(U16 + off);
          const float y0 = gelu_tanh(ya[0] + dsk[0] * bflo(uv.x)), y1 = gelu_tanh(ya[1] + dsk[1] * bfhi(uv.x));
          const float y2 = gelu_tanh(ya[2] + dsk[2] * bflo(uv.y)), y3 = gelu_tanh(ya[3] + dsk[3] * bfhi(uv.y));
#if defined(DBG_FLUSH) && DBG_FLUSH == 1
          const float y0f = fabsf(y0) < 1e-30f ? 0.f : y0, y1f = fabsf(y1) < 1e-30f ? 0.f : y1, y2f = fabsf(y2) < 1e-30f ? 0.f : y2, y3f = fabsf(y3) < 1e-30f ? 0.f : y3;
          uint2 o; o.x = (unsigned)f2bf(y0f) | ((unsigned)f2bf(y1f) << 16); o.y = (unsigned)f2bf(y2f) | ((unsigned)f2bf(y3f) << 16);
#else
          uint2 o; o.x = (unsigned)f2bf(y0) | ((unsigned)f2bf(y1) << 16); o.y = (unsigned)f2bf(y2) | ((unsigned)f2bf(y3) << 16);
#endif
          *(uint2*)(Y + off) = o;
        }
      }
    }
    if (!PASS2) C.E[((size_t)(b * 32 + g) * 64 + j) * 64 + lane] = make_float2(xr, xi);
  }
}

typedef __bf16 bf16x2_t __attribute__((ext_vector_type(2)));
__device__ __forceinline__ float dot2bf(unsigned a, unsigned b, float c) {
  return __builtin_amdgcn_fdot2_f32_bf16(__builtin_bit_cast(bf16x2_t, a), __builtin_bit_cast(bf16x2_t, b), c, false);
}
__device__ void ph_gather(const bf16_t* __restrict__ HN, const int* __restrict__ EXP, const float* __restrict__ GATE,
                          const bf16_t* __restrict__ PU, const bf16_t* __restrict__ PV, const float* __restrict__ gfin,
                          float* __restrict__ H) {
  const int lane = threadIdx.x & 63;
  const int nw = gridDim.x * NWAVE;
  const int kk = lane >> 3;
  for (int tok = __builtin_amdgcn_readfirstlane(blockIdx.x * NWAVE + (threadIdx.x >> 6)); tok < NTOK; tok += nw) {
    const uint4 h0 = *(const uint4*)(HN + (size_t)tok * 1024 + 8 * lane), h1 = *(const uint4*)(HN + (size_t)tok * 1024 + 512 + 8 * lane);
    float acc[16];
#pragma unroll
    for (int i = 0; i < 16; ++i) acc[i] = 0.f;
    const int* ep = EXP + (size_t)tok * 128;
    const float* gp = GATE + (size_t)tok * 128;
    for (int bt = 0; bt < 16; ++bt) {
      int e[8];
#pragma unroll
      for (int k = 0; k < 8; ++k) e[k] = __builtin_amdgcn_readfirstlane(ep[bt * 8 + k]);
      const float gk = gp[bt * 8 + kk];
      uint4 u0[8], u1[8];
#pragma unroll
      for (int k = 0; k < 8; ++k) {
        const bf16_t* r = PU + (size_t)e[k] * 1024 + 8 * lane;
        u0[k] = *(const uint4*)r; u1[k] = *(const uint4*)(r + 512);
      }
      uint4 v0[8], v1[8];
#pragma unroll
      for (int k = 0; k < 8; ++k) {
        const bf16_t* r = PV + (size_t)e[k] * 1024 + 8 * lane;
        v0[k] = *(const uint4*)r; v1[k] = *(const uint4*)(r + 512);
      }
      float d[8];
#pragma unroll
      for (int k = 0; k < 8; ++k) {
        float s = dot2bf(h0.x, u0[k].x, 0.f); s = dot2bf(h0.y, u0[k].y, s); s = dot2bf(h0.z, u0[k].z, s); s = dot2bf(h0.w, u0[k].w, s);
        s = dot2bf(h1.x, u1[k].x, s); s = dot2bf(h1.y, u1[k].y, s); s = dot2bf(h1.z, u1[k].z, s); s = dot2bf(h1.w, u1[k].w, s);
        d[k] = s;
      }
      const bool b5 = lane & 32, b4 = lane & 16, b3 = lane & 8;
      float r4[4];
#pragma unroll
      for (int k = 0; k < 4; ++k) { const float keep = b5 ? d[k + 4] : d[k], send = b5 ? d[k] : d[k + 4]; r4[k] = keep + __shfl_xor(send, 32); }
      float r2[2];
#pragma unroll
      for (int k = 0; k < 2; ++k) { const float keep = b4 ? r4[k + 2] : r4[k], send = b4 ? r4[k] : r4[k + 2]; r2[k] = keep + __shfl_xor(send, 16); }
      float r1;
      { const float keep = b3 ? r2[1] : r2[0], send = b3 ? r2[0] : r2[1]; r1 = keep + __shfl_xor(send, 8); }
      r1 += __shfl_xor(r1, 4); r1 += __shfl_xor(r1, 2); r1 += __shfl_xor(r1, 1);
      const float wl = gk * gelu_tanh(r1);
#pragma unroll
      for (int k = 0; k < 8; ++k) {
        const float w = __shfl(wl, 8 * k);
        acc[0] += w * bflo(v0[k].x); acc[1] += w * bfhi(v0[k].x); acc[2] += w * bflo(v0[k].y); acc[3] += w * bfhi(v0[k].y);
        acc[4] += w * bflo(v0[k].z); acc[5] += w * bfhi(v0[k].z); acc[6] += w * bflo(v0[k].w); acc[7] += w * bfhi(v0[k].w);
        acc[8] += w * bflo(v1[k].x); acc[9] += w * bfhi(v1[k].x); acc[10] += w * bflo(v1[k].y); acc[11] += w * bfhi(v1[k].y);
        acc[12] += w * bflo(v1[k].z); acc[13] += w * bfhi(v1[k].z); acc[14] += w * bflo(v1[k].w); acc[15] += w * bfhi(v1[k].w);
      }
    }
    float* hp = H + (size_t)tok * 1024 + 8 * lane;
    float4 a0 = *(const float4*)hp, a1 = *(const float4*)(hp + 4), a2 = *(const float4*)(hp + 512), a3 = *(const float4*)(hp + 516);
    a0.x += acc[0]; a0.y += acc[1]; a0.z += acc[2]; a0.w += acc[3]; a1.x += acc[4]; a1.y += acc[5]; a1.z += acc[6]; a1.w += acc[7];
    a2.x += acc[8]; a2.y += acc[9]; a2.z += acc[10]; a2.w += acc[11]; a3.x += acc[12]; a3.y += acc[13]; a3.z += acc[14]; a3.w += acc[15];
    float ss = a0.x * a0.x + a0.y * a0.y + a0.z * a0.z + a0.w * a0.w + a1.x * a1.x + a1.y * a1.y + a1.z * a1.z + a1.w * a1.w +
               a2.x * a2.x + a2.y * a2.y + a2.z * a2.z + a2.w * a2.w + a3.x * a3.x + a3.y * a3.y + a3.z * a3.z + a3.w * a3.w;
    ss = wave_sum(ss);
    const float r = rsqrtf(ss / 1024.f + 1e-6f);
    const float4 g0 = *(const float4*)(gfin + 8 * lane), g1 = *(const float4*)(gfin + 8 * lane + 4), g2 = *(const float4*)(gfin + 512 + 8 * lane), g3 = *(const float4*)(gfin + 516 + 8 * lane);
    a0.x *= r * g0.x; a0.y *= r * g0.y; a0.z *= r * g0.z; a0.w *= r * g0.w; a1.x *= r * g1.x; a1.y *= r * g1.y; a1.z *= r * g1.z; a1.w *= r * g1.w;
    a2.x *= r * g2.x; a2.y *= r * g2.y; a2.z *= r * g2.z; a2.w *= r * g2.w; a3.x *= r * g3.x; a3.y *= r * g3.y; a3.z *= r * g3.z; a3.w *= r * g3.w;
    *(float4*)hp = a0; *(float4*)(hp + 4) = a1; *(float4*)(hp + 512) = a2; *(float4*)(hp + 516) = a3;
  }
}

#define PU_SCALE 64.0f
#define PV_SCALE 8.0f
__device__ void prep_cvt_fp8(const float* __restrict__ src, unsigned char* __restrict__ dst, size_t n, float scale) {
  const int lane = threadIdx.x & 63;
  const size_t wv = (size_t)blockIdx.x * NWAVE + (threadIdx.x >> 6), nwv = (size_t)gridDim.x * NWAVE;
#pragma unroll 4
  for (size_t i = wv * 1024; i < n; i += nwv * 1024) {
    f32x4 a[4];
#pragma unroll
    for (int d = 0; d < 4; ++d) a[d] = __builtin_nontemporal_load((const f32x4*)(src + i + 256 * d + 4 * lane));
#pragma unroll
    for (int d = 0; d < 4; ++d) {
      int w = 0;
      w = __builtin_amdgcn_cvt_pk_fp8_f32(a[d][0] * scale, a[d][1] * scale, w, false);
      w = __builtin_amdgcn_cvt_pk_fp8_f32(a[d][2] * scale, a[d][3] * scale, w, true);
      *(unsigned*)(dst + i + 256 * d + 4 * lane) = (unsigned)w;
    }
  }
}
typedef float f32x2_t __attribute__((ext_vector_type(2)));
__device__ __forceinline__ float dot16_fp8(const uint4& u, const float (&h)[16], float s) {
  const unsigned w[4] = {u.x, u.y, u.z, u.w};
#pragma unroll
  for (int d = 0; d < 4; ++d) {
    const f32x2_t lo = __builtin_amdgcn_cvt_pk_f32_fp8((int)w[d], false), hi = __builtin_amdgcn_cvt_pk_f32_fp8((int)w[d], true);
    s += h[4 * d] * lo.x; s += h[4 * d + 1] * lo.y; s += h[4 * d + 2] * hi.x; s += h[4 * d + 3] * hi.y;
  }
  return s;
}
__device__ __forceinline__ void axpy16_fp8(const uint4& v, float w_, float (&acc)[16]) {
  const unsigned w[4] = {v.x, v.y, v.z, v.w};
#pragma unroll
  for (int d = 0; d < 4; ++d) {
    const f32x2_t lo = __builtin_amdgcn_cvt_pk_f32_fp8((int)w[d], false), hi = __builtin_amdgcn_cvt_pk_f32_fp8((int)w[d], true);
    acc[4 * d] += w_ * lo.x; acc[4 * d + 1] += w_ * lo.y; acc[4 * d + 2] += w_ * hi.x; acc[4 * d + 3] += w_ * hi.y;
  }
}

__device__ __forceinline__ float dot16_fp8_pk(const uint4& u, const f32x2_t (&h2)[8]) {
  const unsigned w[4] = {u.x, u.y, u.z, u.w};
  f32x2_t s = {0.f, 0.f};
#pragma unroll
  for (int d = 0; d < 4; ++d) {
    const f32x2_t lo = __builtin_amdgcn_cvt_pk_f32_fp8((int)w[d], false), hi = __builtin_amdgcn_cvt_pk_f32_fp8((int)w[d], true);
    s = __builtin_elementwise_fma(h2[2 * d], lo, s); s = __builtin_elementwise_fma(h2[2 * d + 1], hi, s);
  }
  return s.x + s.y;
}
__device__ __forceinline__ void axpy16_fp8_pk(const uint4& v, float w_, f32x2_t (&acc2)[8]) {
  const unsigned w[4] = {v.x, v.y, v.z, v.w};
  const f32x2_t ww = {w_, w_};
#pragma unroll
  for (int d = 0; d < 4; ++d) {
    const f32x2_t lo = __builtin_amdgcn_cvt_pk_f32_fp8((int)w[d], false), hi = __builtin_amdgcn_cvt_pk_f32_fp8((int)w[d], true);
    acc2[2 * d] = __builtin_elementwise_fma(lo, ww, acc2[2 * d]); acc2[2 * d + 1] = __builtin_elementwise_fma(hi, ww, acc2[2 * d + 1]);
  }
}
__device__ void ph_gather8(const bf16_t* __restrict__ HN, const int* __restrict__ EXP, const float* __restrict__ GATE,
                           const unsigned char* __restrict__ PU8, const unsigned char* __restrict__ PV8,
                           const float* __restrict__ gfin, const float* H, float* Hout) {
  const int lane = threadIdx.x & 63;
  const int nw = gridDim.x * NWAVE;
  const int kk = lane >> 3;
  for (int tok = __builtin_amdgcn_readfirstlane(blockIdx.x * NWAVE + (threadIdx.x >> 6)); tok < NTOK; tok += nw) {
    float hn[16], acc[16];
    {
      const uint4 h0 = *(const uint4*)(HN + (size_t)tok * 1024 + 16 * lane), h1 = *(const uint4*)(HN + (size_t)tok * 1024 + 16 * lane + 8);
      hn[0] = bflo(h0.x); hn[1] = bfhi(h0.x); hn[2] = bflo(h0.y); hn[3] = bfhi(h0.y); hn[4] = bflo(h0.z); hn[5] = bfhi(h0.z); hn[6] = bflo(h0.w); hn[7] = bfhi(h0.w);
      hn[8] = bflo(h1.x); hn[9] = bfhi(h1.x); hn[10] = bflo(h1.y); hn[11] = bfhi(h1.y); hn[12] = bflo(h1.z); hn[13] = bfhi(h1.z); hn[14] = bflo(h1.w); hn[15] = bfhi(h1.w);
    }
#pragma unroll
    for (int i = 0; i < 16; ++i) acc[i] = 0.f;
    const int* ep = EXP + (size_t)tok * 128;
    const float* gp = GATE + (size_t)tok * 128;
    uint4 uc[8], vc[8];
#pragma unroll
    for (int k = 0; k < 8; ++k) {
      const int e = __builtin_amdgcn_readfirstlane(ep[k]);
      uc[k] = *(const uint4*)(PU8 + (size_t)e * 1024 + 16 * lane); vc[k] = *(const uint4*)(PV8 + (size_t)e * 1024 + 16 * lane);
    }
#pragma unroll 1
    for (int bt = 0; bt < 16; ++bt) {
      uint4 un[8], vn[8];
      const int nb = (bt < 15) ? bt + 1 : bt;
#pragma unroll
      for (int k = 0; k < 8; ++k) {
        const int e = __builtin_amdgcn_readfirstlane(ep[nb * 8 + k]);
        un[k] = *(const uint4*)(PU8 + (size_t)e * 1024 + 16 * lane); vn[k] = *(const uint4*)(PV8 + (size_t)e * 1024 + 16 * lane);
      }
      const float gk = gp[bt * 8 + kk];
      float d[8];
#pragma unroll
      for (int k = 0; k < 8; ++k) d[k] = dot16_fp8(uc[k], hn, 0.f);
      const bool b5 = lane & 32, b4 = lane & 16, b3 = lane & 8;
      float r4[4];
#pragma unroll
      for (int k = 0; k < 4; ++k) { const float keep = b5 ? d[k + 4] : d[k], send = b5 ? d[k] : d[k + 4]; r4[k] = keep + __shfl_xor(send, 32); }
      float r2[2];
#pragma unroll
      for (int k = 0; k < 2; ++k) { const float keep = b4 ? r4[k + 2] : r4[k], send = b4 ? r4[k] : r4[k + 2]; r2[k] = keep + __shfl_xor(send, 16); }
      float r1;
      { const float keep = b3 ? r2[1] : r2[0], send = b3 ? r2[0] : r2[1]; r1 = keep + __shfl_xor(send, 8); }
      r1 += __shfl_xor(r1, 4); r1 += __shfl_xor(r1, 2); r1 += __shfl_xor(r1, 1);
      const float wl = gk * gelu_tanh(r1 * (1.0f / PU_SCALE));
#pragma unroll
      for (int k = 0; k < 8; ++k) axpy16_fp8(vc[k], __shfl(wl, 8 * k), acc);
#pragma unroll
      for (int k = 0; k < 8; ++k) { uc[k] = un[k]; vc[k] = vn[k]; }
    }
    const float* hp = H + (size_t)tok * 1024 + 16 * lane; float* hq = Hout + (size_t)tok * 1024 + 16 * lane;
    float4 a[4]; float ss = 0.f;
#pragma unroll
    for (int q = 0; q < 4; ++q) {
      a[q] = *(const float4*)(hp + 4 * q);
      a[q].x += acc[4 * q] * (1.0f / PV_SCALE); a[q].y += acc[4 * q + 1] * (1.0f / PV_SCALE); a[q].z += acc[4 * q + 2] * (1.0f / PV_SCALE); a[q].w += acc[4 * q + 3] * (1.0f / PV_SCALE);
      ss += a[q].x * a[q].x + a[q].y * a[q].y + a[q].z * a[q].z + a[q].w * a[q].w;
    }
    ss = wave_sum(ss);
    const float r = rsqrtf(ss / 1024.f + 1e-6f);
#pragma unroll
    for (int q = 0; q < 4; ++q) {
      const float4 g = *(const float4*)(gfin + 16 * lane + 4 * q);
      a[q].x *= r * g.x; a[q].y *= r * g.y; a[q].z *= r * g.z; a[q].w *= r * g.w;
      *(float4*)(hq + 4 * q) = a[q];
    }
  }
}

#ifndef RES_BF16
#define RES_BF16 1
#endif
__device__ __forceinline__ unsigned bsort_step(unsigned v, unsigned pv, bool keep_min) { return keep_min ? min(v, pv) : max(v, pv); }
__device__ __forceinline__ void wave_sort128(unsigned& k0, unsigned& k1, int lane) {
#pragma unroll
  for (int k = 2; k <= 128; k <<= 1) {
#pragma unroll
    for (int j = k >> 1; j > 0; j >>= 1) {
      if (j == 64) {
        const unsigned lo = min(k0, k1), hi = max(k0, k1); k0 = lo; k1 = hi;
      } else {
        const unsigned p0 = __shfl_xor(k0, j), p1 = __shfl_xor(k1, j);
        const bool lower = (lane & j) == 0;
        const bool asc0 = ((lane & k) == 0) || (k == 128), asc1 = (((64 + lane) & k) == 0) || (k == 128);
        k0 = bsort_step(k0, p0, lower == asc0); k1 = bsort_step(k1, p1, lower == asc1);
      }
    }
  }
}

template <int N, int BIT>
__device__ __forceinline__ float treduce_lvl(const float (&c)[N], int lane) {
  if constexpr (N == 1) {
    float r = c[0];
#pragma unroll
    for (int b = BIT; b >= 1; b >>= 1) r += __shfl_xor(r, b);
    return r;
  } else {
    const bool hi = (lane & BIT) != 0;
    float nx[N / 2];
#pragma unroll
    for (int k = 0; k < N / 2; ++k) { const float keep = hi ? c[k + N / 2] : c[k], send = hi ? c[k] : c[k + N / 2]; nx[k] = keep + __shfl_xor(send, BIT); }
    return treduce_lvl<N / 2, BIT / 2>(nx, lane);
  }
}
template <int NB>
__device__ __forceinline__ float treduce(const float (&d)[NB], int lane) { return treduce_lvl<NB, 32>(d, lane); }

template <int NS, int NB>
__device__ void ph_gather9(const bf16_t* __restrict__ HN, const int* __restrict__ EXP, const float* __restrict__ GATE,
                           const unsigned char* __restrict__ PU8, const unsigned char* __restrict__ PV8,
                           const float* __restrict__ gfin, const float* H, float* Hout, unsigned char* lds,
                           const float* __restrict__ ss2, const float* __restrict__ gffn) {
  int tid_ = threadIdx.x; asm volatile("" : "+v"(tid_));
  const int wv = tid_ >> 6, lane = tid_ & 63;
  unsigned* se = (unsigned*)(lds + wv * (NS * 1024));
  float* sw = (float*)(lds + wv * (NS * 1024) + NS * 512);
  constexpr int STEP = NB / NS;
  constexpr int LPG = 64 / NB;
  for (int base = (blockIdx.x * NWAVE + wv) * NS; base < NTOK; base += gridDim.x * NWAVE * NS) {
#pragma unroll 1
    for (int s = 0; s < NS; ++s) {
      const int tok = base + s;
      unsigned k0 = ((unsigned)EXP[(size_t)tok * 128 + lane] << 7) | (unsigned)lane;
      unsigned k1 = ((unsigned)EXP[(size_t)tok * 128 + 64 + lane] << 7) | (unsigned)(64 + lane);
      wave_sort128(k0, k1, lane);
      se[s * 128 + lane] = k0 >> 7; se[s * 128 + 64 + lane] = k1 >> 7;
      sw[s * 128 + lane] = GATE[(size_t)tok * 128 + (k0 & 127u)]; sw[s * 128 + 64 + lane] = GATE[(size_t)tok * 128 + (k1 & 127u)];
    }
    wave_lds_sync();
    {
      f32x2_t hn[NS][8];
      f32x2_t gf[8];
#pragma unroll
      for (int q = 0; q < 8; ++q) gf[q] = *(const f32x2_t*)(gffn + 16 * lane + 2 * q);
#pragma unroll
      for (int s = 0; s < NS; ++s) {
        const uint4 h0 = *(const uint4*)(HN + (size_t)(base + s) * 1024 + 16 * lane), h1 = *(const uint4*)(HN + (size_t)(base + s) * 1024 + 16 * lane + 8);
        hn[s][0] = (f32x2_t){bflo(h0.x), bfhi(h0.x)}; hn[s][1] = (f32x2_t){bflo(h0.y), bfhi(h0.y)}; hn[s][2] = (f32x2_t){bflo(h0.z), bfhi(h0.z)}; hn[s][3] = (f32x2_t){bflo(h0.w), bfhi(h0.w)};
        hn[s][4] = (f32x2_t){bflo(h1.x), bfhi(h1.x)}; hn[s][5] = (f32x2_t){bflo(h1.y), bfhi(h1.y)}; hn[s][6] = (f32x2_t){bflo(h1.z), bfhi(h1.z)}; hn[s][7] = (f32x2_t){bflo(h1.w), bfhi(h1.w)};
        const float rs2 = rsqrtf(ss2[base + s] * (1.0f / 1024.f) + 1e-6f);
#pragma unroll
        for (int q = 0; q < 8; ++q) hn[s][q] = hn[s][q] * gf[q] * rs2;
      }
      uint4 uc[NB];
#pragma unroll
      for (int k = 0; k < NB; ++k) { const unsigned e = __builtin_amdgcn_readfirstlane(se[(k % NS) * 128 + (k / NS)]); uc[k] = *(const uint4*)(PU8 + (size_t)e * 1024 + 16 * lane); }
#pragma unroll 1
      for (int i = 0; i < 128; i += STEP) {
        uint4 un[NB];
        const int ni = (i + STEP < 128) ? i + STEP : i;
#pragma unroll
        for (int k = 0; k < NB; ++k) { const unsigned e = __builtin_amdgcn_readfirstlane(se[(k % NS) * 128 + ni + (k / NS)]); un[k] = *(const uint4*)(PU8 + (size_t)e * 1024 + 16 * lane); }
        float d[NB];
#pragma unroll
        for (int k = 0; k < NB; ++k) {
          d[k] = dot16_fp8_pk(uc[k], hn[k % NS]);
#ifdef PROBE_UVALU2
          { uint4 t = uc[k]; asm volatile("" : "+v"(t.x), "+v"(t.y), "+v"(t.z), "+v"(t.w)); d[k] = (d[k] + dot16_fp8_pk(t, hn[k % NS])) * 0.5f; }
#endif
        }
        const float r1 = treduce<NB>(d, lane);
        const int kk = lane / LPG;
        const int pos = (kk % NS) * 128 + i + (kk / NS);
        const float wgt = sw[pos] * gelu_tanh(r1 * (1.0f / PU_SCALE));
        if ((lane % LPG) == 0) sw[pos] = wgt;
#pragma unroll
        for (int k = 0; k < NB; ++k) uc[k] = un[k];
      }
    }
    wave_lds_sync();
    f32x2_t acc[NS][8];
#pragma unroll
    for (int s = 0; s < NS; ++s)
#pragma unroll
      for (int q = 0; q < 8; ++q) acc[s][q] = (f32x2_t){0.f, 0.f};
    {
      uint4 vc[NB];
#pragma unroll
      for (int k = 0; k < NB; ++k) { const unsigned e = __builtin_amdgcn_readfirstlane(se[(k % NS) * 128 + (k / NS)]); vc[k] = *(const uint4*)(PV8 + (size_t)e * 1024 + 16 * lane); }
#pragma unroll 1
      for (int i = 0; i < 128; i += STEP) {
        uint4 vn[NB];
        const int ni = (i + STEP < 128) ? i + STEP : i;
#pragma unroll
        for (int k = 0; k < NB; ++k) { const unsigned e = __builtin_amdgcn_readfirstlane(se[(k % NS) * 128 + ni + (k / NS)]); vn[k] = *(const uint4*)(PV8 + (size_t)e * 1024 + 16 * lane); }
#pragma unroll
        for (int k = 0; k < NB; ++k) axpy16_fp8_pk(vc[k], sw[(k % NS) * 128 + i + (k / NS)], acc[k % NS]);
#pragma unroll
        for (int k = 0; k < NB; ++k) vc[k] = vn[k];
      }
    }
#pragma unroll
    for (int s = 0; s < NS; ++s) {
      float* hq = Hout + (size_t)(base + s) * 1024 + 16 * lane;
      float4 a[4]; float ss = 0.f;
#if RES_BF16
      const uint4 r0 = *(const uint4*)(HN + (size_t)(base + s) * 1024 + 16 * lane), r1 = *(const uint4*)(HN + (size_t)(base + s) * 1024 + 16 * lane + 8);
      a[0] = make_float4(bflo(r0.x), bfhi(r0.x), bflo(r0.y), bfhi(r0.y)); a[1] = make_float4(bflo(r0.z), bfhi(r0.z), bflo(r0.w), bfhi(r0.w));
      a[2] = make_float4(bflo(r1.x), bfhi(r1.x), bflo(r1.y), bfhi(r1.y)); a[3] = make_float4(bflo(r1.z), bfhi(r1.z), bflo(r1.w), bfhi(r1.w));
#else
      const float* hp = H + (size_t)(base + s) * 1024 + 16 * lane;
#endif
#pragma unroll
      for (int q = 0; q < 4; ++q) {
#if !RES_BF16
        a[q] = *(const float4*)(hp + 4 * q);
#endif
        a[q].x += acc[s][2 * q].x * (1.0f / PV_SCALE); a[q].y += acc[s][2 * q].y * (1.0f / PV_SCALE); a[q].z += acc[s][2 * q + 1].x * (1.0f / PV_SCALE); a[q].w += acc[s][2 * q + 1].y * (1.0f / PV_SCALE);
        ss += a[q].x * a[q].x + a[q].y * a[q].y + a[q].z * a[q].z + a[q].w * a[q].w;
      }
      ss = wave_sum(ss);
      const float r = rsqrtf(ss / 1024.f + 1e-6f);
#pragma unroll
      for (int q = 0; q < 4; ++q) {
        const float4 g = *(const float4*)(gfin + 16 * lane + 4 * q);
        a[q].x *= r * g.x; a[q].y *= r * g.y; a[q].z *= r * g.z; a[q].w *= r * g.w;
        *(float4*)(hq + 4 * q) = a[q];
      }
    }
    wave_lds_sync();
  }
}

#ifndef PX_SCALE
#define PX_SCALE 16.0f
#endif
template <int NS, int NB, int NBU>
__device__ void ph_gather10(const bf16_t* __restrict__ HN, const int* __restrict__ EXP, const float* __restrict__ GATE,
                           const unsigned char* __restrict__ PU8, const unsigned char* __restrict__ PV8,
                           const float* __restrict__ gfin, const float* H, float* Hout, unsigned char* lds,
                           const float* __restrict__ ss2, const float* __restrict__ gffn) {
  int tid_ = threadIdx.x; asm volatile("" : "+v"(tid_));
  const int wv = tid_ >> 6, lane = tid_ & 63;
  unsigned* se = (unsigned*)(lds + wv * (NS * 1024));
  float* sw = (float*)(lds + wv * (NS * 1024) + NS * 512);
  constexpr int STEP = NB / NS;
  constexpr int LPG = 64 / NB;
  for (int base = (blockIdx.x * NWAVE + wv) * NS; base < NTOK; base += gridDim.x * NWAVE * NS) {
#pragma unroll 1
    for (int s = 0; s < NS; ++s) {
      const int tok = base + s;
      unsigned k0 = ((unsigned)EXP[(size_t)tok * 128 + lane] << 7) | (unsigned)lane;
      unsigned k1 = ((unsigned)EXP[(size_t)tok * 128 + 64 + lane] << 7) | (unsigned)(64 + lane);
      wave_sort128(k0, k1, lane);
      se[s * 128 + lane] = k0 >> 7; se[s * 128 + 64 + lane] = k1 >> 7;
      sw[s * 128 + lane] = GATE[(size_t)tok * 128 + (k0 & 127u)]; sw[s * 128 + 64 + lane] = GATE[(size_t)tok * 128 + (k1 & 127u)];
    }
    wave_lds_sync();
    {
      long xb0[NS], xb1[NS];
      {
        f32x2_t gf[8];
#pragma unroll
        for (int q = 0; q < 8; ++q) gf[q] = *(const f32x2_t*)(gffn + 16 * lane + 2 * q);
#pragma unroll
        for (int s = 0; s < NS; ++s) {
          const uint4 h0 = *(const uint4*)(HN + (size_t)(base + s) * 1024 + 16 * lane), h1 = *(const uint4*)(HN + (size_t)(base + s) * 1024 + 16 * lane + 8);
          f32x2_t hn[8];
          hn[0] = (f32x2_t){bflo(h0.x), bfhi(h0.x)}; hn[1] = (f32x2_t){bflo(h0.y), bfhi(h0.y)}; hn[2] = (f32x2_t){bflo(h0.z), bfhi(h0.z)}; hn[3] = (f32x2_t){bflo(h0.w), bfhi(h0.w)};
          hn[4] = (f32x2_t){bflo(h1.x), bfhi(h1.x)}; hn[5] = (f32x2_t){bflo(h1.y), bfhi(h1.y)}; hn[6] = (f32x2_t){bflo(h1.z), bfhi(h1.z)}; hn[7] = (f32x2_t){bflo(h1.w), bfhi(h1.w)};
          const float rs2 = rsqrtf(ss2[base + s] * (1.0f / 1024.f) + 1e-6f) * PX_SCALE;
#pragma unroll
          for (int q = 0; q < 8; ++q) hn[q] = hn[q] * gf[q] * rs2;
          int w0 = 0, w1 = 0, w2 = 0, w3 = 0;
          w0 = __builtin_amdgcn_cvt_pk_fp8_f32(hn[0].x, hn[0].y, w0, false); w0 = __builtin_amdgcn_cvt_pk_fp8_f32(hn[1].x, hn[1].y, w0, true);
          w1 = __builtin_amdgcn_cvt_pk_fp8_f32(hn[2].x, hn[2].y, w1, false); w1 = __builtin_amdgcn_cvt_pk_fp8_f32(hn[3].x, hn[3].y, w1, true);
          w2 = __builtin_amdgcn_cvt_pk_fp8_f32(hn[4].x, hn[4].y, w2, false); w2 = __builtin_amdgcn_cvt_pk_fp8_f32(hn[5].x, hn[5].y, w2, true);
          w3 = __builtin_amdgcn_cvt_pk_fp8_f32(hn[6].x, hn[6].y, w3, false); w3 = __builtin_amdgcn_cvt_pk_fp8_f32(hn[7].x, hn[7].y, w3, true);
          xb0[s] = (long)(((unsigned long)(unsigned)w1 << 32) | (unsigned long)(unsigned)w0);
          xb1[s] = (long)(((unsigned long)(unsigned)w3 << 32) | (unsigned long)(unsigned)w2);
        }
      }
      const bool dg = (lane >> 4) == ((lane >> 2) & 3);
      const f32x2_t m01 = {(dg && (lane & 3) == 0) ? 1.f : 0.f, (dg && (lane & 3) == 1) ? 1.f : 0.f}, m23 = {(dg && (lane & 3) == 2) ? 1.f : 0.f, (dg && (lane & 3) == 3) ? 1.f : 0.f};
      constexpr int STEPU = NBU / NS, LPGU = 64 / NBU;
      uint4 uc[NBU];
#pragma unroll
      for (int k = 0; k < NBU; ++k) { const unsigned e = __builtin_amdgcn_readfirstlane(se[(k % NS) * 128 + (k / NS)]); uc[k] = *(const uint4*)(PU8 + (size_t)e * 1024 + 16 * lane); }
#pragma unroll 1
      for (int i = 0; i < 128; i += STEPU) {
        uint4 un[NBU];
        const int ni = (i + STEPU < 128) ? i + STEPU : i;
#pragma unroll
        for (int k = 0; k < NBU; ++k) { const unsigned e = __builtin_amdgcn_readfirstlane(se[(k % NS) * 128 + ni + (k / NS)]); un[k] = *(const uint4*)(PU8 + (size_t)e * 1024 + 16 * lane); }
        float d[NBU];
#pragma unroll
        for (int k = 0; k < NBU; ++k) {
          const long a0 = (long)(((unsigned long)uc[k].y << 32) | (unsigned long)uc[k].x), a1 = (long)(((unsigned long)uc[k].w << 32) | (unsigned long)uc[k].z);
          f32x4 acc = {0.f, 0.f, 0.f, 0.f};
          acc = __builtin_amdgcn_mfma_f32_16x16x32_fp8_fp8(a0, xb0[k % NS], acc, 0, 0, 0);
          acc = __builtin_amdgcn_mfma_f32_16x16x32_fp8_fp8(a1, xb1[k % NS], acc, 0, 0, 0);
          const f32x2_t t = (f32x2_t){acc[0], acc[1]} * m01 + (f32x2_t){acc[2], acc[3]} * m23;
          d[k] = t.x + t.y;
        }
        const float r1 = treduce<NBU>(d, lane);
        const int kk = lane / LPGU;
        const int pos = (kk % NS) * 128 + i + (kk / NS);
        const float wgt = sw[pos] * gelu_tanh(r1 * (1.0f / (PU_SCALE * PX_SCALE)));
        if ((lane % LPGU) == 0) sw[pos] = wgt;
#pragma unroll
        for (int k = 0; k < NBU; ++k) uc[k] = un[k];
      }
    }
    wave_lds_sync();
    f32x2_t acc[NS][8];
#pragma unroll
    for (int s = 0; s < NS; ++s)
#pragma unroll
      for (int q = 0; q < 8; ++q) acc[s][q] = (f32x2_t){0.f, 0.f};
    {
      uint4 vc[NB];
#pragma unroll
      for (int k = 0; k < NB; ++k) { const unsigned e = __builtin_amdgcn_readfirstlane(se[(k % NS) * 128 + (k / NS)]); vc[k] = *(const uint4*)(PV8 + (size_t)e * 1024 + 16 * lane); }
#pragma unroll 1
      for (int i = 0; i < 128; i += STEP) {
        uint4 vn[NB];
        const int ni = (i + STEP < 128) ? i + STEP : i;
#pragma unroll
        for (int k = 0; k < NB; ++k) { const unsigned e = __builtin_amdgcn_readfirstlane(se[(k % NS) * 128 + ni + (k / NS)]); vn[k] = *(const uint4*)(PV8 + (size_t)e * 1024 + 16 * lane); }
#pragma unroll
        for (int k = 0; k < NB; ++k) axpy16_fp8_pk(vc[k], sw[(k % NS) * 128 + i + (k / NS)], acc[k % NS]);
#pragma unroll
        for (int k = 0; k < NB; ++k) vc[k] = vn[k];
      }
    }
#pragma unroll
    for (int s = 0; s < NS; ++s) {
      float* hq = Hout + (size_t)(base + s) * 1024 + 16 * lane;
      float4 a[4]; float ss = 0.f;
#if RES_BF16
      const uint4 r0 = *(const uint4*)(HN + (size_t)(base + s) * 1024 + 16 * lane), r1 = *(const uint4*)(HN + (size_t)(base + s) * 1024 + 16 * lane + 8);
      a[0] = make_float4(bflo(r0.x), bfhi(r0.x), bflo(r0.y), bfhi(r0.y)); a[1] = make_float4(bflo(r0.z), bfhi(r0.z), bflo(r0.w), bfhi(r0.w));
      a[2] = make_float4(bflo(r1.x), bfhi(r1.x), bflo(r1.y), bfhi(r1.y)); a[3] = make_float4(bflo(r1.z), bfhi(r1.z), bflo(r1.w), bfhi(r1.w));
#else
      const float* hp = H + (size_t)(base + s) * 1024 + 16 * lane;
#endif
#pragma unroll
      for (int q = 0; q < 4; ++q) {
#if !RES_BF16
        a[q] = *(const float4*)(hp + 4 * q);
#endif
        a[q].x += acc[s][2 * q].x * (1.0f / PV_SCALE); a[q].y += acc[s][2 * q].y * (1.0f / PV_SCALE); a[q].z += acc[s][2 * q + 1].x * (1.0f / PV_SCALE); a[q].w += acc[s][2 * q + 1].y * (1.0f / PV_SCALE);
        ss += a[q].x * a[q].x + a[q].y * a[q].y + a[q].z * a[q].z + a[q].w * a[q].w;
      }
      ss = wave_sum(ss);
      const float r = rsqrtf(ss / 1024.f + 1e-6f);
#pragma unroll
      for (int q = 0; q < 4; ++q) {
        const float4 g = *(const float4*)(gfin + 16 * lane + 4 * q);
        a[q].x *= r * g.x; a[q].y *= r * g.y; a[q].z *= r * g.z; a[q].w *= r * g.w;
        *(float4*)(hq + 4 * q) = a[q];
      }
    }
    wave_lds_sync();
  }
}

#ifndef PX_SCALE
#define PX_SCALE 16.0f
#endif
template <int NS, int NB, int NBU>
__device__ void ph_gather11(const bf16_t* __restrict__ HN, const int* __restrict__ EXP, const float* __restrict__ GATE,
                           const unsigned char* __restrict__ PU8, const unsigned char* __restrict__ PV8,
                           const float* __restrict__ gfin, const float* H, float* Hout, unsigned char* lds,
                           const float* __restrict__ ss2, const float* __restrict__ gffn) {
  int tid_ = threadIdx.x; asm volatile("" : "+v"(tid_));
  const int wv = tid_ >> 6, lane = tid_ & 63;
  unsigned* se = (unsigned*)(lds + wv * (NS * 1024));
  float* sw = (float*)(lds + wv * (NS * 1024) + NS * 512);
  constexpr int STEP = NB / NS;
  constexpr int LPG = 64 / NB;
  for (int base = (blockIdx.x * NWAVE + wv) * NS; base < NTOK; base += gridDim.x * NWAVE * NS) {
#pragma unroll 1
    for (int s = 0; s < NS; ++s) {
      const int tok = base + s;
      unsigned k0 = ((unsigned)EXP[(size_t)tok * 128 + lane] << 7) | (unsigned)lane;
      unsigned k1 = ((unsigned)EXP[(size_t)tok * 128 + 64 + lane] << 7) | (unsigned)(64 + lane);
      wave_sort128(k0, k1, lane);
      se[s * 128 + lane] = k0 >> 7; se[s * 128 + 64 + lane] = k1 >> 7;
      sw[s * 128 + lane] = GATE[(size_t)tok * 128 + (k0 & 127u)]; sw[s * 128 + 64 + lane] = GATE[(size_t)tok * 128 + (k1 & 127u)];
    }
    wave_lds_sync();
    {
      long xb0[NS], xb1[NS];
      {
        f32x2_t gf[8];
#pragma unroll
        for (int q = 0; q < 8; ++q) gf[q] = *(const f32x2_t*)(gffn + 16 * lane + 2 * q);
#pragma unroll
        for (int s = 0; s < NS; ++s) {
          const uint4 h0 = *(const uint4*)(HN + (size_t)(base + s) * 1024 + 16 * lane), h1 = *(const uint4*)(HN + (size_t)(base + s) * 1024 + 16 * lane + 8);
          f32x2_t hn[8];
          hn[0] = (f32x2_t){bflo(h0.x), bfhi(h0.x)}; hn[1] = (f32x2_t){bflo(h0.y), bfhi(h0.y)}; hn[2] = (f32x2_t){bflo(h0.z), bfhi(h0.z)}; hn[3] = (f32x2_t){bflo(h0.w), bfhi(h0.w)};
          hn[4] = (f32x2_t){bflo(h1.x), bfhi(h1.x)}; hn[5] = (f32x2_t){bflo(h1.y), bfhi(h1.y)}; hn[6] = (f32x2_t){bflo(h1.z), bfhi(h1.z)}; hn[7] = (f32x2_t){bflo(h1.w), bfhi(h1.w)};
          const float rs2 = rsqrtf(ss2[base + s] * (1.0f / 1024.f) + 1e-6f) * PX_SCALE;
#pragma unroll
          for (int q = 0; q < 8; ++q) hn[q] = hn[q] * gf[q] * rs2;
          int w0 = 0, w1 = 0, w2 = 0, w3 = 0;
          w0 = __builtin_amdgcn_cvt_pk_fp8_f32(hn[0].x, hn[0].y, w0, false); w0 = __builtin_amdgcn_cvt_pk_fp8_f32(hn[1].x, hn[1].y, w0, true);
          w1 = __builtin_amdgcn_cvt_pk_fp8_f32(hn[2].x, hn[2].y, w1, false); w1 = __builtin_amdgcn_cvt_pk_fp8_f32(hn[3].x, hn[3].y, w1, true);
          w2 = __builtin_amdgcn_cvt_pk_fp8_f32(hn[4].x, hn[4].y, w2, false); w2 = __builtin_amdgcn_cvt_pk_fp8_f32(hn[5].x, hn[5].y, w2, true);
          w3 = __builtin_amdgcn_cvt_pk_fp8_f32(hn[6].x, hn[6].y, w3, false); w3 = __builtin_amdgcn_cvt_pk_fp8_f32(hn[7].x, hn[7].y, w3, true);
          xb0[s] = (long)(((unsigned long)(unsigned)w1 << 32) | (unsigned long)(unsigned)w0);
          xb1[s] = (long)(((unsigned long)(unsigned)w3 << 32) | (unsigned long)(unsigned)w2);
        }
      }
      const bool dg = (lane >> 4) == ((lane >> 2) & 3);
      const f32x2_t m01 = {(dg && (lane & 3) == 0) ? 1.f : 0.f, (dg && (lane & 3) == 1) ? 1.f : 0.f}, m23 = {(dg && (lane & 3) == 2) ? 1.f : 0.f, (dg && (lane & 3) == 3) ? 1.f : 0.f};
      constexpr int STEPU = NBU / NS, LPGU = 64 / NBU;
      const unsigned lo16 = (unsigned)lane << 4;
#define U_LOAD(buf, ii) _Pragma("unroll") for (int k = 0; k < NBU; ++k) { const unsigned e = se[(k % NS) * 128 + (ii) + (k / NS)]; buf[k] = *(const uint4*)(PU8 + ((e << 10) | lo16)); }
#define U_COMP(buf, ii) { float d[NBU]; \
        _Pragma("unroll") for (int k = 0; k < NBU; ++k) { \
          const long a0 = (long)(((unsigned long)buf[k].y << 32) | (unsigned long)buf[k].x), a1 = (long)(((unsigned long)buf[k].w << 32) | (unsigned long)buf[k].z); \
          f32x4 acc = {0.f, 0.f, 0.f, 0.f}; \
          acc = __builtin_amdgcn_mfma_f32_16x16x32_fp8_fp8(a0, xb0[k % NS], acc, 0, 0, 0); \
          acc = __builtin_amdgcn_mfma_f32_16x16x32_fp8_fp8(a1, xb1[k % NS], acc, 0, 0, 0); \
          const f32x2_t t = (f32x2_t){acc[0], acc[1]} * m01 + (f32x2_t){acc[2], acc[3]} * m23; \
          d[k] = t.x + t.y; } \
        const float r1 = treduce<NBU>(d, lane); \
        const int kk = lane / LPGU; \
        const int pos = (kk % NS) * 128 + (ii) + (kk / NS); \
        const float wgt = sw[pos] * gelu_tanh(r1 * (1.0f / (PU_SCALE * PX_SCALE))); \
        if ((lane % LPGU) == 0) sw[pos] = wgt; }
      uint4 ua[NBU], ub[NBU];
      U_LOAD(ua, 0)
#pragma unroll 1
      for (int i = 0; i < 128; i += 2 * STEPU) {
        U_LOAD(ub, i + STEPU)
        __builtin_amdgcn_sched_barrier(0);
        U_COMP(ua, i)
        __builtin_amdgcn_sched_barrier(0);
        const int ni = (i + 2 * STEPU < 128) ? i + 2 * STEPU : i;
        U_LOAD(ua, ni)
        __builtin_amdgcn_sched_barrier(0);
        U_COMP(ub, i + STEPU)
        __builtin_amdgcn_sched_barrier(0);
      }
#undef U_LOAD
#undef U_COMP
    }
    wave_lds_sync();
    f32x2_t acc[NS][8];
#pragma unroll
    for (int s = 0; s < NS; ++s)
#pragma unroll
      for (int q = 0; q < 8; ++q) acc[s][q] = (f32x2_t){0.f, 0.f};
    {
      const unsigned lo16 = (unsigned)lane << 4;
#define V_LOAD(buf, ii) _Pragma("unroll") for (int k = 0; k < NB; ++k) { const unsigned e = se[(k % NS) * 128 + (ii) + (k / NS)]; buf[k] = *(const uint4*)(PV8 + ((e << 10) | lo16)); }
#define V_COMP(buf, ii) _Pragma("unroll") for (int k = 0; k < NB; ++k) axpy16_fp8_pk(buf[k], sw[(k % NS) * 128 + (ii) + (k / NS)], acc[k % NS]);
      uint4 va[NB], vb[NB];
      V_LOAD(va, 0)
#pragma unroll 1
      for (int i = 0; i < 128; i += 2 * STEP) {
        V_LOAD(vb, i + STEP)
        __builtin_amdgcn_sched_barrier(0);
        V_COMP(va, i)
        __builtin_amdgcn_sched_barrier(0);
        const int ni = (i + 2 * STEP < 128) ? i + 2 * STEP : i;
        V_LOAD(va, ni)
        __builtin_amdgcn_sched_barrier(0);
        V_COMP(vb, i + STEP)
        __builtin_amdgcn_sched_barrier(0);
      }
#undef V_LOAD
#undef V_COMP
    }
#pragma unroll
    for (int s = 0; s < NS; ++s) {
      float* hq = Hout + (size_t)(base + s) * 1024 + 16 * lane;
      float4 a[4]; float ss = 0.f;
#if RES_BF16
      const uint4 r0 = *(const uint4*)(HN + (size_t)(base + s) * 1024 + 16 * lane), r1 = *(const uint4*)(HN + (size_t)(base + s) * 1024 + 16 * lane + 8);
      a[0] = make_float4(bflo(r0.x), bfhi(r0.x), bflo(r0.y), bfhi(r0.y)); a[1] = make_float4(bflo(r0.z), bfhi(r0.z), bflo(r0.w), bfhi(r0.w));
      a[2] = make_float4(bflo(r1.x), bfhi(r1.x), bflo(r1.y), bfhi(r1.y)); a[3] = make_float4(bflo(r1.z), bfhi(r1.z), bflo(r1.w), bfhi(r1.w));
#else
      const float* hp = H + (size_t)(base + s) * 1024 + 16 * lane;
#endif
#pragma unroll
      for (int q = 0; q < 4; ++q) {
#if !RES_BF16
        a[q] = *(const float4*)(hp + 4 * q);
#endif
        a[q].x += acc[s][2 * q].x * (1.0f / PV_SCALE); a[q].y += acc[s][2 * q].y * (1.0f / PV_SCALE); a[q].z += acc[s][2 * q + 1].x * (1.0f / PV_SCALE); a[q].w += acc[s][2 * q + 1].y * (1.0f / PV_SCALE);
        ss += a[q].x * a[q].x + a[q].y * a[q].y + a[q].z * a[q].z + a[q].w * a[q].w;
      }
      ss = wave_sum(ss);
      const float r = rsqrtf(ss / 1024.f + 1e-6f);
#ifdef PROBE_VARRATIO
      float pp = 0.f;
#pragma unroll
      for (int q = 0; q < 8; ++q) pp += acc[s][q].x * acc[s][q].x + acc[s][q].y * acc[s][q].y;
      pp = wave_sum(pp) * (1.0f / (PV_SCALE * PV_SCALE));
      const float cst = 10.0f * sqrtf(pp / ss);
#pragma unroll
      for (int q = 0; q < 4; ++q) *(float4*)(hq + 4 * q) = make_float4(cst, cst, cst, cst);
#else
#pragma unroll
      for (int q = 0; q < 4; ++q) {
        const float4 g = *(const float4*)(gfin + 16 * lane + 4 * q);
        a[q].x *= r * g.x; a[q].y *= r * g.y; a[q].z *= r * g.z; a[q].w *= r * g.w;
        *(float4*)(hq + 4 * q) = a[q];
      }
#endif
    }
    wave_lds_sync();
  }
}

#ifndef PX_SCALE
#define PX_SCALE 16.0f
#endif
#ifndef NT_FP4
#define NT_FP4 0
#endif
#ifndef PV4_SCALE
#define PV4_SCALE 5.65f
#endif
__device__ void prep_cvt_fp4(const float* __restrict__ src, unsigned char* __restrict__ dst, size_t n, float scale, int wg, int nwg) {
#pragma unroll 4
  for (size_t i = ((size_t)wg * NTHR + threadIdx.x) * 8; i < n; i += (size_t)nwg * NTHR * 8) {
    const f32x4 a = __builtin_nontemporal_load((const f32x4*)(src + i)), b = __builtin_nontemporal_load((const f32x4*)(src + i + 4));
    unsigned q = 0;
    q = __builtin_amdgcn_cvt_scalef32_pk_fp4_f32(q, a[0] * scale, a[1] * scale, 1.0f, 0);
    q = __builtin_amdgcn_cvt_scalef32_pk_fp4_f32(q, a[2] * scale, a[3] * scale, 1.0f, 1);
    q = __builtin_amdgcn_cvt_scalef32_pk_fp4_f32(q, b[0] * scale, b[1] * scale, 1.0f, 2);
    q = __builtin_amdgcn_cvt_scalef32_pk_fp4_f32(q, b[2] * scale, b[3] * scale, 1.0f, 3);
#if NT_FP4
    __builtin_nontemporal_store(q, (unsigned*)(dst + (i >> 1)));
#else
    *(unsigned*)(dst + (i >> 1)) = q;
#endif
  }
}
typedef unsigned u32x2_t __attribute__((ext_vector_type(2)));
__device__ __forceinline__ void axpy16_fp4_pk(const u32x2_t& v, float w_, f32x2_t (&acc2)[8]) {
  const f32x2_t ww = {w_, w_};
  acc2[0] = __builtin_elementwise_fma(__builtin_amdgcn_cvt_scalef32_pk_f32_fp4(v.x, 1.0f, 0), ww, acc2[0]);
  acc2[1] = __builtin_elementwise_fma(__builtin_amdgcn_cvt_scalef32_pk_f32_fp4(v.x, 1.0f, 1), ww, acc2[1]);
  acc2[2] = __builtin_elementwise_fma(__builtin_amdgcn_cvt_scalef32_pk_f32_fp4(v.x, 1.0f, 2), ww, acc2[2]);
  acc2[3] = __builtin_elementwise_fma(__builtin_amdgcn_cvt_scalef32_pk_f32_fp4(v.x, 1.0f, 3), ww, acc2[3]);
  acc2[4] = __builtin_elementwise_fma(__builtin_amdgcn_cvt_scalef32_pk_f32_fp4(v.y, 1.0f, 0), ww, acc2[4]);
  acc2[5] = __builtin_elementwise_fma(__builtin_amdgcn_cvt_scalef32_pk_f32_fp4(v.y, 1.0f, 1), ww, acc2[5]);
  acc2[6] = __builtin_elementwise_fma(__builtin_amdgcn_cvt_scalef32_pk_f32_fp4(v.y, 1.0f, 2), ww, acc2[6]);
  acc2[7] = __builtin_elementwise_fma(__builtin_amdgcn_cvt_scalef32_pk_f32_fp4(v.y, 1.0f, 3), ww, acc2[7]);
}
template <int NS, int NB, int NBU>
__device__ void ph_gather13(const bf16_t* __restrict__ HN, const int* __restrict__ EXP, const float* __restrict__ GATE,
                           const unsigned char* __restrict__ PU8, const unsigned char* __restrict__ PV8,
                           const float* __restrict__ gfin, const float* H, float* Hout, unsigned char* lds,
                           const float* __restrict__ ss2, const float* __restrict__ gffn) {
  int tid_ = threadIdx.x; asm volatile("" : "+v"(tid_));
  const int wv = tid_ >> 6, lane = tid_ & 63;
  unsigned* se = (unsigned*)(lds + wv * (NS * 1024));
  float* sw = (float*)(lds + wv * (NS * 1024) + NS * 512);
  constexpr int STEP = NB / NS;
  constexpr int LPG = 64 / NB;
  for (int base = (blockIdx.x * NWAVE + wv) * NS; base < NTOK; base += gridDim.x * NWAVE * NS) {
#pragma unroll 1
    for (int s = 0; s < NS; ++s) {
      const int tok = base + s;
      unsigned k0 = ((unsigned)EXP[(size_t)tok * 128 + lane] << 7) | (unsigned)lane;
      unsigned k1 = ((unsigned)EXP[(size_t)tok * 128 + 64 + lane] << 7) | (unsigned)(64 + lane);
      wave_sort128(k0, k1, lane);
      se[s * 128 + lane] = k0 >> 7; se[s * 128 + 64 + lane] = k1 >> 7;
      sw[s * 128 + lane] = GATE[(size_t)tok * 128 + (k0 & 127u)]; sw[s * 128 + 64 + lane] = GATE[(size_t)tok * 128 + (k1 & 127u)];
    }
    wave_lds_sync();
    {
      long xb0[NS], xb1[NS];
      {
        f32x2_t gf[8];
#pragma unroll
        for (int q = 0; q < 8; ++q) gf[q] = *(const f32x2_t*)(gffn + 16 * lane + 2 * q);
#pragma unroll
        for (int s = 0; s < NS; ++s) {
          const uint4 h0 = *(const uint4*)(HN + (size_t)(base + s) * 1024 + 16 * lane), h1 = *(const uint4*)(HN + (size_t)(base + s) * 1024 + 16 * lane + 8);
          f32x2_t hn[8];
          hn[0] = (f32x2_t){bflo(h0.x), bfhi(h0.x)}; hn[1] = (f32x2_t){bflo(h0.y), bfhi(h0.y)}; hn[2] = (f32x2_t){bflo(h0.z), bfhi(h0.z)}; hn[3] = (f32x2_t){bflo(h0.w), bfhi(h0.w)};
          hn[4] = (f32x2_t){bflo(h1.x), bfhi(h1.x)}; hn[5] = (f32x2_t){bflo(h1.y), bfhi(h1.y)}; hn[6] = (f32x2_t){bflo(h1.z), bfhi(h1.z)}; hn[7] = (f32x2_t){bflo(h1.w), bfhi(h1.w)};
          const float rs2 = rsqrtf(ss2[base + s] * (1.0f / 1024.f) + 1e-6f) * PX_SCALE;
#pragma unroll
          for (int q = 0; q < 8; ++q) hn[q] = hn[q] * gf[q] * rs2;
          int w0 = 0, w1 = 0, w2 = 0, w3 = 0;
          w0 = __builtin_amdgcn_cvt_pk_fp8_f32(hn[0].x, hn[0].y, w0, false); w0 = __builtin_amdgcn_cvt_pk_fp8_f32(hn[1].x, hn[1].y, w0, true);
          w1 = __builtin_amdgcn_cvt_pk_fp8_f32(hn[2].x, hn[2].y, w1, false); w1 = __builtin_amdgcn_cvt_pk_fp8_f32(hn[3].x, hn[3].y, w1, true);
          w2 = __builtin_amdgcn_cvt_pk_fp8_f32(hn[4].x, hn[4].y, w2, false); w2 = __builtin_amdgcn_cvt_pk_fp8_f32(hn[5].x, hn[5].y, w2, true);
          w3 = __builtin_amdgcn_cvt_pk_fp8_f32(hn[6].x, hn[6].y, w3, false); w3 = __builtin_amdgcn_cvt_pk_fp8_f32(hn[7].x, hn[7].y, w3, true);
          xb0[s] = (long)(((unsigned long)(unsigned)w1 << 32) | (unsigned long)(unsigned)w0);
          xb1[s] = (long)(((unsigned long)(unsigned)w3 << 32) | (unsigned long)(unsigned)w2);
        }
      }
      const bool dg = (lane >> 4) == ((lane >> 2) & 3);
      const f32x2_t m01 = {(dg && (lane & 3) == 0) ? 1.f : 0.f, (dg && (lane & 3) == 1) ? 1.f : 0.f}, m23 = {(dg && (lane & 3) == 2) ? 1.f : 0.f, (dg && (lane & 3) == 3) ? 1.f : 0.f};
      constexpr int STEPU = NBU / NS, LPGU = 64 / NBU;
      const unsigned lo16 = (unsigned)lane << 4;
#define U_LOAD(buf, ii) _Pragma("unroll") for (int k = 0; k < NBU; ++k) { const unsigned e = se[(k % NS) * 128 + (ii) + (k / NS)]; buf[k] = *(const uint4*)(PU8 + ((e << 10) | lo16)); }
#define U_COMP(buf, ii) { float d[NBU]; \
        _Pragma("unroll") for (int k = 0; k < NBU; ++k) { \
          const long a0 = (long)(((unsigned long)buf[k].y << 32) | (unsigned long)buf[k].x), a1 = (long)(((unsigned long)buf[k].w << 32) | (unsigned long)buf[k].z); \
          f32x4 acc = {0.f, 0.f, 0.f, 0.f}; \
          acc = __builtin_amdgcn_mfma_f32_16x16x32_fp8_fp8(a0, xb0[k % NS], acc, 0, 0, 0); \
          acc = __builtin_amdgcn_mfma_f32_16x16x32_fp8_fp8(a1, xb1[k % NS], acc, 0, 0, 0); \
          const f32x2_t t = (f32x2_t){acc[0], acc[1]} * m01 + (f32x2_t){acc[2], acc[3]} * m23; \
          d[k] = t.x + t.y; } \
        const float r1 = treduce<NBU>(d, lane); \
        const int kk = lane / LPGU; \
        const int pos = (kk % NS) * 128 + (ii) + (kk / NS); \
        const float wgt = sw[pos] * gelu_tanh(r1 * (1.0f / (PU_SCALE * PX_SCALE))); \
        if ((lane % LPGU) == 0) sw[pos] = wgt; }
      uint4 ua[NBU], ub[NBU];
      U_LOAD(ua, 0)
#pragma unroll 1
      for (int i = 0; i < 128; i += 2 * STEPU) {
        U_LOAD(ub, i + STEPU)
        __builtin_amdgcn_sched_barrier(0);
        U_COMP(ua, i)
        __builtin_amdgcn_sched_barrier(0);
        const int ni = (i + 2 * STEPU < 128) ? i + 2 * STEPU : i;
        U_LOAD(ua, ni)
        __builtin_amdgcn_sched_barrier(0);
        U_COMP(ub, i + STEPU)
        __builtin_amdgcn_sched_barrier(0);
      }
#undef U_LOAD
#undef U_COMP
    }
    wave_lds_sync();
    f32x2_t acc[NS][8];
#pragma unroll
    for (int s = 0; s < NS; ++s)
#pragma unroll
      for (int q = 0; q < 8; ++q) acc[s][q] = (f32x2_t){0.f, 0.f};
    {
      const unsigned lo8 = (unsigned)lane << 3;
#define V_LOAD(buf, ii) _Pragma("unroll") for (int k = 0; k < NB; ++k) { const unsigned e = se[(k % NS) * 128 + (ii) + (k / NS)]; buf[k] = *(const u32x2_t*)(PV8 + ((e << 9) | lo8)); }
#define V_COMP(buf, ii) _Pragma("unroll") for (int k = 0; k < NB; ++k) axpy16_fp4_pk(buf[k], sw[(k % NS) * 128 + (ii) + (k / NS)], acc[k % NS]);
      u32x2_t va[NB], vb[NB];
      V_LOAD(va, 0)
#pragma unroll 1
      for (int i = 0; i < 128; i += 2 * STEP) {
        V_LOAD(vb, i + STEP)
        __builtin_amdgcn_sched_barrier(0);
        V_COMP(va, i)
        __builtin_amdgcn_sched_barrier(0);
        const int ni = (i + 2 * STEP < 128) ? i + 2 * STEP : i;
        V_LOAD(va, ni)
        __builtin_amdgcn_sched_barrier(0);
        V_COMP(vb, i + STEP)
        __builtin_amdgcn_sched_barrier(0);
      }
#undef V_LOAD
#undef V_COMP
    }
#pragma unroll
    for (int s = 0; s < NS; ++s) {
      float* hq = Hout + (size_t)(base + s) * 1024 + 16 * lane;
      float4 a[4]; float ss = 0.f;
#if RES_BF16
      const uint4 r0 = *(const uint4*)(HN + (size_t)(base + s) * 1024 + 16 * lane), r1 = *(const uint4*)(HN + (size_t)(base + s) * 1024 + 16 * lane + 8);
      a[0] = make_float4(bflo(r0.x), bfhi(r0.x), bflo(r0.y), bfhi(r0.y)); a[1] = make_float4(bflo(r0.z), bfhi(r0.z), bflo(r0.w), bfhi(r0.w));
      a[2] = make_float4(bflo(r1.x), bfhi(r1.x), bflo(r1.y), bfhi(r1.y)); a[3] = make_float4(bflo(r1.z), bfhi(r1.z), bflo(r1.w), bfhi(r1.w));
#else
      const float* hp = H + (size_t)(base + s) * 1024 + 16 * lane;
#endif
#pragma unroll
      for (int q = 0; q < 4; ++q) {
#if !RES_BF16
        a[q] = *(const float4*)(hp + 4 * q);
#endif
        a[q].x += acc[s][2 * q].x * (1.0f / PV4_SCALE); a[q].y += acc[s][2 * q].y * (1.0f / PV4_SCALE); a[q].z += acc[s][2 * q + 1].x * (1.0f / PV4_SCALE); a[q].w += acc[s][2 * q + 1].y * (1.0f / PV4_SCALE);
        ss += a[q].x * a[q].x + a[q].y * a[q].y + a[q].z * a[q].z + a[q].w * a[q].w;
      }
      ss = wave_sum(ss);
      const float r = rsqrtf(ss / 1024.f + 1e-6f);
#ifdef PROBE_VARRATIO
      float pp = 0.f;
#pragma unroll
      for (int q = 0; q < 8; ++q) pp += acc[s][q].x * acc[s][q].x + acc[s][q].y * acc[s][q].y;
      pp = wave_sum(pp) * (1.0f / (PV4_SCALE * PV4_SCALE));
      const float cst = 10.0f * sqrtf(pp / ss);
#pragma unroll
      for (int q = 0; q < 4; ++q) *(float4*)(hq + 4 * q) = make_float4(cst, cst, cst, cst);
#else
#pragma unroll
      for (int q = 0; q < 4; ++q) {
        const float4 g = *(const float4*)(gfin + 16 * lane + 4 * q);
        a[q].x *= r * g.x; a[q].y *= r * g.y; a[q].z *= r * g.z; a[q].w *= r * g.w;
        *(float4*)(hq + 4 * q) = a[q];
      }
#endif
    }
    wave_lds_sync();
  }
}

#ifndef PU4_SCALE
#define PU4_SCALE 64.0f
#endif
typedef int i32x8_t __attribute__((ext_vector_type(8)));
typedef unsigned u32x4_t __attribute__((ext_vector_type(4)));
template <int NS, int NB, int NBU>
__device__ void ph_gather14(const bf16_t* __restrict__ HN, const int* __restrict__ EXP, const float* __restrict__ GATE,
                           const unsigned char* __restrict__ PU8, const unsigned char* __restrict__ PV8,
                           const float* __restrict__ gfin, const float* H, float* Hout, unsigned char* lds,
                           const float* __restrict__ ss2, const float* __restrict__ gffn) {
  int tid_ = threadIdx.x; asm volatile("" : "+v"(tid_));
  const int wv = tid_ >> 6, lane = tid_ & 63;
  unsigned* se = (unsigned*)(lds + wv * (NS * 1024));
  float* sw = (float*)(lds + wv * (NS * 1024) + NS * 512);
  constexpr int STEP = NB / NS;
  constexpr int LPG = 64 / NB;
  for (int base = (blockIdx.x * NWAVE + wv) * NS; base < NTOK; base += gridDim.x * NWAVE * NS) {
#pragma unroll 1
    for (int s = 0; s < NS; ++s) {
      const int tok = base + s;
      unsigned k0 = ((unsigned)EXP[(size_t)tok * 128 + lane] << 7) | (unsigned)lane;
      unsigned k1 = ((unsigned)EXP[(size_t)tok * 128 + 64 + lane] << 7) | (unsigned)(64 + lane);
      wave_sort128(k0, k1, lane);
      se[s * 128 + lane] = k0 >> 7; se[s * 128 + 64 + lane] = k1 >> 7;
      sw[s * 128 + lane] = GATE[(size_t)tok * 128 + (k0 & 127u)]; sw[s * 128 + 64 + lane] = GATE[(size_t)tok * 128 + (k1 & 127u)];
    }
    wave_lds_sync();
    {
      static_assert(NS == 4, "layout");
      const int tc = lane & 7, tg = lane >> 4, th = (lane >> 3) & 1;
      const unsigned l32 = 8u * tg + tc;
      i32x8_t xb[NS];
      {
        const int e0 = 256 * (tg >> 1) + 32 * tc + 16 * (tg & 1);
        const float* gfp = gffn + e0; asm volatile("" : "+v"(gfp));
        f32x4 gq[8];
#pragma unroll
        for (int q = 0; q < 4; ++q) { gq[2 * q] = *(const f32x4*)(gfp + (q >> 1) * 512 + (q & 1) * 8); gq[2 * q + 1] = *(const f32x4*)(gfp + (q >> 1) * 512 + (q & 1) * 8 + 4); }
#pragma unroll
        for (int s = 0; s < NS; ++s) {
          const bf16_t* hp = HN + (size_t)(base + s) * 1024 + e0;
          const float rs2 = rsqrtf(ss2[base + s] * (1.0f / 1024.f) + 1e-6f) * PX_SCALE;
#pragma unroll
          for (int q = 0; q < 4; ++q) {
            const uint4 h = *(const uint4*)(hp + (q >> 1) * 512 + (q & 1) * 8);
            const float v0 = bflo(h.x) * gq[2 * q][0] * rs2, v1 = bfhi(h.x) * gq[2 * q][1] * rs2, v2 = bflo(h.y) * gq[2 * q][2] * rs2, v3 = bfhi(h.y) * gq[2 * q][3] * rs2;
            const float v4 = bflo(h.z) * gq[2 * q + 1][0] * rs2, v5 = bfhi(h.z) * gq[2 * q + 1][1] * rs2, v6 = bflo(h.w) * gq[2 * q + 1][2] * rs2, v7 = bfhi(h.w) * gq[2 * q + 1][3] * rs2;
            int w0 = 0, w1 = 0;
            w0 = __builtin_amdgcn_cvt_pk_fp8_f32(v0, v1, w0, false); w0 = __builtin_amdgcn_cvt_pk_fp8_f32(v2, v3, w0, true);
            w1 = __builtin_amdgcn_cvt_pk_fp8_f32(v4, v5, w1, false); w1 = __builtin_amdgcn_cvt_pk_fp8_f32(v6, v7, w1, true);
            xb[s][2 * q] = w0; xb[s][2 * q + 1] = w1;
          }
        }
      }
      const bool dg = (lane >> 4) == ((lane >> 2) & 3);
      const f32x2_t m01 = {(dg && (lane & 3) == 0) ? 1.f : 0.f, (dg && (lane & 3) == 1) ? 1.f : 0.f}, m23 = {(dg && (lane & 3) == 2) ? 1.f : 0.f, (dg && (lane & 3) == 3) ? 1.f : 0.f};
      const unsigned lo16 = 16u * l32;
      const unsigned* seh = se + th;
#define U_LOAD(buf, ii) _Pragma("unroll") for (int k = 0; k < 8; ++k) { const unsigned e = seh[(k % NS) * 128 + (ii) + 2 * (k / NS)]; buf[k] = *(const u32x4_t*)(PU8 + ((e << 9) | lo16)); }
#define U_COMP(buf, ii) { float d[8]; \
        _Pragma("unroll") for (int k = 0; k < 8; ++k) { \
          const i32x8_t a = {(int)buf[k][0], (int)buf[k][1], (int)buf[k][2], (int)buf[k][3], 0, 0, 0, 0}; \
          f32x4 acc = {0.f, 0.f, 0.f, 0.f}; \
          acc = __builtin_amdgcn_mfma_scale_f32_16x16x128_f8f6f4(a, xb[k % NS], acc, 4, 0, 0, 0, 0, 0); \
          const f32x2_t t = (f32x2_t){acc[0], acc[1]} * m01 + (f32x2_t){acc[2], acc[3]} * m23; \
          d[k] = t.x + t.y; } \
        const float r1 = treduce_lvl<8, 16>(d, lane);             \
        const int kk = (lane >> 2) & 7; \
        const int pos = (kk % NS) * 128 + (ii) + 2 * (kk / NS) + (lane >> 5); \
        const float wgt = sw[pos] * gelu_tanh(r1 * (1.0f / (PU4_SCALE * PX_SCALE))); \
        if ((lane & 3) == 0) sw[pos] = wgt; }
      u32x4_t ua[8], ub[8];
      U_LOAD(ua, 0)
#pragma unroll 1
      for (int i = 0; i < 128; i += 8) {
        U_LOAD(ub, i + 4)
        __builtin_amdgcn_sched_barrier(0);
        U_COMP(ua, i)
        __builtin_amdgcn_sched_barrier(0);
        const int ni = (i + 8 < 128) ? i + 8 : i;
        U_LOAD(ua, ni)
        __builtin_amdgcn_sched_barrier(0);
        U_COMP(ub, i + 4)
        __builtin_amdgcn_sched_barrier(0);
      }
#undef U_LOAD
#undef U_COMP
    }
    wave_lds_sync();
    f32x2_t acc[NS][8];
#pragma unroll
    for (int s = 0; s < NS; ++s)
#pragma unroll
      for (int q = 0; q < 8; ++q) acc[s][q] = (f32x2_t){0.f, 0.f};
    {
      const unsigned lo8 = (unsigned)lane << 3;
#define V_LOAD(buf, ii) _Pragma("unroll") for (int k = 0; k < NB; ++k) { const unsigned e = se[(k % NS) * 128 + (ii) + (k / NS)]; buf[k] = *(const u32x2_t*)(PV8 + ((e << 9) | lo8)); }
#define V_COMP(buf, ii) _Pragma("unroll") for (int k = 0; k < NB; ++k) axpy16_fp4_pk(buf[k], sw[(k % NS) * 128 + (ii) + (k / NS)], acc[k % NS]);
      u32x2_t va[NB], vb[NB];
      V_LOAD(va, 0)
#pragma unroll 1
      for (int i = 0; i < 128; i += 2 * STEP) {
        V_LOAD(vb, i + STEP)
        __builtin_amdgcn_sched_barrier(0);
        V_COMP(va, i)
        __builtin_amdgcn_sched_barrier(0);
        const int ni = (i + 2 * STEP < 128) ? i + 2 * STEP : i;
        V_LOAD(va, ni)
        __builtin_amdgcn_sched_barrier(0);
        V_COMP(vb, i + STEP)
        __builtin_amdgcn_sched_barrier(0);
      }
#undef V_LOAD
#undef V_COMP
    }
#pragma unroll
    for (int s = 0; s < NS; ++s) {
      float* hq = Hout + (size_t)(base + s) * 1024 + 16 * lane;
      float4 a[4]; float ss = 0.f;
#if RES_BF16
      const uint4 r0 = *(const uint4*)(HN + (size_t)(base + s) * 1024 + 16 * lane), r1 = *(const uint4*)(HN + (size_t)(base + s) * 1024 + 16 * lane + 8);
      a[0] = make_float4(bflo(r0.x), bfhi(r0.x), bflo(r0.y), bfhi(r0.y)); a[1] = make_float4(bflo(r0.z), bfhi(r0.z), bflo(r0.w), bfhi(r0.w));
      a[2] = make_float4(bflo(r1.x), bfhi(r1.x), bflo(r1.y), bfhi(r1.y)); a[3] = make_float4(bflo(r1.z), bfhi(r1.z), bflo(r1.w), bfhi(r1.w));
#else
      const float* hp = H + (size_t)(base + s) * 1024 + 16 * lane;
#endif
#pragma unroll
      for (int q = 0; q < 4; ++q) {
#if !RES_BF16
        a[q] = *(const float4*)(hp + 4 * q);
#endif
        a[q].x += acc[s][2 * q].x * (1.0f / PV4_SCALE); a[q].y += acc[s][2 * q].y * (1.0f / PV4_SCALE); a[q].z += acc[s][2 * q + 1].x * (1.0f / PV4_SCALE); a[q].w += acc[s][2 * q + 1].y * (1.0f / PV4_SCALE);
        ss += a[q].x * a[q].x + a[q].y * a[q].y + a[q].z * a[q].z + a[q].w * a[q].w;
      }
      ss = wave_sum(ss);
      const float r = rsqrtf(ss / 1024.f + 1e-6f);
#ifdef PROBE_VARRATIO
      float pp = 0.f;
#pragma unroll
      for (int q = 0; q < 8; ++q) pp += acc[s][q].x * acc[s][q].x + acc[s][q].y * acc[s][q].y;
      pp = wave_sum(pp) * (1.0f / (PV4_SCALE * PV4_SCALE));
#ifdef PROBE_MFMA4
      const float cst = (float)__hip_atomic_load(DBG_CNT_PTR, __ATOMIC_RELAXED, __HIP_MEMORY_SCOPE_AGENT) + 0.f * pp;
#else
      const float cst = 10.0f * sqrtf(pp / ss);
#endif
#pragma unroll
      for (int q = 0; q < 4; ++q) *(float4*)(hq + 4 * q) = make_float4(cst, cst, cst, cst);
#else
#pragma unroll
      for (int q = 0; q < 4; ++q) {
        const float4 g = *(const float4*)(gfin + 16 * lane + 4 * q);
        a[q].x *= r * g.x; a[q].y *= r * g.y; a[q].z *= r * g.z; a[q].w *= r * g.w;
        *(float4*)(hq + 4 * q) = a[q];
      }
#endif
    }
    wave_lds_sync();
  }
}

#ifdef PROBE_MFMA4
__device__ unsigned probe_mfma4(unsigned char* lds) {
  const int lane = threadIdx.x & 63;
  unsigned* LA = (unsigned*)lds; unsigned* LB = (unsigned*)lds + 256;
  unsigned a[4], b[8];
  unsigned st = (unsigned)lane * 2654435761u + 12345u;
#pragma unroll
  for (int r = 0; r < 4; ++r) { unsigned w = 0; for (int nb = 0; nb < 8; ++nb) { st = st * 1664525u + 1013904223u; const unsigned v = (st >> 24) % 3u; w |= (v * 2u) << (4 * nb); } a[r] = w; LA[lane * 4 + r] = w; }
#pragma unroll
  for (int r = 0; r < 8; ++r) { unsigned w = 0; for (int bb = 0; bb < 4; ++bb) { st = st * 1664525u + 1013904223u; const unsigned v = (st >> 24) & 3u; const unsigned code = v == 0 ? 0u : v == 1 ? 0x38u : v == 2 ? 0x40u : 0x44u; w |= code << (8 * bb); } b[r] = w; LB[lane * 8 + r] = w; }
  wave_lds_sync();
  const i32x8_t A = {(int)a[0], (int)a[1], (int)a[2], (int)a[3], 0, 0, 0, 0}, B = {(int)b[0], (int)b[1], (int)b[2], (int)b[3], (int)b[4], (int)b[5], (int)b[6], (int)b[7]};
  f32x4 D = {0.f, 0.f, 0.f, 0.f};
  D = __builtin_amdgcn_mfma_scale_f32_16x16x128_f8f6f4(A, B, D, 4, 0, 0, 0, 0, 0);
  const int n = lane & 15, q = lane >> 4;
  unsigned code = 0;
#pragma unroll 1
  for (int h = 6; h >= 1; --h) {
    const bool aswap = (h == 2 || h == 6), ahalf = (h == 4 || h == 5), bhalf = (h == 3 || h == 5 || h == 6);
    bool ok = true;
#pragma unroll
    for (int jj = 0; jj < 4; ++jj) {
      const int row = 4 * q + jj;
      float E = 0.f;
#pragma unroll 1
      for (int gj = 0; gj < 128; ++gj) {
        const int g = gj >> 5, j = gj & 31;
        const unsigned wa = LA[(16 * g + row) * 4 + (j >> 3)];
        const float av = 0.5f * (float)((wa >> (4 * (j & 7))) & 15u);
        const int je = aswap ? (j ^ 1) : j;
        const int k = ahalf ? (je < 16 ? 16 * g + je : 64 + 16 * g + (je - 16)) : 32 * g + je;
        int g2, j2;
        if (bhalf) { if (k < 64) { g2 = k >> 4; j2 = k & 15; } else { g2 = (k - 64) >> 4; j2 = 16 + ((k - 64) & 15); } }
        else { g2 = k >> 5; j2 = k & 31; }
        const unsigned wb = LB[(16 * g2 + n) * 8 + (j2 >> 2)];
        const unsigned by = (wb >> (8 * (j2 & 3))) & 255u;
        const float bv = by == 0u ? 0.f : by == 0x38u ? 1.f : by == 0x40u ? 2.f : 3.f;
        E += av * bv;
      }
      ok = ok && (E == D[jj]);
    }
    if (__all(ok)) code = (unsigned)h;
  }
  if (code == 0u && __all(D[0] == 0.f && D[1] == 0.f && D[2] == 0.f && D[3] == 0.f)) code = 7u;
  return code;
}
#endif

#ifndef PW_SCALE
#define PW_SCALE 64.0f
#endif
typedef float f32x16_t __attribute__((ext_vector_type(16)));
template <int NS, int NB, int NBU>
__device__ void ph_gather17(const bf16_t* __restrict__ HN, const int* __restrict__ EXP, const float* __restrict__ GATE,
                           const unsigned char* __restrict__ PU8, const unsigned char* __restrict__ PV8,
                           const float* __restrict__ gfin, const float* H, float* Hout, unsigned char* lds,
                           const float* __restrict__ ss2, const float* __restrict__ gffn) {
  int tid_ = threadIdx.x; asm volatile("" : "+v"(tid_));
  const int wv = tid_ >> 6, lane = tid_ & 63;
  unsigned* se = (unsigned*)(lds + wv * 8192);
  float* sw = (float*)(lds + wv * 8192 + 2048);
  float* stg = (float*)(lds + wv * 8192 + 4096);
  constexpr int STEP = NB / NS;
  constexpr int LPG = 64 / NB;
  for (int base = (blockIdx.x * NWAVE + wv) * NS; base < NTOK; base += gridDim.x * NWAVE * NS) {
#pragma unroll 1
    for (int s = 0; s < NS; ++s) {
      const int tok = base + s;
      unsigned k0 = ((unsigned)EXP[(size_t)tok * 128 + lane] << 7) | (unsigned)lane;
      unsigned k1 = ((unsigned)EXP[(size_t)tok * 128 + 64 + lane] << 7) | (unsigned)(64 + lane);
      wave_sort128(k0, k1, lane);
      se[s * 128 + lane] = k0 >> 7; se[s * 128 + 64 + lane] = k1 >> 7;
      sw[s * 128 + lane] = GATE[(size_t)tok * 128 + (k0 & 127u)]; sw[s * 128 + 64 + lane] = GATE[(size_t)tok * 128 + (k1 & 127u)];
    }
    wave_lds_sync();
    {
      static_assert(NS == 4, "layout");
      const int tc = lane & 7, tg = lane >> 4, th = (lane >> 3) & 1;
      const unsigned l32 = 8u * tg + tc;
      i32x8_t xb[NS];
      {
        const int e0 = 256 * (tg >> 1) + 32 * tc + 16 * (tg & 1);
        const float* gfp = gffn + e0; asm volatile("" : "+v"(gfp));
        f32x4 gq[8];
#pragma unroll
        for (int q = 0; q < 4; ++q) { gq[2 * q] = *(const f32x4*)(gfp + (q >> 1) * 512 + (q & 1) * 8); gq[2 * q + 1] = *(const f32x4*)(gfp + (q >> 1) * 512 + (q & 1) * 8 + 4); }
#pragma unroll
        for (int s = 0; s < NS; ++s) {
          const bf16_t* hp = HN + (size_t)(base + s) * 1024 + e0;
          const float rs2 = rsqrtf(ss2[base + s] * (1.0f / 1024.f) + 1e-6f) * PX_SCALE;
#pragma unroll
          for (int q = 0; q < 4; ++q) {
            const uint4 h = *(const uint4*)(hp + (q >> 1) * 512 + (q & 1) * 8);
            const float v0 = bflo(h.x) * gq[2 * q][0] * rs2, v1 = bfhi(h.x) * gq[2 * q][1] * rs2, v2 = bflo(h.y) * gq[2 * q][2] * rs2, v3 = bfhi(h.y) * gq[2 * q][3] * rs2;
            const float v4 = bflo(h.z) * gq[2 * q + 1][0] * rs2, v5 = bfhi(h.z) * gq[2 * q + 1][1] * rs2, v6 = bflo(h.w) * gq[2 * q + 1][2] * rs2, v7 = bfhi(h.w) * gq[2 * q + 1][3] * rs2;
            int w0 = 0, w1 = 0;
            w0 = __builtin_amdgcn_cvt_pk_fp8_f32(v0, v1, w0, false); w0 = __builtin_amdgcn_cvt_pk_fp8_f32(v2, v3, w0, true);
            w1 = __builtin_amdgcn_cvt_pk_fp8_f32(v4, v5, w1, false); w1 = __builtin_amdgcn_cvt_pk_fp8_f32(v6, v7, w1, true);
            xb[s][2 * q] = w0; xb[s][2 * q + 1] = w1;
          }
        }
      }
      const bool dg = (lane >> 4) == ((lane >> 2) & 3);
      const f32x2_t m01 = {(dg && (lane & 3) == 0) ? 1.f : 0.f, (dg && (lane & 3) == 1) ? 1.f : 0.f}, m23 = {(dg && (lane & 3) == 2) ? 1.f : 0.f, (dg && (lane & 3) == 3) ? 1.f : 0.f};
      const unsigned lo16 = 16u * l32;
      const unsigned* seh = se + th;
#define U_LOAD(buf, ii) _Pragma("unroll") for (int k = 0; k < 8; ++k) { const unsigned e = seh[(k % NS) * 128 + (ii) + 2 * (k / NS)]; buf[k] = *(const u32x4_t*)(PU8 + ((e << 9) | lo16)); }
#define U_COMP(buf, ii) { float d[8]; \
        _Pragma("unroll") for (int k = 0; k < 8; ++k) { \
          const i32x8_t a = {(int)buf[k][0], (int)buf[k][1], (int)buf[k][2], (int)buf[k][3], 0, 0, 0, 0}; \
          f32x4 acc = {0.f, 0.f, 0.f, 0.f}; \
          acc = __builtin_amdgcn_mfma_scale_f32_16x16x128_f8f6f4(a, xb[k % NS], acc, 4, 0, 0, 0, 0, 0); \
          const f32x2_t t = (f32x2_t){acc[0], acc[1]} * m01 + (f32x2_t){acc[2], acc[3]} * m23; \
          d[k] = t.x + t.y; } \
        const float r1 = treduce_lvl<8, 16>(d, lane);             \
        const int kk = (lane >> 2) & 7; \
        const int pos = (kk % NS) * 128 + (ii) + 2 * (kk / NS) + (lane >> 5); \
        const float wgt = sw[pos] * gelu_tanh(r1 * (1.0f / (PU4_SCALE * PX_SCALE))); \
        const unsigned w8 = (unsigned)__builtin_amdgcn_cvt_pk_fp8_f32(wgt * PW_SCALE, 0.f, 0, false) & 255u; \
        if ((lane & 3) == 0) ((unsigned*)sw)[pos] = w8 * 0x01010101u; }
      u32x4_t ua[8], ub[8];
      U_LOAD(ua, 0)
#pragma unroll 1
      for (int i = 0; i < 128; i += 8) {
        U_LOAD(ub, i + 4)
        __builtin_amdgcn_sched_barrier(0);
        U_COMP(ua, i)
        __builtin_amdgcn_sched_barrier(0);
        const int ni = (i + 8 < 128) ? i + 8 : i;
        U_LOAD(ua, ni)
        __builtin_amdgcn_sched_barrier(0);
        U_COMP(ub, i + 4)
        __builtin_amdgcn_sched_barrier(0);
      }
#undef U_LOAD
#undef U_COMP
    }
    wave_lds_sync();
    f32x16_t acc[NS];
#pragma unroll
    for (int s = 0; s < NS; ++s)
#pragma unroll
      for (int r = 0; r < 16; ++r) acc[s][r] = 0.f;
    {
      const int vn = lane & 31, vg = lane >> 5;
      const bool act = vg == (vn >> 4);
      unsigned M[4];
#pragma unroll
      for (int d = 0; d < 4; ++d) M[d] = (act && d == ((lane & 15) >> 2)) ? (0xFFu << (8 * (lane & 3))) : 0u;
      const unsigned lo16v = 16u * vn;
      const unsigned* sev = se + vg;
      const unsigned* swr = (const unsigned*)sw;
#define V_LOAD(buf, ii) _Pragma("unroll") for (int k = 0; k < 8; ++k) { const unsigned e = sev[(k & 3) * 128 + (ii) + 2 * (k >> 2)]; buf[k] = *(const u32x4_t*)(PV8 + ((e << 9) | lo16v)); }
#define V_COMP(buf, ii) _Pragma("unroll") for (int k = 0; k < 8; ++k) { \
        const unsigned w0 = swr[(k & 3) * 128 + (ii) + 2 * (k >> 2)], w1 = swr[(k & 3) * 128 + (ii) + 2 * (k >> 2) + 1]; \
        const i32x8_t A = {(int)(w0 & M[0]), (int)(w0 & M[1]), (int)(w0 & M[2]), (int)(w0 & M[3]), (int)(w1 & M[0]), (int)(w1 & M[1]), (int)(w1 & M[2]), (int)(w1 & M[3])}; \
        const i32x8_t B = {(int)buf[k][0], (int)buf[k][1], (int)buf[k][2], (int)buf[k][3], 0, 0, 0, 0}; \
        acc[k & 3] = __builtin_amdgcn_mfma_scale_f32_32x32x64_f8f6f4(A, B, acc[k & 3], 0, 4, 0, 0, 0, 0); }
      u32x4_t va[8], vb[8];
      V_LOAD(va, 0)
#pragma unroll 1
      for (int i = 0; i < 128; i += 8) {
        V_LOAD(vb, i + 4)
        __builtin_amdgcn_sched_barrier(0);
        V_COMP(va, i)
        __builtin_amdgcn_sched_barrier(0);
        const int ni = (i + 8 < 128) ? i + 8 : i;
        V_LOAD(va, ni)
        __builtin_amdgcn_sched_barrier(0);
        V_COMP(vb, i + 4)
        __builtin_amdgcn_sched_barrier(0);
      }
#undef V_LOAD
#undef V_COMP
    }
#pragma unroll
    for (int s = 0; s < NS; ++s) {
      {
        const int vn = lane & 31, vg = lane >> 5;
#pragma unroll
        for (int c = 0; c < 4; ++c) *(float4*)(stg + 32 * vn + 8 * c + 4 * vg) = make_float4(acc[s][4 * c], acc[s][4 * c + 1], acc[s][4 * c + 2], acc[s][4 * c + 3]);
      }
      wave_lds_sync();
      float4 o[4];
#pragma unroll
      for (int q = 0; q < 4; ++q) o[q] = *(const float4*)(stg + 16 * lane + 4 * q);
      wave_lds_sync();
      float* hq = Hout + (size_t)(base + s) * 1024 + 16 * lane;
      float4 a[4]; float ss = 0.f;
      const uint4 r0 = *(const uint4*)(HN + (size_t)(base + s) * 1024 + 16 * lane), r1 = *(const uint4*)(HN + (size_t)(base + s) * 1024 + 16 * lane + 8);
      a[0] = make_float4(bflo(r0.x), bfhi(r0.x), bflo(r0.y), bfhi(r0.y)); a[1] = make_float4(bflo(r0.z), bfhi(r0.z), bflo(r0.w), bfhi(r0.w));
      a[2] = make_float4(bflo(r1.x), bfhi(r1.x), bflo(r1.y), bfhi(r1.y)); a[3] = make_float4(bflo(r1.z), bfhi(r1.z), bflo(r1.w), bfhi(r1.w));
      constexpr float osc = 1.0f / (PV4_SCALE * PW_SCALE);
#pragma unroll
      for (int q = 0; q < 4; ++q) {
        a[q].x += o[q].x * osc; a[q].y += o[q].y * osc; a[q].z += o[q].z * osc; a[q].w += o[q].w * osc;
        ss += a[q].x * a[q].x + a[q].y * a[q].y + a[q].z * a[q].z + a[q].w * a[q].w;
      }
      ss = wave_sum(ss);
      const float r = rsqrtf(ss / 1024.f + 1e-6f);
#pragma unroll
      for (int q = 0; q < 4; ++q) {
        const float4 gg = *(const float4*)(gfin + 16 * lane + 4 * q);
        a[q].x *= r * gg.x; a[q].y *= r * gg.y; a[q].z *= r * gg.z; a[q].w *= r * gg.w;
        *(float4*)(hq + 4 * q) = a[q];
      }
    }
    wave_lds_sync();
  }
}

#ifndef GATH_NU
#define GATH_NU 16
#endif
template <int NS, int NB, int NBU>
__device__ void ph_gather18(const bf16_t* __restrict__ HN, const int* __restrict__ EXP, const float* __restrict__ GATE,
                           const unsigned char* __restrict__ PU8, const unsigned char* __restrict__ PV8,
                           const float* __restrict__ gfin, const float* H, float* Hout, unsigned char* lds,
                           const float* __restrict__ ss2, const float* __restrict__ gffn) {
  int tid_ = threadIdx.x; asm volatile("" : "+v"(tid_));
  const int wv = tid_ >> 6, lane = tid_ & 63;
  unsigned* se = (unsigned*)(lds + wv * 8192);
  float* sw = (float*)(lds + wv * 8192 + 2048);
  float* stg = (float*)(lds + wv * 8192 + 4096);
  constexpr int STEP = NB / NS;
  constexpr int LPG = 64 / NB;
  for (int base = (blockIdx.x * NWAVE + wv) * NS; base < NTOK; base += gridDim.x * NWAVE * NS) {
#pragma unroll 1
    for (int s = 0; s < NS; ++s) {
      const int tok = base + s;
      unsigned k0 = ((unsigned)EXP[(size_t)tok * 128 + lane] << 7) | (unsigned)lane;
      unsigned k1 = ((unsigned)EXP[(size_t)tok * 128 + 64 + lane] << 7) | (unsigned)(64 + lane);
      wave_sort128(k0, k1, lane);
      se[s * 128 + lane] = k0 >> 7; se[s * 128 + 64 + lane] = k1 >> 7;
      sw[s * 128 + lane] = GATE[(size_t)tok * 128 + (k0 & 127u)]; sw[s * 128 + 64 + lane] = GATE[(size_t)tok * 128 + (k1 & 127u)];
    }
    wave_lds_sync();
    {
      static_assert(NS == 4, "layout");
      const int tc = lane & 7, tg = lane >> 4, th = (lane >> 3) & 1;
      const unsigned l32 = 8u * tg + tc;
      i32x8_t xb[NS];
      {
        const int e0 = 256 * (tg >> 1) + 32 * tc + 16 * (tg & 1);
        const float* gfp = gffn + e0; asm volatile("" : "+v"(gfp));
        f32x4 gq[8];
#pragma unroll
        for (int q = 0; q < 4; ++q) { gq[2 * q] = *(const f32x4*)(gfp + (q >> 1) * 512 + (q & 1) * 8); gq[2 * q + 1] = *(const f32x4*)(gfp + (q >> 1) * 512 + (q & 1) * 8 + 4); }
#pragma unroll
        for (int s = 0; s < NS; ++s) {
          const bf16_t* hp = HN + (size_t)(base + s) * 1024 + e0;
          const float rs2 = rsqrtf(ss2[base + s] * (1.0f / 1024.f) + 1e-6f) * PX_SCALE;
#pragma unroll
          for (int q = 0; q < 4; ++q) {
            const uint4 h = *(const uint4*)(hp + (q >> 1) * 512 + (q & 1) * 8);
#define XCL(v) __builtin_amdgcn_fmed3f((v), -440.f, 440.f)
            const float v0 = XCL(bflo(h.x) * gq[2 * q][0] * rs2), v1 = XCL(bfhi(h.x) * gq[2 * q][1] * rs2), v2 = XCL(bflo(h.y) * gq[2 * q][2] * rs2), v3 = XCL(bfhi(h.y) * gq[2 * q][3] * rs2);
            const float v4 = XCL(bflo(h.z) * gq[2 * q + 1][0] * rs2), v5 = XCL(bfhi(h.z) * gq[2 * q + 1][1] * rs2), v6 = XCL(bflo(h.w) * gq[2 * q + 1][2] * rs2), v7 = XCL(bfhi(h.w) * gq[2 * q + 1][3] * rs2);
#undef XCL
            int w0 = 0, w1 = 0;
            w0 = __builtin_amdgcn_cvt_pk_fp8_f32(v0, v1, w0, false); w0 = __builtin_amdgcn_cvt_pk_fp8_f32(v2, v3, w0, true);
            w1 = __builtin_amdgcn_cvt_pk_fp8_f32(v4, v5, w1, false); w1 = __builtin_amdgcn_cvt_pk_fp8_f32(v6, v7, w1, true);
            xb[s][2 * q] = w0; xb[s][2 * q + 1] = w1;
          }
        }
      }
      const bool dg = (lane >> 4) == ((lane >> 2) & 3);
      const f32x2_t m01 = {(dg && (lane & 3) == 0) ? 1.f : 0.f, (dg && (lane & 3) == 1) ? 1.f : 0.f}, m23 = {(dg && (lane & 3) == 2) ? 1.f : 0.f, (dg && (lane & 3) == 3) ? 1.f : 0.f};
      const unsigned lo16 = 16u * l32;
      const unsigned* seh = se + th;
#define U_LOAD(buf, ii) _Pragma("unroll") for (int k = 0; k < NU; ++k) { const unsigned e = seh[(k % NS) * 128 + (ii) + 2 * (k / NS)]; buf[k] = *(const u32x4_t*)(PU8 + ((e << 9) | lo16)); }
#define U_COMP(buf, ii) { float d[NU]; \
        _Pragma("unroll") for (int k = 0; k < NU; ++k) { \
          const i32x8_t a = {(int)buf[k][0], (int)buf[k][1], (int)buf[k][2], (int)buf[k][3], 0, 0, 0, 0}; \
          f32x4 acc = {0.f, 0.f, 0.f, 0.f}; \
          acc = __builtin_amdgcn_mfma_scale_f32_16x16x128_f8f6f4(a, xb[k % NS], acc, 4, 0, 0, 0, 0, 0); \
          const f32x2_t t = (f32x2_t){acc[0], acc[1]} * m01 + (f32x2_t){acc[2], acc[3]} * m23; \
          d[k] = t.x + t.y; } \
        const float r1 = treduce_lvl<NU, 16>(d, lane);            \
        const int kk = (lane & 31) / LPGU2; \
        const int pos = (kk % NS) * 128 + (ii) + 2 * (kk / NS) + (lane >> 5); \
        const float wgt = sw[pos] * gelu_tanh(r1 * (1.0f / (PU4_SCALE * PX_SCALE))); \
        const unsigned w8 = (unsigned)__builtin_amdgcn_cvt_pk_fp8_f32(__builtin_amdgcn_fmed3f(wgt * PW_SCALE, -440.f, 440.f), 0.f, 0, false) & 255u; \
        if ((lane % LPGU2) == 0) ((unsigned*)sw)[pos] = w8 * 0x01010101u; }
      constexpr int NU = GATH_NU, LPGU2 = 32 / NU, PSTEP = NU / 2;
      u32x4_t ua[NU], ub[NU];
      U_LOAD(ua, 0)
#pragma unroll 1
      for (int i = 0; i < 128; i += 2 * PSTEP) {
        U_LOAD(ub, i + PSTEP)
        __builtin_amdgcn_sched_barrier(0);
        U_COMP(ua, i)
        __builtin_amdgcn_sched_barrier(0);
        const int ni = (i + 2 * PSTEP < 128) ? i + 2 * PSTEP : i;
        U_LOAD(ua, ni)
        __builtin_amdgcn_sched_barrier(0);
        U_COMP(ub, i + PSTEP)
        __builtin_amdgcn_sched_barrier(0);
      }
#undef U_LOAD
#undef U_COMP
    }
    wave_lds_sync();
    f32x16_t acc[NS];
#pragma unroll
    for (int s = 0; s < NS; ++s)
#pragma unroll
      for (int r = 0; r < 16; ++r) acc[s][r] = 0.f;
    {
      const int vn = lane & 31, vg = lane >> 5;
      const bool act = vg == (vn >> 4);
      unsigned M[4];
#pragma unroll
      for (int d = 0; d < 4; ++d) M[d] = (act && d == ((lane & 15) >> 2)) ? (0xFFu << (8 * (lane & 3))) : 0u;
      const unsigned lo16v = 16u * vn;
      const unsigned* sev = se + vg;
      const unsigned* swr = (const unsigned*)sw;
#define V_LOAD(buf, ii) _Pragma("unroll") for (int k = 0; k < 8; ++k) { const unsigned e = sev[(k & 3) * 128 + (ii) + 2 * (k >> 2)]; buf[k] = *(const u32x4_t*)(PV8 + ((e << 9) | lo16v)); }
#define V_COMP(buf, ii) _Pragma("unroll") for (int k = 0; k < 8; ++k) { \
        const unsigned w0 = swr[(k & 3) * 128 + (ii) + 2 * (k >> 2)], w1 = swr[(k & 3) * 128 + (ii) + 2 * (k >> 2) + 1]; \
        const i32x8_t A = {(int)(w0 & M[0]), (int)(w0 & M[1]), (int)(w0 & M[2]), (int)(w0 & M[3]), (int)(w1 & M[0]), (int)(w1 & M[1]), (int)(w1 & M[2]), (int)(w1 & M[3])}; \
        const i32x8_t B = {(int)buf[k][0], (int)buf[k][1], (int)buf[k][2], (int)buf[k][3], 0, 0, 0, 0}; \
        acc[k & 3] = __builtin_amdgcn_mfma_scale_f32_32x32x64_f8f6f4(A, B, acc[k & 3], 0, 4, 0, 0, 0, 0); }
      u32x4_t va[8], vb[8];
      V_LOAD(va, 0)
#pragma unroll 1
      for (int i = 0; i < 128; i += 8) {
        V_LOAD(vb, i + 4)
        __builtin_amdgcn_sched_barrier(0);
        V_COMP(va, i)
        __builtin_amdgcn_sched_barrier(0);
        const int ni = (i + 8 < 128) ? i + 8 : i;
        V_LOAD(va, ni)
        __builtin_amdgcn_sched_barrier(0);
        V_COMP(vb, i + 4)
        __builtin_amdgcn_sched_barrier(0);
      }
#undef V_LOAD
#undef V_COMP
    }
#pragma unroll
    for (int s = 0; s < NS; ++s) {
      {
        const int vn = lane & 31, vg = lane >> 5;
#pragma unroll
        for (int c = 0; c < 4; ++c) *(float4*)(stg + 32 * vn + 8 * c + 4 * vg) = make_float4(acc[s][4 * c], acc[s][4 * c + 1], acc[s][4 * c + 2], acc[s][4 * c + 3]);
      }
      wave_lds_sync();
      float4 o[4];
#pragma unroll
      for (int q = 0; q < 4; ++q) o[q] = *(const float4*)(stg + 16 * lane + 4 * q);
      wave_lds_sync();
      float* hq = Hout + (size_t)(base + s) * 1024 + 16 * lane;
      float4 a[4]; float ss = 0.f;
      const uint4 r0 = *(const uint4*)(HN + (size_t)(base + s) * 1024 + 16 * lane), r1 = *(const uint4*)(HN + (size_t)(base + s) * 1024 + 16 * lane + 8);
      a[0] = make_float4(bflo(r0.x), bfhi(r0.x), bflo(r0.y), bfhi(r0.y)); a[1] = make_float4(bflo(r0.z), bfhi(r0.z), bflo(r0.w), bfhi(r0.w));
      a[2] = make_float4(bflo(r1.x), bfhi(r1.x), bflo(r1.y), bfhi(r1.y)); a[3] = make_float4(bflo(r1.z), bfhi(r1.z), bflo(r1.w), bfhi(r1.w));
      constexpr float osc = 1.0f / (PV4_SCALE * PW_SCALE);
#pragma unroll
      for (int q = 0; q < 4; ++q) {
        a[q].x += o[q].x * osc; a[q].y += o[q].y * osc; a[q].z += o[q].z * osc; a[q].w += o[q].w * osc;
        ss += a[q].x * a[q].x + a[q].y * a[q].y + a[q].z * a[q].z + a[q].w * a[q].w;
      }
      ss = wave_sum(ss);
      const float r = rsqrtf(ss / 1024.f + 1e-6f);
#pragma unroll
      for (int q = 0; q < 4; ++q) {
        const float4 gg = *(const float4*)(gfin + 16 * lane + 4 * q);
        a[q].x *= r * gg.x; a[q].y *= r * gg.y; a[q].z *= r * gg.z; a[q].w *= r * gg.w;
#ifdef PROBE_CONST
        { const float cst = (float)__hip_atomic_load(DBG_CNT_PTR, __ATOMIC_RELAXED, __HIP_MEMORY_SCOPE_AGENT) * (1.0f / PROBE_CONST); a[q] = make_float4(cst, cst, cst, cst); }
#endif
        *(float4*)(hq + 4 * q) = a[q];
      }
    }
    wave_lds_sync();
  }
}

template <bool DIAG>
__device__ __forceinline__ void attn_block(bf16x8 (&Kf)[4], bf16x8 (&Vf)[2][2], const bf16x8 (&Qf)[4], f32x16& O0, f32x16& O1, float& Rrun,
                                           int qi, int hh, const bf16_t* Kbase, const bf16_t* Vbase, int knext) {
  f32x16 S;
#pragma unroll
  for (int i = 0; i < 16; ++i) S[i] = 0.f;
#pragma unroll
  for (int s = 0; s < 4; ++s) S = __builtin_amdgcn_mfma_f32_32x32x16_bf16(Kf[s], Qf[s], S, 0, 0, 0);
#pragma unroll
  for (int s = 0; s < 4; ++s) Kf[s] = *(const bf16x8*)(Kbase + (size_t)knext * 2048 + 512 * s);
  float beta[16], rp[16];
  float run = 1.f;
#pragma unroll
  for (int i = 15; i >= 0; --i) {
    const float e = __builtin_amdgcn_exp2f(fminf(S[i] * -0.18033688011112042f, 115.4156f));
    const float r = __builtin_amdgcn_rcpf(1.0f + e), er = e * r;
    if (DIAG) {
      const bool vis = 16 * hh + i < qi;
      beta[i] = vis ? r : 0.f;
      rp[i] = run;
      run *= vis ? er : 1.f;
    } else {
      beta[i] = r;
      rp[i] = run;
      run *= er;
    }
  }
  const float Tp = __shfl_xor(run, 32);
  const float off = Rrun * (hh == 0 ? Tp : 1.f);
  Rrun *= run * Tp;
  unsigned pk[8];
#pragma unroll
  for (int i = 0; i < 16; i += 2) pk[i >> 1] = pg8::cvt_pk_bf16(beta[i] * rp[i] * off, beta[i + 1] * rp[i + 1] * off);
  bf16x8 P0, P1;
  { u32x4 t0 = {pk[0], pk[1], pk[2], pk[3]}, t1 = {pk[4], pk[5], pk[6], pk[7]}; P0 = __builtin_bit_cast(bf16x8, t0); P1 = __builtin_bit_cast(bf16x8, t1); }
  O0 = __builtin_amdgcn_mfma_f32_32x32x16_bf16(Vf[0][0], P0, O0, 0, 0, 0);
  O0 = __builtin_amdgcn_mfma_f32_32x32x16_bf16(Vf[0][1], P1, O0, 0, 0, 0);
  O1 = __builtin_amdgcn_mfma_f32_32x32x16_bf16(Vf[1][0], P0, O1, 0, 0, 0);
  O1 = __builtin_amdgcn_mfma_f32_32x32x16_bf16(Vf[1][1], P1, O1, 0, 0, 0);
#pragma unroll
  for (int mb = 0; mb < 2; ++mb)
#pragma unroll
    for (int s2 = 0; s2 < 2; ++s2) Vf[mb][s2] = *(const bf16x8*)(Vbase + (size_t)knext * 2048 + 1024 * mb + 512 * s2);
}
__device__ void ph_attn(const bf16_t* __restrict__ Qfr, const bf16_t* __restrict__ Kfr, const bf16_t* __restrict__ Vfr, const float* __restrict__ ga,
                        bf16_t* __restrict__ MIX, unsigned char* lds) {
  const int h = threadIdx.x >> 6, lane = threadIdx.x & 63, c = lane & 31, hh = lane >> 5;
  float* red = (float*)lds;
  const int kap = 16 * ((c >> 2) & 1) + 4 * (c >> 3) + (c & 3);
  int par = 0;
  for (int unit = blockIdx.x; unit < 512; unit += gridDim.x, par ^= 1) {
    const int b = unit >> 8, ut = unit & 255, qt = (gridDim.x == 256u) ? ((ut & 7) * 32 + (ut >> 3)) : ut, q0 = qt * 32;
    const size_t tb = (size_t)b * SEQ;
    bf16x8 Qf[4];
#pragma unroll
    for (int s = 0; s < 4; ++s) Qf[s] = *(const bf16x8*)(Qfr + (((size_t)(b * 8 + h) * 256 + (q0 >> 5)) * 2048) + 512 * s + 256 * hh + 8 * c);
    f32x16 O0, O1;
#pragma unroll
    for (int i = 0; i < 16; ++i) { O0[i] = 0.f; O1[i] = 0.f; }
    float Rrun = 1.f;
    const bf16_t* Kbase = Kfr + (size_t)(b * 8 + h) * 256 * 2048 + 256 * hh + 8 * c;
    const bf16_t* Vbase = Vfr + (size_t)(b * 8 + h) * 256 * 2048 + 256 * hh + 8 * c;
    bf16x8 KA[4], VA[2][2], KB[4], VB[2][2];
    int kb = q0 >> 5;
    {
      const int k1 = kb > 0 ? kb - 1 : 0;
#pragma unroll
      for (int s = 0; s < 4; ++s) { KA[s] = *(const bf16x8*)(Kbase + (size_t)kb * 2048 + 512 * s); KB[s] = *(const bf16x8*)(Kbase + (size_t)k1 * 2048 + 512 * s); }
#pragma unroll
      for (int mb = 0; mb < 2; ++mb)
#pragma unroll
        for (int s2 = 0; s2 < 2; ++s2) { VA[mb][s2] = *(const bf16x8*)(Vbase + (size_t)kb * 2048 + 1024 * mb + 512 * s2); VB[mb][s2] = *(const bf16x8*)(Vbase + (size_t)k1 * 2048 + 1024 * mb + 512 * s2); }
    }
    attn_block<true>(KA, VA, Qf, O0, O1, Rrun, c, hh, Kbase, Vbase, kb > 1 ? kb - 2 : 0);
    while (!(kb == 0 || __all(Rrun == 0.f))) {
      --kb;
      attn_block<false>(KB, VB, Qf, O0, O1, Rrun, c, hh, Kbase, Vbase, kb > 1 ? kb - 2 : 0);
      if (kb == 0 || __all(Rrun == 0.f)) break;
      --kb;
      attn_block<false>(KA, VA, Qf, O0, O1, Rrun, c, hh, Kbase, Vbase, kb > 1 ? kb - 2 : 0);
    }
    float ss = 0.f;
#pragma unroll
    for (int i = 0; i < 16; ++i) ss += O0[i] * O0[i] + O1[i] * O1[i];
    ss += __shfl_xor(ss, 32);
    if (hh == 0) red[(par * 8 + h) * 32 + c] = ss;
    __syncthreads();
    float tot = 0.f;
#pragma unroll
    for (int k = 0; k < 8; ++k) tot += red[(par * 8 + k) * 32 + c];
    const float rs = rsqrtf(tot * (1.0f / 512.f) + 1e-6f);
    bf16_t* op = MIX + (tb + q0 + c) * 1024 + h * 64 + 4 * hh;
    const float* gp = ga + h * 64 + 4 * hh;
#pragma unroll
    for (int a = 0; a < 4; ++a) {
      const f32x4 g0 = *(const f32x4*)(gp + 8 * a), g1 = *(const f32x4*)(gp + 32 + 8 * a);
      uint2 o0, o1;
      o0.x = pg8::cvt_pk_bf16(O0[4 * a] * rs * g0[0], O0[4 * a + 1] * rs * g0[1]); o0.y = pg8::cvt_pk_bf16(O0[4 * a + 2] * rs * g0[2], O0[4 * a + 3] * rs * g0[3]);
      o1.x = pg8::cvt_pk_bf16(O1[4 * a] * rs * g1[0], O1[4 * a + 1] * rs * g1[1]); o1.y = pg8::cvt_pk_bf16(O1[4 * a + 2] * rs * g1[2], O1[4 * a + 3] * rs * g1[3]);
      *(uint2*)(op + 8 * a) = o0; *(uint2*)(op + 32 + 8 * a) = o1;
    }
  }
  __syncthreads();
}
__device__ void ph_ssmnorm(bf16_t* __restrict__ mix, const float* __restrict__ gs) {
  const int lane = threadIdx.x & 63;
  for (int row = blockIdx.x * NWAVE + (threadIdx.x >> 6); row < NTOK; row += gridDim.x * NWAVE) {
    bf16_t* p = mix + (size_t)row * 1024 + 512 + 8 * lane;
    const uint4 v = *(const uint4*)p;
    float f[8] = {bflo(v.x), bfhi(v.x), bflo(v.y), bfhi(v.y), bflo(v.z), bfhi(v.z), bflo(v.w), bfhi(v.w)};
    float ss = 0.f;
#pragma unroll
    for (int i = 0; i < 8; ++i) ss += f[i] * f[i];
    ss = wave_sum(ss);
    const float r = rsqrtf(ss / 512.f + 1e-6f);
    const float4 g0 = *(const float4*)(gs + 8 * lane), g1 = *(const float4*)(gs + 8 * lane + 4);
    uint4 o;
    o.x = pg8::cvt_pk_bf16(f[0] * r * g0.x, f[1] * r * g0.y); o.y = pg8::cvt_pk_bf16(f[2] * r * g0.z, f[3] * r * g0.w);
    o.z = pg8::cvt_pk_bf16(f[4] * r * g1.x, f[5] * r * g1.y); o.w = pg8::cvt_pk_bf16(f[6] * r * g1.z, f[7] * r * g1.w);
    *(uint4*)p = o;
  }
}

#define XA_ROWB 528
__device__ void ph_xattn(const bf16_t* __restrict__ QX, const bf16_t* __restrict__ KM, const bf16_t* __restrict__ VtM,
                         bf16_t* __restrict__ XO, unsigned char* lds) {
  const int w = threadIdx.x >> 6, lane = threadIdx.x & 63, c = lane & 31, hh = lane >> 5;
  const int kap = 16 * ((c >> 2) & 1) + 4 * (c >> 3) + (c & 3);
  pg8::StaticOrder SO; SO.init(NTOK, 1024, (int)gridDim.x, (int)blockIdx.x);
  pg8::Unit un;
  for (int ui = 0; SO.next(ui, un); ++ui) {
    const int tile = un.pm, h = un.pn, b = tile >> 5;
    const size_t tok = (size_t)tile * 256 + w * 32 + c;
    __syncthreads();
    {
      u32x4 kv[16];
#pragma unroll
      for (int i = 0; i < 16; ++i) { const int ch = threadIdx.x + NTHR * i, row = ch >> 5, c16 = ch & 31; kv[i] = *(const u32x4*)(KM + ((size_t)(b * 256 + row)) * 1024 + h * 256 + c16 * 8); }
      __builtin_amdgcn_sched_barrier(0);
#pragma unroll
      for (int i = 0; i < 16; ++i) { const int ch = threadIdx.x + NTHR * i, row = ch >> 5, c16 = ch & 31; *(u32x4*)(lds + row * XA_ROWB + c16 * 16) = kv[i]; }
    }
    bf16x8 Qf[16];
#pragma unroll
    for (int s = 0; s < 16; ++s) Qf[s] = *(const bf16x8*)(QX + tok * 1024 + h * 256 + 16 * s + 8 * hh);
    __syncthreads();
    f32x16 S[8];
#pragma unroll
    for (int kb = 0; kb < 8; ++kb) {
#pragma unroll
      for (int i = 0; i < 16; ++i) S[kb][i] = 0.f;
#pragma unroll
      for (int s = 0; s < 16; ++s) {
        const bf16x8 kf = *(const bf16x8*)(lds + (32 * kb + kap) * XA_ROWB + (16 * s + 8 * hh) * 2);
        S[kb] = __builtin_amdgcn_mfma_f32_32x32x16_bf16(kf, Qf[s], S[kb], 0, 0, 0);
      }
    }
    float mx = -3.0e38f;
#pragma unroll
    for (int kb = 0; kb < 8; ++kb)
#pragma unroll
      for (int i = 0; i < 16; ++i) mx = fmaxf(mx, S[kb][i]);
    mx = fmaxf(mx, __shfl_xor(mx, 32));
    float sum = 0.f;
    bf16x8 Pf[8][2];
#pragma unroll
    for (int kb = 0; kb < 8; ++kb) {
      unsigned pk[8];
#pragma unroll
      for (int i = 0; i < 16; i += 2) {
        const float p0 = __expf((S[kb][i] - mx) * 0.0625f), p1 = __expf((S[kb][i + 1] - mx) * 0.0625f);
        sum += p0 + p1;
        pk[i >> 1] = pg8::cvt_pk_bf16(p0, p1);
      }
      u32x4 t0 = {pk[0], pk[1], pk[2], pk[3]}, t1 = {pk[4], pk[5], pk[6], pk[7]};
      Pf[kb][0] = __builtin_bit_cast(bf16x8, t0); Pf[kb][1] = __builtin_bit_cast(bf16x8, t1);
    }
    sum += __shfl_xor(sum, 32);
    const float inv = 1.0f / sum;
    __syncthreads();
    {
      u32x4 kv[16];
#pragma unroll
      for (int i = 0; i < 16; ++i) { const int ch = threadIdx.x + NTHR * i, row = ch >> 5, c16 = ch & 31; kv[i] = *(const u32x4*)(VtM + ((size_t)(b * 1024 + h * 256 + row)) * 256 + c16 * 8); }
      __builtin_amdgcn_sched_barrier(0);
#pragma unroll
      for (int i = 0; i < 16; ++i) { const int ch = threadIdx.x + NTHR * i, row = ch >> 5, c16 = ch & 31; *(u32x4*)(lds + row * XA_ROWB + c16 * 16) = kv[i]; }
    }
    __syncthreads();
    bf16_t* op = XO + tok * 1024 + h * 256 + 4 * hh;
#pragma unroll
    for (int mb = 0; mb < 8; ++mb) {
      f32x16 O;
#pragma unroll
      for (int i = 0; i < 16; ++i) O[i] = 0.f;
#pragma unroll
      for (int kb = 0; kb < 8; ++kb)
#pragma unroll
        for (int s2 = 0; s2 < 2; ++s2) {
          const bf16x8 vf = *(const bf16x8*)(lds + (32 * mb + c) * XA_ROWB + (32 * kb + 16 * hh + 8 * s2) * 2);
          O = __builtin_amdgcn_mfma_f32_32x32x16_bf16(vf, Pf[kb][s2], O, 0, 0, 0);
        }
#pragma unroll
      for (int a = 0; a < 4; ++a) {
        uint2 o;
        o.x = pg8::cvt_pk_bf16(O[4 * a] * inv, O[4 * a + 1] * inv); o.y = pg8::cvt_pk_bf16(O[4 * a + 2] * inv, O[4 * a + 3] * inv);
        *(uint2*)(op + 32 * mb + 8 * a) = o;
      }
    }
  }
  __syncthreads();
}
struct GEpiXkv {
  static constexpr bool PERM = true, AFTER_DRAIN = false;
  bf16_t* km; bf16_t* vtm;
  __device__ __forceinline__ void operator()(const f32x4 (&acc)[2][2][4][2], const pg8::Unit& un, int wr, int wc, int fr, int fq) const {
    const int row0 = un.pm * 256 + wr * 64 + fr, col0 = un.pn * 256 + wc * 32 + 8 * fq;
#pragma unroll
    for (int ai = 0; ai < 2; ++ai)
#pragma unroll
      for (int m = 0; m < 4; ++m) {
        const int row = row0 + ai * 128 + m * 16;
#pragma unroll
        for (int bj = 0; bj < 2; ++bj) *(u32x4*)(km + (size_t)row * 1024 + col0 + bj * 128) = pack8(acc[ai][bj][m][0], acc[ai][bj][m][1]);
      }
  }
};
struct GEpiXvT {
  static constexpr bool PERM = true, AFTER_DRAIN = false;
  bf16_t* vtm;
  __device__ __forceinline__ void operator()(const f32x4 (&acc)[2][2][4][2], const pg8::Unit& un, int wr, int wc, int fr, int fq) const {
    const int row0 = un.pm * 256 + wr * 64 + fr, col0 = un.pn * 256 + wc * 32 + 8 * fq;
#pragma unroll
    for (int ai = 0; ai < 2; ++ai)
#pragma unroll
      for (int m = 0; m < 4; ++m) {
        const int vc = row0 + ai * 128 + m * 16;
#pragma unroll
        for (int bj = 0; bj < 2; ++bj) {
          const int cn = col0 + bj * 128, b = cn >> 8, key = cn & 255;
          *(u32x4*)(vtm + ((size_t)(b * 1024 + vc)) * 256 + key) = pack8(acc[ai][bj][m][0], acc[ai][bj][m][1]);
        }
      }
  }
};


__device__ __forceinline__ float pkid(float v, unsigned id, unsigned mask) { return __uint_as_float((__float_as_uint(v) & ~mask) | id); }
__device__ __forceinline__ void sort16_desc(float (&v)[16]) {
  float hi, lo;
  hi = fmaxf(v[0], v[1]); lo = fminf(v[0], v[1]); v[0] = hi; v[1] = lo;
  hi = fmaxf(v[2], v[3]); lo = fminf(v[2], v[3]); v[2] = lo; v[3] = hi;
  hi = fmaxf(v[4], v[5]); lo = fminf(v[4], v[5]); v[4] = hi; v[5] = lo;
  hi = fmaxf(v[6], v[7]); lo = fminf(v[6], v[7]); v[6] = lo; v[7] = hi;
  hi = fmaxf(v[8], v[9]); lo = fminf(v[8], v[9]); v[8] = hi; v[9] = lo;
  hi = fmaxf(v[10], v[11]); lo = fminf(v[10], v[11]); v[10] = lo; v[11] = hi;
  hi = fmaxf(v[12], v[13]); lo = fminf(v[12], v[13]); v[12] = hi; v[13] = lo;
  hi = fmaxf(v[14], v[15]); lo = fminf(v[14], v[15]); v[14] = lo; v[15] = hi;
  hi = fmaxf(v[0], v[2]); lo = fminf(v[0], v[2]); v[0] = hi; v[2] = lo;
  hi = fmaxf(v[1], v[3]); lo = fminf(v[1], v[3]); v[1] = hi; v[3] = lo;
  hi = fmaxf(v[4], v[6]); lo = fminf(v[4], v[6]); v[4] = lo; v[6] = hi;
  hi = fmaxf(v[5], v[7]); lo = fminf(v[5], v[7]); v[5] = lo; v[7] = hi;
  hi = fmaxf(v[8], v[10]); lo = fminf(v[8], v[10]); v[8] = hi; v[10] = lo;
  hi = fmaxf(v[9], v[11]); lo = fminf(v[9], v[11]); v[9] = hi; v[11] = lo;
  hi = fmaxf(v[12], v[14]); lo = fminf(v[12], v[14]); v[12] = lo; v[14] = hi;
  hi = fmaxf(v[13], v[15]); lo = fminf(v[13], v[15]); v[13] = lo; v[15] = hi;
  hi = fmaxf(v[0], v[1]); lo = fminf(v[0], v[1]); v[0] = hi; v[1] = lo;
  hi = fmaxf(v[2], v[3]); lo = fminf(v[2], v[3]); v[2] = hi; v[3] = lo;
  hi = fmaxf(v[4], v[5]); lo = fminf(v[4], v[5]); v[4] = lo; v[5] = hi;
  hi = fmaxf(v[6], v[7]); lo = fminf(v[6], v[7]); v[6] = lo; v[7] = hi;
  hi = fmaxf(v[8], v[9]); lo = fminf(v[8], v[9]); v[8] = hi; v[9] = lo;
  hi = fmaxf(v[10], v[11]); lo = fminf(v[10], v[11]); v[10] = hi; v[11] = lo;
  hi = fmaxf(v[12], v[13]); lo = fminf(v[12], v[13]); v[12] = lo; v[13] = hi;
  hi = fmaxf(v[14], v[15]); lo = fminf(v[14], v[15]); v[14] = lo; v[15] = hi;
  hi = fmaxf(v[0], v[4]); lo = fminf(v[0], v[4]); v[0] = hi; v[4] = lo;
  hi = fmaxf(v[1], v[5]); lo = fminf(v[1], v[5]); v[1] = hi; v[5] = lo;
  hi = fmaxf(v[2], v[6]); lo = fminf(v[2], v[6]); v[2] = hi; v[6] = lo;
  hi = fmaxf(v[3], v[7]); lo = fminf(v[3], v[7]); v[3] = hi; v[7] = lo;
  hi = fmaxf(v[8], v[12]); lo = fminf(v[8], v[12]); v[8] = lo; v[12] = hi;
  hi = fmaxf(v[9], v[13]); lo = fminf(v[9], v[13]); v[9] = lo; v[13] = hi;
  hi = fmaxf(v[10], v[14]); lo = fminf(v[10], v[14]); v[10] = lo; v[14] = hi;
  hi = fmaxf(v[11], v[15]); lo = fminf(v[11], v[15]); v[11] = lo; v[15] = hi;
  hi = fmaxf(v[0], v[2]); lo = fminf(v[0], v[2]); v[0] = hi; v[2] = lo;
  hi = fmaxf(v[1], v[3]); lo = fminf(v[1], v[3]); v[1] = hi; v[3] = lo;
  hi = fmaxf(v[4], v[6]); lo = fminf(v[4], v[6]); v[4] = hi; v[6] = lo;
  hi = fmaxf(v[5], v[7]); lo = fminf(v[5], v[7]); v[5] = hi; v[7] = lo;
  hi = fmaxf(v[8], v[10]); lo = fminf(v[8], v[10]); v[8] = lo; v[10] = hi;
  hi = fmaxf(v[9], v[11]); lo = fminf(v[9], v[11]); v[9] = lo; v[11] = hi;
  hi = fmaxf(v[12], v[14]); lo = fminf(v[12], v[14]); v[12] = lo; v[14] = hi;
  hi = fmaxf(v[13], v[15]); lo = fminf(v[13], v[15]); v[13] = lo; v[15] = hi;
  hi = fmaxf(v[0], v[1]); lo = fminf(v[0], v[1]); v[0] = hi; v[1] = lo;
  hi = fmaxf(v[2], v[3]); lo = fminf(v[2], v[3]); v[2] = hi; v[3] = lo;
  hi = fmaxf(v[4], v[5]); lo = fminf(v[4], v[5]); v[4] = hi; v[5] = lo;
  hi = fmaxf(v[6], v[7]); lo = fminf(v[6], v[7]); v[6] = hi; v[7] = lo;
  hi = fmaxf(v[8], v[9]); lo = fminf(v[8], v[9]); v[8] = lo; v[9] = hi;
  hi = fmaxf(v[10], v[11]); lo = fminf(v[10], v[11]); v[10] = lo; v[11] = hi;
  hi = fmaxf(v[12], v[13]); lo = fminf(v[12], v[13]); v[12] = lo; v[13] = hi;
  hi = fmaxf(v[14], v[15]); lo = fminf(v[14], v[15]); v[14] = lo; v[15] = hi;
  hi = fmaxf(v[0], v[8]); lo = fminf(v[0], v[8]); v[0] = hi; v[8] = lo;
  hi = fmaxf(v[1], v[9]); lo = fminf(v[1], v[9]); v[1] = hi; v[9] = lo;
  hi = fmaxf(v[2], v[10]); lo = fminf(v[2], v[10]); v[2] = hi; v[10] = lo;
  hi = fmaxf(v[3], v[11]); lo = fminf(v[3], v[11]); v[3] = hi; v[11] = lo;
  hi = fmaxf(v[4], v[12]); lo = fminf(v[4], v[12]); v[4] = hi; v[12] = lo;
  hi = fmaxf(v[5], v[13]); lo = fminf(v[5], v[13]); v[5] = hi; v[13] = lo;
  hi = fmaxf(v[6], v[14]); lo = fminf(v[6], v[14]); v[6] = hi; v[14] = lo;
  hi = fmaxf(v[7], v[15]); lo = fminf(v[7], v[15]); v[7] = hi; v[15] = lo;
  hi = fmaxf(v[0], v[4]); lo = fminf(v[0], v[4]); v[0] = hi; v[4] = lo;
  hi = fmaxf(v[1], v[5]); lo = fminf(v[1], v[5]); v[1] = hi; v[5] = lo;
  hi = fmaxf(v[2], v[6]); lo = fminf(v[2], v[6]); v[2] = hi; v[6] = lo;
  hi = fmaxf(v[3], v[7]); lo = fminf(v[3], v[7]); v[3] = hi; v[7] = lo;
  hi = fmaxf(v[8], v[12]); lo = fminf(v[8], v[12]); v[8] = hi; v[12] = lo;
  hi = fmaxf(v[9], v[13]); lo = fminf(v[9], v[13]); v[9] = hi; v[13] = lo;
  hi = fmaxf(v[10], v[14]); lo = fminf(v[10], v[14]); v[10] = hi; v[14] = lo;
  hi = fmaxf(v[11], v[15]); lo = fminf(v[11], v[15]); v[11] = hi; v[15] = lo;
  hi = fmaxf(v[0], v[2]); lo = fminf(v[0], v[2]); v[0] = hi; v[2] = lo;
  hi = fmaxf(v[1], v[3]); lo = fminf(v[1], v[3]); v[1] = hi; v[3] = lo;
  hi = fmaxf(v[4], v[6]); lo = fminf(v[4], v[6]); v[4] = hi; v[6] = lo;
  hi = fmaxf(v[5], v[7]); lo = fminf(v[5], v[7]); v[5] = hi; v[7] = lo;
  hi = fmaxf(v[8], v[10]); lo = fminf(v[8], v[10]); v[8] = hi; v[10] = lo;
  hi = fmaxf(v[9], v[11]); lo = fminf(v[9], v[11]); v[9] = hi; v[11] = lo;
  hi = fmaxf(v[12], v[14]); lo = fminf(v[12], v[14]); v[12] = hi; v[14] = lo;
  hi = fmaxf(v[13], v[15]); lo = fminf(v[13], v[15]); v[13] = hi; v[15] = lo;
  hi = fmaxf(v[0], v[1]); lo = fminf(v[0], v[1]); v[0] = hi; v[1] = lo;
  hi = fmaxf(v[2], v[3]); lo = fminf(v[2], v[3]); v[2] = hi; v[3] = lo;
  hi = fmaxf(v[4], v[5]); lo = fminf(v[4], v[5]); v[4] = hi; v[5] = lo;
  hi = fmaxf(v[6], v[7]); lo = fminf(v[6], v[7]); v[6] = hi; v[7] = lo;
  hi = fmaxf(v[8], v[9]); lo = fminf(v[8], v[9]); v[8] = hi; v[9] = lo;
  hi = fmaxf(v[10], v[11]); lo = fminf(v[10], v[11]); v[10] = hi; v[11] = lo;
  hi = fmaxf(v[12], v[13]); lo = fminf(v[12], v[13]); v[12] = hi; v[13] = lo;
  hi = fmaxf(v[14], v[15]); lo = fminf(v[14], v[15]); v[14] = hi; v[15] = lo;
}
__device__ __forceinline__ void sort32_desc(float (&v)[32]) {
  float hi, lo;
  hi = fmaxf(v[0], v[1]); lo = fminf(v[0], v[1]); v[0] = hi; v[1] = lo;
  hi = fmaxf(v[2], v[3]); lo = fminf(v[2], v[3]); v[2] = lo; v[3] = hi;
  hi = fmaxf(v[4], v[5]); lo = fminf(v[4], v[5]); v[4] = hi; v[5] = lo;
  hi = fmaxf(v[6], v[7]); lo = fminf(v[6], v[7]); v[6] = lo; v[7] = hi;
  hi = fmaxf(v[8], v[9]); lo = fminf(v[8], v[9]); v[8] = hi; v[9] = lo;
  hi = fmaxf(v[10], v[11]); lo = fminf(v[10], v[11]); v[10] = lo; v[11] = hi;
  hi = fmaxf(v[12], v[13]); lo = fminf(v[12], v[13]); v[12] = hi; v[13] = lo;
  hi = fmaxf(v[14], v[15]); lo = fminf(v[14], v[15]); v[14] = lo; v[15] = hi;
  hi = fmaxf(v[16], v[17]); lo = fminf(v[16], v[17]); v[16] = hi; v[17] = lo;
  hi = fmaxf(v[18], v[19]); lo = fminf(v[18], v[19]); v[18] = lo; v[19] = hi;
  hi = fmaxf(v[20], v[21]); lo = fminf(v[20], v[21]); v[20] = hi; v[21] = lo;
  hi = fmaxf(v[22], v[23]); lo = fminf(v[22], v[23]); v[22] = lo; v[23] = hi;
  hi = fmaxf(v[24], v[25]); lo = fminf(v[24], v[25]); v[24] = hi; v[25] = lo;
  hi = fmaxf(v[26], v[27]); lo = fminf(v[26], v[27]); v[26] = lo; v[27] = hi;
  hi = fmaxf(v[28], v[29]); lo = fminf(v[28], v[29]); v[28] = hi; v[29] = lo;
  hi = fmaxf(v[30], v[31]); lo = fminf(v[30], v[31]); v[30] = lo; v[31] = hi;
  hi = fmaxf(v[0], v[2]); lo = fminf(v[0], v[2]); v[0] = hi; v[2] = lo;
  hi = fmaxf(v[1], v[3]); lo = fminf(v[1], v[3]); v[1] = hi; v[3] = lo;
  hi = fmaxf(v[4], v[6]); lo = fminf(v[4], v[6]); v[4] = lo; v[6] = hi;
  hi = fmaxf(v[5], v[7]); lo = fminf(v[5], v[7]); v[5] = lo; v[7] = hi;
  hi = fmaxf(v[8], v[10]); lo = fminf(v[8], v[10]); v[8] = hi; v[10] = lo;
  hi = fmaxf(v[9], v[11]); lo = fminf(v[9], v[11]); v[9] = hi; v[11] = lo;
  hi = fmaxf(v[12], v[14]); lo = fminf(v[12], v[14]); v[12] = lo; v[14] = hi;
  hi = fmaxf(v[13], v[15]); lo = fminf(v[13], v[15]); v[13] = lo; v[15] = hi;
  hi = fmaxf(v[16], v[18]); lo = fminf(v[16], v[18]); v[16] = hi; v[18] = lo;
  hi = fmaxf(v[17], v[19]); lo = fminf(v[17], v[19]); v[17] = hi; v[19] = lo;
  hi = fmaxf(v[20], v[22]); lo = fminf(v[20], v[22]); v[20] = lo; v[22] = hi;
  hi = fmaxf(v[21], v[23]); lo = fminf(v[21], v[23]); v[21] = lo; v[23] = hi;
  hi = fmaxf(v[24], v[26]); lo = fminf(v[24], v[26]); v[24] = hi; v[26] = lo;
  hi = fmaxf(v[25], v[27]); lo = fminf(v[25], v[27]); v[25] = hi; v[27] = lo;
  hi = fmaxf(v[28], v[30]); lo = fminf(v[28], v[30]); v[28] = lo; v[30] = hi;
  hi = fmaxf(v[29], v[31]); lo = fminf(v[29], v[31]); v[29] = lo; v[31] = hi;
  hi = fmaxf(v[0], v[1]); lo = fminf(v[0], v[1]); v[0] = hi; v[1] = lo;
  hi = fmaxf(v[2], v[3]); lo = fminf(v[2], v[3]); v[2] = hi; v[3] = lo;
  hi = fmaxf(v[4], v[5]); lo = fminf(v[4], v[5]); v[4] = lo; v[5] = hi;
  hi = fmaxf(v[6], v[7]); lo = fminf(v[6], v[7]); v[6] = lo; v[7] = hi;
  hi = fmaxf(v[8], v[9]); lo = fminf(v[8], v[9]); v[8] = hi; v[9] = lo;
  hi = fmaxf(v[10], v[11]); lo = fminf(v[10], v[11]); v[10] = hi; v[11] = lo;
  hi = fmaxf(v[12], v[13]); lo = fminf(v[12], v[13]); v[12] = lo; v[13] = hi;
  hi = fmaxf(v[14], v[15]); lo = fminf(v[14], v[15]); v[14] = lo; v[15] = hi;
  hi = fmaxf(v[16], v[17]); lo = fminf(v[16], v[17]); v[16] = hi; v[17] = lo;
  hi = fmaxf(v[18], v[19]); lo = fminf(v[18], v[19]); v[18] = hi; v[19] = lo;
  hi = fmaxf(v[20], v[21]); lo = fminf(v[20], v[21]); v[20] = lo; v[21] = hi;
  hi = fmaxf(v[22], v[23]); lo = fminf(v[22], v[23]); v[22] = lo; v[23] = hi;
  hi = fmaxf(v[24], v[25]); lo = fminf(v[24], v[25]); v[24] = hi; v[25] = lo;
  hi = fmaxf(v[26], v[27]); lo = fminf(v[26], v[27]); v[26] = hi; v[27] = lo;
  hi = fmaxf(v[28], v[29]); lo = fminf(v[28], v[29]); v[28] = lo; v[29] = hi;
  hi = fmaxf(v[30], v[31]); lo = fminf(v[30], v[31]); v[30] = lo; v[31] = hi;
  hi = fmaxf(v[0], v[4]); lo = fminf(v[0], v[4]); v[0] = hi; v[4] = lo;
  hi = fmaxf(v[1], v[5]); lo = fminf(v[1], v[5]); v[1] = hi; v[5] = lo;
  hi = fmaxf(v[2], v[6]); lo = fminf(v[2], v[6]); v[2] = hi; v[6] = lo;
  hi = fmaxf(v[3], v[7]); lo = fminf(v[3], v[7]); v[3] = hi; v[7] = lo;
  hi = fmaxf(v[8], v[12]); lo = fminf(v[8], v[12]); v[8] = lo; v[12] = hi;
  hi = fmaxf(v[9], v[13]); lo = fminf(v[9], v[13]); v[9] = lo; v[13] = hi;
  hi = fmaxf(v[10], v[14]); lo = fminf(v[10], v[14]); v[10] = lo; v[14] = hi;
  hi = fmaxf(v[11], v[15]); lo = fminf(v[11], v[15]); v[11] = lo; v[15] = hi;
  hi = fmaxf(v[16], v[20]); lo = fminf(v[16], v[20]); v[16] = hi; v[20] = lo;
  hi = fmaxf(v[17], v[21]); lo = fminf(v[17], v[21]); v[17] = hi; v[21] = lo;
  hi = fmaxf(v[18], v[22]); lo = fminf(v[18], v[22]); v[18] = hi; v[22] = lo;
  hi = fmaxf(v[19], v[23]); lo = fminf(v[19], v[23]); v[19] = hi; v[23] = lo;
  hi = fmaxf(v[24], v[28]); lo = fminf(v[24], v[28]); v[24] = lo; v[28] = hi;
  hi = fmaxf(v[25], v[29]); lo = fminf(v[25], v[29]); v[25] = lo; v[29] = hi;
  hi = fmaxf(v[26], v[30]); lo = fminf(v[26], v[30]); v[26] = lo; v[30] = hi;
  hi = fmaxf(v[27], v[31]); lo = fminf(v[27], v[31]); v[27] = lo; v[31] = hi;
  hi = fmaxf(v[0], v[2]); lo = fminf(v[0], v[2]); v[0] = hi; v[2] = lo;
  hi = fmaxf(v[1], v[3]); lo = fminf(v[1], v[3]); v[1] = hi; v[3] = lo;
  hi = fmaxf(v[4], v[6]); lo = fminf(v[4], v[6]); v[4] = hi; v[6] = lo;
  hi = fmaxf(v[5], v[7]); lo = fminf(v[5], v[7]); v[5] = hi; v[7] = lo;
  hi = fmaxf(v[8], v[10]); lo = fminf(v[8], v[10]); v[8] = lo; v[10] = hi;
  hi = fmaxf(v[9], v[11]); lo = fminf(v[9], v[11]); v[9] = lo; v[11] = hi;
  hi = fmaxf(v[12], v[14]); lo = fminf(v[12], v[14]); v[12] = lo; v[14] = hi;
  hi = fmaxf(v[13], v[15]); lo = fminf(v[13], v[15]); v[13] = lo; v[15] = hi;
  hi = fmaxf(v[16], v[18]); lo = fminf(v[16], v[18]); v[16] = hi; v[18] = lo;
  hi = fmaxf(v[17], v[19]); lo = fminf(v[17], v[19]); v[17] = hi; v[19] = lo;
  hi = fmaxf(v[20], v[22]); lo = fminf(v[20], v[22]); v[20] = hi; v[22] = lo;
  hi = fmaxf(v[21], v[23]); lo = fminf(v[21], v[23]); v[21] = hi; v[23] = lo;
  hi = fmaxf(v[24], v[26]); lo = fminf(v[24], v[26]); v[24] = lo; v[26] = hi;
  hi = fmaxf(v[25], v[27]); lo = fminf(v[25], v[27]); v[25] = lo; v[27] = hi;
  hi = fmaxf(v[28], v[30]); lo = fminf(v[28], v[30]); v[28] = lo; v[30] = hi;
  hi = fmaxf(v[29], v[31]); lo = fminf(v[29], v[31]); v[29] = lo; v[31] = hi;
  hi = fmaxf(v[0], v[1]); lo = fminf(v[0], v[1]); v[0] = hi; v[1] = lo;
  hi = fmaxf(v[2], v[3]); lo = fminf(v[2], v[3]); v[2] = hi; v[3] = lo;
  hi = fmaxf(v[4], v[5]); lo = fminf(v[4], v[5]); v[4] = hi; v[5] = lo;
  hi = fmaxf(v[6], v[7]); lo = fminf(v[6], v[7]); v[6] = hi; v[7] = lo;
  hi = fmaxf(v[8], v[9]); lo = fminf(v[8], v[9]); v[8] = lo; v[9] = hi;
  hi = fmaxf(v[10], v[11]); lo = fminf(v[10], v[11]); v[10] = lo; v[11] = hi;
  hi = fmaxf(v[12], v[13]); lo = fminf(v[12], v[13]); v[12] = lo; v[13] = hi;
  hi = fmaxf(v[14], v[15]); lo = fminf(v[14], v[15]); v[14] = lo; v[15] = hi;
  hi = fmaxf(v[16], v[17]); lo = fminf(v[16], v[17]); v[16] = hi; v[17] = lo;
  hi = fmaxf(v[18], v[19]); lo = fminf(v[18], v[19]); v[18] = hi; v[19] = lo;
  hi = fmaxf(v[20], v[21]); lo = fminf(v[20], v[21]); v[20] = hi; v[21] = lo;
  hi = fmaxf(v[22], v[23]); lo = fminf(v[22], v[23]); v[22] = hi; v[23] = lo;
  hi = fmaxf(v[24], v[25]); lo = fminf(v[24], v[25]); v[24] = lo; v[25] = hi;
  hi = fmaxf(v[26], v[27]); lo = fminf(v[26], v[27]); v[26] = lo; v[27] = hi;
  hi = fmaxf(v[28], v[29]); lo = fminf(v[28], v[29]); v[28] = lo; v[29] = hi;
  hi = fmaxf(v[30], v[31]); lo = fminf(v[30], v[31]); v[30] = lo; v[31] = hi;
  hi = fmaxf(v[0], v[8]); lo = fminf(v[0], v[8]); v[0] = hi; v[8] = lo;
  hi = fmaxf(v[1], v[9]); lo = fminf(v[1], v[9]); v[1] = hi; v[9] = lo;
  hi = fmaxf(v[2], v[10]); lo = fminf(v[2], v[10]); v[2] = hi; v[10] = lo;
  hi = fmaxf(v[3], v[11]); lo = fminf(v[3], v[11]); v[3] = hi; v[11] = lo;
  hi = fmaxf(v[4], v[12]); lo = fminf(v[4], v[12]); v[4] = hi; v[12] = lo;
  hi = fmaxf(v[5], v[13]); lo = fminf(v[5], v[13]); v[5] = hi; v[13] = lo;
  hi = fmaxf(v[6], v[14]); lo = fminf(v[6], v[14]); v[6] = hi; v[14] = lo;
  hi = fmaxf(v[7], v[15]); lo = fminf(v[7], v[15]); v[7] = hi; v[15] = lo;
  hi = fmaxf(v[16], v[24]); lo = fminf(v[16], v[24]); v[16] = lo; v[24] = hi;
  hi = fmaxf(v[17], v[25]); lo = fminf(v[17], v[25]); v[17] = lo; v[25] = hi;
  hi = fmaxf(v[18], v[26]); lo = fminf(v[18], v[26]); v[18] = lo; v[26] = hi;
  hi = fmaxf(v[19], v[27]); lo = fminf(v[19], v[27]); v[19] = lo; v[27] = hi;
  hi = fmaxf(v[20], v[28]); lo = fminf(v[20], v[28]); v[20] = lo; v[28] = hi;
  hi = fmaxf(v[21], v[29]); lo = fminf(v[21], v[29]); v[21] = lo; v[29] = hi;
  hi = fmaxf(v[22], v[30]); lo = fminf(v[22], v[30]); v[22] = lo; v[30] = hi;
  hi = fmaxf(v[23], v[31]); lo = fminf(v[23], v[31]); v[23] = lo; v[31] = hi;
  hi = fmaxf(v[0], v[4]); lo = fminf(v[0], v[4]); v[0] = hi; v[4] = lo;
  hi = fmaxf(v[1], v[5]); lo = fminf(v[1], v[5]); v[1] = hi; v[5] = lo;
  hi = fmaxf(v[2], v[6]); lo = fminf(v[2], v[6]); v[2] = hi; v[6] = lo;
  hi = fmaxf(v[3], v[7]); lo = fminf(v[3], v[7]); v[3] = hi; v[7] = lo;
  hi = fmaxf(v[8], v[12]); lo = fminf(v[8], v[12]); v[8] = hi; v[12] = lo;
  hi = fmaxf(v[9], v[13]); lo = fminf(v[9], v[13]); v[9] = hi; v[13] = lo;
  hi = fmaxf(v[10], v[14]); lo = fminf(v[10], v[14]); v[10] = hi; v[14] = lo;
  hi = fmaxf(v[11], v[15]); lo = fminf(v[11], v[15]); v[11] = hi; v[15] = lo;
  hi = fmaxf(v[16], v[20]); lo = fminf(v[16], v[20]); v[16] = lo; v[20] = hi;
  hi = fmaxf(v[17], v[21]); lo = fminf(v[17], v[21]); v[17] = lo; v[21] = hi;
  hi = fmaxf(v[18], v[22]); lo = fminf(v[18], v[22]); v[18] = lo; v[22] = hi;
  hi = fmaxf(v[19], v[23]); lo = fminf(v[19], v[23]); v[19] = lo; v[23] = hi;
  hi = fmaxf(v[24], v[28]); lo = fminf(v[24], v[28]); v[24] = lo; v[28] = hi;
  hi = fmaxf(v[25], v[29]); lo = fminf(v[25], v[29]); v[25] = lo; v[29] = hi;
  hi = fmaxf(v[26], v[30]); lo = fminf(v[26], v[30]); v[26] = lo; v[30] = hi;
  hi = fmaxf(v[27], v[31]); lo = fminf(v[27], v[31]); v[27] = lo; v[31] = hi;
  hi = fmaxf(v[0], v[2]); lo = fminf(v[0], v[2]); v[0] = hi; v[2] = lo;
  hi = fmaxf(v[1], v[3]); lo = fminf(v[1], v[3]); v[1] = hi; v[3] = lo;
  hi = fmaxf(v[4], v[6]); lo = fminf(v[4], v[6]); v[4] = hi; v[6] = lo;
  hi = fmaxf(v[5], v[7]); lo = fminf(v[5], v[7]); v[5] = hi; v[7] = lo;
  hi = fmaxf(v[8], v[10]); lo = fminf(v[8], v[10]); v[8] = hi; v[10] = lo;
  hi = fmaxf(v[9], v[11]); lo = fminf(v[9], v[11]); v[9] = hi; v[11] = lo;
  hi = fmaxf(v[12], v[14]); lo = fminf(v[12], v[14]); v[12] = hi; v[14] = lo;
  hi = fmaxf(v[13], v[15]); lo = fminf(v[13], v[15]); v[13] = hi; v[15] = lo;
  hi = fmaxf(v[16], v[18]); lo = fminf(v[16], v[18]); v[16] = lo; v[18] = hi;
  hi = fmaxf(v[17], v[19]); lo = fminf(v[17], v[19]); v[17] = lo; v[19] = hi;
  hi = fmaxf(v[20], v[22]); lo = fminf(v[20], v[22]); v[20] = lo; v[22] = hi;
  hi = fmaxf(v[21], v[23]); lo = fminf(v[21], v[23]); v[21] = lo; v[23] = hi;
  hi = fmaxf(v[24], v[26]); lo = fminf(v[24], v[26]); v[24] = lo; v[26] = hi;
  hi = fmaxf(v[25], v[27]); lo = fminf(v[25], v[27]); v[25] = lo; v[27] = hi;
  hi = fmaxf(v[28], v[30]); lo = fminf(v[28], v[30]); v[28] = lo; v[30] = hi;
  hi = fmaxf(v[29], v[31]); lo = fminf(v[29], v[31]); v[29] = lo; v[31] = hi;
  hi = fmaxf(v[0], v[1]); lo = fminf(v[0], v[1]); v[0] = hi; v[1] = lo;
  hi = fmaxf(v[2], v[3]); lo = fminf(v[2], v[3]); v[2] = hi; v[3] = lo;
  hi = fmaxf(v[4], v[5]); lo = fminf(v[4], v[5]); v[4] = hi; v[5] = lo;
  hi = fmaxf(v[6], v[7]); lo = fminf(v[6], v[7]); v[6] = hi; v[7] = lo;
  hi = fmaxf(v[8], v[9]); lo = fminf(v[8], v[9]); v[8] = hi; v[9] = lo;
  hi = fmaxf(v[10], v[11]); lo = fminf(v[10], v[11]); v[10] = hi; v[11] = lo;
  hi = fmaxf(v[12], v[13]); lo = fminf(v[12], v[13]); v[12] = hi; v[13] = lo;
  hi = fmaxf(v[14], v[15]); lo = fminf(v[14], v[15]); v[14] = hi; v[15] = lo;
  hi = fmaxf(v[16], v[17]); lo = fminf(v[16], v[17]); v[16] = lo; v[17] = hi;
  hi = fmaxf(v[18], v[19]); lo = fminf(v[18], v[19]); v[18] = lo; v[19] = hi;
  hi = fmaxf(v[20], v[21]); lo = fminf(v[20], v[21]); v[20] = lo; v[21] = hi;
  hi = fmaxf(v[22], v[23]); lo = fminf(v[22], v[23]); v[22] = lo; v[23] = hi;
  hi = fmaxf(v[24], v[25]); lo = fminf(v[24], v[25]); v[24] = lo; v[25] = hi;
  hi = fmaxf(v[26], v[27]); lo = fminf(v[26], v[27]); v[26] = lo; v[27] = hi;
  hi = fmaxf(v[28], v[29]); lo = fminf(v[28], v[29]); v[28] = lo; v[29] = hi;
  hi = fmaxf(v[30], v[31]); lo = fminf(v[30], v[31]); v[30] = lo; v[31] = hi;
  hi = fmaxf(v[0], v[16]); lo = fminf(v[0], v[16]); v[0] = hi; v[16] = lo;
  hi = fmaxf(v[1], v[17]); lo = fminf(v[1], v[17]); v[1] = hi; v[17] = lo;
  hi = fmaxf(v[2], v[18]); lo = fminf(v[2], v[18]); v[2] = hi; v[18] = lo;
  hi = fmaxf(v[3], v[19]); lo = fminf(v[3], v[19]); v[3] = hi; v[19] = lo;
  hi = fmaxf(v[4], v[20]); lo = fminf(v[4], v[20]); v[4] = hi; v[20] = lo;
  hi = fmaxf(v[5], v[21]); lo = fminf(v[5], v[21]); v[5] = hi; v[21] = lo;
  hi = fmaxf(v[6], v[22]); lo = fminf(v[6], v[22]); v[6] = hi; v[22] = lo;
  hi = fmaxf(v[7], v[23]); lo = fminf(v[7], v[23]); v[7] = hi; v[23] = lo;
  hi = fmaxf(v[8], v[24]); lo = fminf(v[8], v[24]); v[8] = hi; v[24] = lo;
  hi = fmaxf(v[9], v[25]); lo = fminf(v[9], v[25]); v[9] = hi; v[25] = lo;
  hi = fmaxf(v[10], v[26]); lo = fminf(v[10], v[26]); v[10] = hi; v[26] = lo;
  hi = fmaxf(v[11], v[27]); lo = fminf(v[11], v[27]); v[11] = hi; v[27] = lo;
  hi = fmaxf(v[12], v[28]); lo = fminf(v[12], v[28]); v[12] = hi; v[28] = lo;
  hi = fmaxf(v[13], v[29]); lo = fminf(v[13], v[29]); v[13] = hi; v[29] = lo;
  hi = fmaxf(v[14], v[30]); lo = fminf(v[14], v[30]); v[14] = hi; v[30] = lo;
  hi = fmaxf(v[15], v[31]); lo = fminf(v[15], v[31]); v[15] = hi; v[31] = lo;
  hi = fmaxf(v[0], v[8]); lo = fminf(v[0], v[8]); v[0] = hi; v[8] = lo;
  hi = fmaxf(v[1], v[9]); lo = fminf(v[1], v[9]); v[1] = hi; v[9] = lo;
  hi = fmaxf(v[2], v[10]); lo = fminf(v[2], v[10]); v[2] = hi; v[10] = lo;
  hi = fmaxf(v[3], v[11]); lo = fminf(v[3], v[11]); v[3] = hi; v[11] = lo;
  hi = fmaxf(v[4], v[12]); lo = fminf(v[4], v[12]); v[4] = hi; v[12] = lo;
  hi = fmaxf(v[5], v[13]); lo = fminf(v[5], v[13]); v[5] = hi; v[13] = lo;
  hi = fmaxf(v[6], v[14]); lo = fminf(v[6], v[14]); v[6] = hi; v[14] = lo;
  hi = fmaxf(v[7], v[15]); lo = fminf(v[7], v[15]); v[7] = hi; v[15] = lo;
  hi = fmaxf(v[16], v[24]); lo = fminf(v[16], v[24]); v[16] = hi; v[24] = lo;
  hi = fmaxf(v[17], v[25]); lo = fminf(v[17], v[25]); v[17] = hi; v[25] = lo;
  hi = fmaxf(v[18], v[26]); lo = fminf(v[18], v[26]); v[18] = hi; v[26] = lo;
  hi = fmaxf(v[19], v[27]); lo = fminf(v[19], v[27]); v[19] = hi; v[27] = lo;
  hi = fmaxf(v[20], v[28]); lo = fminf(v[20], v[28]); v[20] = hi; v[28] = lo;
  hi = fmaxf(v[21], v[29]); lo = fminf(v[21], v[29]); v[21] = hi; v[29] = lo;
  hi = fmaxf(v[22], v[30]); lo = fminf(v[22], v[30]); v[22] = hi; v[30] = lo;
  hi = fmaxf(v[23], v[31]); lo = fminf(v[23], v[31]); v[23] = hi; v[31] = lo;
  hi = fmaxf(v[0], v[4]); lo = fminf(v[0], v[4]); v[0] = hi; v[4] = lo;
  hi = fmaxf(v[1], v[5]); lo = fminf(v[1], v[5]); v[1] = hi; v[5] = lo;
  hi = fmaxf(v[2], v[6]); lo = fminf(v[2], v[6]); v[2] = hi; v[6] = lo;
  hi = fmaxf(v[3], v[7]); lo = fminf(v[3], v[7]); v[3] = hi; v[7] = lo;
  hi = fmaxf(v[8], v[12]); lo = fminf(v[8], v[12]); v[8] = hi; v[12] = lo;
  hi = fmaxf(v[9], v[13]); lo = fminf(v[9], v[13]); v[9] = hi; v[13] = lo;
  hi = fmaxf(v[10], v[14]); lo = fminf(v[10], v[14]); v[10] = hi; v[14] = lo;
  hi = fmaxf(v[11], v[15]); lo = fminf(v[11], v[15]); v[11] = hi; v[15] = lo;
  hi = fmaxf(v[16], v[20]); lo = fminf(v[16], v[20]); v[16] = hi; v[20] = lo;
  hi = fmaxf(v[17], v[21]); lo = fminf(v[17], v[21]); v[17] = hi; v[21] = lo;
  hi = fmaxf(v[18], v[22]); lo = fminf(v[18], v[22]); v[18] = hi; v[22] = lo;
  hi = fmaxf(v[19], v[23]); lo = fminf(v[19], v[23]); v[19] = hi; v[23] = lo;
  hi = fmaxf(v[24], v[28]); lo = fminf(v[24], v[28]); v[24] = hi; v[28] = lo;
  hi = fmaxf(v[25], v[29]); lo = fminf(v[25], v[29]); v[25] = hi; v[29] = lo;
  hi = fmaxf(v[26], v[30]); lo = fminf(v[26], v[30]); v[26] = hi; v[30] = lo;
  hi = fmaxf(v[27], v[31]); lo = fminf(v[27], v[31]); v[27] = hi; v[31] = lo;
  hi = fmaxf(v[0], v[2]); lo = fminf(v[0], v[2]); v[0] = hi; v[2] = lo;
  hi = fmaxf(v[1], v[3]); lo = fminf(v[1], v[3]); v[1] = hi; v[3] = lo;
  hi = fmaxf(v[4], v[6]); lo = fminf(v[4], v[6]); v[4] = hi; v[6] = lo;
  hi = fmaxf(v[5], v[7]); lo = fminf(v[5], v[7]); v[5] = hi; v[7] = lo;
  hi = fmaxf(v[8], v[10]); lo = fminf(v[8], v[10]); v[8] = hi; v[10] = lo;
  hi = fmaxf(v[9], v[11]); lo = fminf(v[9], v[11]); v[9] = hi; v[11] = lo;
  hi = fmaxf(v[12], v[14]); lo = fminf(v[12], v[14]); v[12] = hi; v[14] = lo;
  hi = fmaxf(v[13], v[15]); lo = fminf(v[13], v[15]); v[13] = hi; v[15] = lo;
  hi = fmaxf(v[16], v[18]); lo = fminf(v[16], v[18]); v[16] = hi; v[18] = lo;
  hi = fmaxf(v[17], v[19]); lo = fminf(v[17], v[19]); v[17] = hi; v[19] = lo;
  hi = fmaxf(v[20], v[22]); lo = fminf(v[20], v[22]); v[20] = hi; v[22] = lo;
  hi = fmaxf(v[21], v[23]); lo = fminf(v[21], v[23]); v[21] = hi; v[23] = lo;
  hi = fmaxf(v[24], v[26]); lo = fminf(v[24], v[26]); v[24] = hi; v[26] = lo;
  hi = fmaxf(v[25], v[27]); lo = fminf(v[25], v[27]); v[25] = hi; v[27] = lo;
  hi = fmaxf(v[28], v[30]); lo = fminf(v[28], v[30]); v[28] = hi; v[30] = lo;
  hi = fmaxf(v[29], v[31]); lo = fminf(v[29], v[31]); v[29] = hi; v[31] = lo;
  hi = fmaxf(v[0], v[1]); lo = fminf(v[0], v[1]); v[0] = hi; v[1] = lo;
  hi = fmaxf(v[2], v[3]); lo = fminf(v[2], v[3]); v[2] = hi; v[3] = lo;
  hi = fmaxf(v[4], v[5]); lo = fminf(v[4], v[5]); v[4] = hi; v[5] = lo;
  hi = fmaxf(v[6], v[7]); lo = fminf(v[6], v[7]); v[6] = hi; v[7] = lo;
  hi = fmaxf(v[8], v[9]); lo = fminf(v[8], v[9]); v[8] = hi; v[9] = lo;
  hi = fmaxf(v[10], v[11]); lo = fminf(v[10], v[11]); v[10] = hi; v[11] = lo;
  hi = fmaxf(v[12], v[13]); lo = fminf(v[12], v[13]); v[12] = hi; v[13] = lo;
  hi = fmaxf(v[14], v[15]); lo = fminf(v[14], v[15]); v[14] = hi; v[15] = lo;
  hi = fmaxf(v[16], v[17]); lo = fminf(v[16], v[17]); v[16] = hi; v[17] = lo;
  hi = fmaxf(v[18], v[19]); lo = fminf(v[18], v[19]); v[18] = hi; v[19] = lo;
  hi = fmaxf(v[20], v[21]); lo = fminf(v[20], v[21]); v[20] = hi; v[21] = lo;
  hi = fmaxf(v[22], v[23]); lo = fminf(v[22], v[23]); v[22] = hi; v[23] = lo;
  hi = fmaxf(v[24], v[25]); lo = fminf(v[24], v[25]); v[24] = hi; v[25] = lo;
  hi = fmaxf(v[26], v[27]); lo = fminf(v[26], v[27]); v[26] = hi; v[27] = lo;
  hi = fmaxf(v[28], v[29]); lo = fminf(v[28], v[29]); v[28] = hi; v[29] = lo;
  hi = fmaxf(v[30], v[31]); lo = fminf(v[30], v[31]); v[30] = hi; v[31] = lo;
}
__device__ __forceinline__ void bmerge16_desc(float (&v)[16]) {
  float hi, lo;
  hi = fmaxf(v[0], v[8]); lo = fminf(v[0], v[8]); v[0] = hi; v[8] = lo;
  hi = fmaxf(v[1], v[9]); lo = fminf(v[1], v[9]); v[1] = hi; v[9] = lo;
  hi = fmaxf(v[2], v[10]); lo = fminf(v[2], v[10]); v[2] = hi; v[10] = lo;
  hi = fmaxf(v[3], v[11]); lo = fminf(v[3], v[11]); v[3] = hi; v[11] = lo;
  hi = fmaxf(v[4], v[12]); lo = fminf(v[4], v[12]); v[4] = hi; v[12] = lo;
  hi = fmaxf(v[5], v[13]); lo = fminf(v[5], v[13]); v[5] = hi; v[13] = lo;
  hi = fmaxf(v[6], v[14]); lo = fminf(v[6], v[14]); v[6] = hi; v[14] = lo;
  hi = fmaxf(v[7], v[15]); lo = fminf(v[7], v[15]); v[7] = hi; v[15] = lo;
  hi = fmaxf(v[0], v[4]); lo = fminf(v[0], v[4]); v[0] = hi; v[4] = lo;
  hi = fmaxf(v[1], v[5]); lo = fminf(v[1], v[5]); v[1] = hi; v[5] = lo;
  hi = fmaxf(v[2], v[6]); lo = fminf(v[2], v[6]); v[2] = hi; v[6] = lo;
  hi = fmaxf(v[3], v[7]); lo = fminf(v[3], v[7]); v[3] = hi; v[7] = lo;
  hi = fmaxf(v[8], v[12]); lo = fminf(v[8], v[12]); v[8] = hi; v[12] = lo;
  hi = fmaxf(v[9], v[13]); lo = fminf(v[9], v[13]); v[9] = hi; v[13] = lo;
  hi = fmaxf(v[10], v[14]); lo = fminf(v[10], v[14]); v[10] = hi; v[14] = lo;
  hi = fmaxf(v[11], v[15]); lo = fminf(v[11], v[15]); v[11] = hi; v[15] = lo;
  hi = fmaxf(v[0], v[2]); lo = fminf(v[0], v[2]); v[0] = hi; v[2] = lo;
  hi = fmaxf(v[1], v[3]); lo = fminf(v[1], v[3]); v[1] = hi; v[3] = lo;
  hi = fmaxf(v[4], v[6]); lo = fminf(v[4], v[6]); v[4] = hi; v[6] = lo;
  hi = fmaxf(v[5], v[7]); lo = fminf(v[5], v[7]); v[5] = hi; v[7] = lo;
  hi = fmaxf(v[8], v[10]); lo = fminf(v[8], v[10]); v[8] = hi; v[10] = lo;
  hi = fmaxf(v[9], v[11]); lo = fminf(v[9], v[11]); v[9] = hi; v[11] = lo;
  hi = fmaxf(v[12], v[14]); lo = fminf(v[12], v[14]); v[12] = hi; v[14] = lo;
  hi = fmaxf(v[13], v[15]); lo = fminf(v[13], v[15]); v[13] = hi; v[15] = lo;
  hi = fmaxf(v[0], v[1]); lo = fminf(v[0], v[1]); v[0] = hi; v[1] = lo;
  hi = fmaxf(v[2], v[3]); lo = fminf(v[2], v[3]); v[2] = hi; v[3] = lo;
  hi = fmaxf(v[4], v[5]); lo = fminf(v[4], v[5]); v[4] = hi; v[5] = lo;
  hi = fmaxf(v[6], v[7]); lo = fminf(v[6], v[7]); v[6] = hi; v[7] = lo;
  hi = fmaxf(v[8], v[9]); lo = fminf(v[8], v[9]); v[8] = hi; v[9] = lo;
  hi = fmaxf(v[10], v[11]); lo = fminf(v[10], v[11]); v[10] = hi; v[11] = lo;
  hi = fmaxf(v[12], v[13]); lo = fminf(v[12], v[13]); v[12] = hi; v[13] = lo;
  hi = fmaxf(v[14], v[15]); lo = fminf(v[14], v[15]); v[14] = hi; v[15] = lo;
}
__device__ __forceinline__ void merge_top16(float (&a)[16], const float (&b)[16]) {
#pragma unroll
  for (int i = 0; i < 16; ++i) a[i] = fmaxf(a[i], b[15 - i]);
  bmerge16_desc(a);
}
__device__ __forceinline__ void partner_merge16(float (&a)[16]) {
  float b[16];
#pragma unroll
  for (int i = 0; i < 16; ++i) b[i] = __shfl_xor(a[i], 32);
  merge_top16(a, b);
}
#define RT_KROWB 272
__device__ __forceinline__ void route_half(const bf16_t* __restrict__ PQ, const unsigned char* klds, size_t tok, int hd, int half, int c, int hh, float (&out)[16]) {
  bf16x8 Qf[8];
#pragma unroll
  for (int s = 0; s < 8; ++s) Qf[s] = *(const bf16x8*)(PQ + tok * 2048 + hd * 256 + half * 128 + 16 * s + 8 * hh);
  const unsigned char* kb0 = klds + (size_t)(half * 128 + c) * RT_KROWB + 16 * hh;
  float T[16];
#pragma unroll
  for (int i = 0; i < 16; ++i) T[i] = -3.0e38f;
#pragma unroll 1
  for (int kb = 0; kb < 4; ++kb) {
    f32x16 S;
#pragma unroll
    for (int i = 0; i < 16; ++i) S[i] = 0.f;
#pragma unroll
    for (int s = 0; s < 8; ++s) {
      const bf16x8 kf = *(const bf16x8*)(kb0 + (size_t)(32 * kb) * RT_KROWB + 32 * s);
      S = __builtin_amdgcn_mfma_f32_32x32x16_bf16(kf, Qf[s], S, 0, 0, 0);
    }
    float L[16];
#pragma unroll
    for (int i = 0; i < 16; ++i) L[i] = pkid(S[i], (unsigned)(32 * kb + (i & 3) + 8 * (i >> 2) + 4 * hh), 127u);
    sort16_desc(L);
    merge_top16(T, L);
  }
  partner_merge16(T);
#pragma unroll
  for (int i = 0; i < 16; ++i) out[i] = T[i];
}
__device__ void ph_route(const bf16_t* __restrict__ PQ, const bf16_t* __restrict__ SKb, int* __restrict__ EXP, float* __restrict__ GATE, unsigned char* lds) {
  const int w = threadIdx.x >> 6, lane = threadIdx.x & 63, c = lane & 31, hh = lane >> 5;
  unsigned char* klds = lds;
  unsigned* tab = (unsigned*)(lds + 2 * 128 * RT_KROWB) + w * (32 * 33);
  pg8::StaticOrder SO; SO.init(NTOK, 2048, (int)gridDim.x, (int)blockIdx.x);
  pg8::Unit un;
  for (int ui = 0; SO.next(ui, un); ++ui) {
    {
      const int hd = un.pn;
      __syncthreads();
      {
        pg8::u32x4 kv[8];
#pragma unroll
        for (int i = 0; i < 8; ++i) { const int ch = threadIdx.x + NTHR * i, row = ch >> 4, c16 = ch & 15; kv[i] = *(const pg8::u32x4*)(SKb + ((size_t)hd * 256 + row) * 128 + c16 * 8); }
        __builtin_amdgcn_sched_barrier(0);
#pragma unroll
        for (int i = 0; i < 8; ++i) { const int ch = threadIdx.x + NTHR * i, row = ch >> 4, c16 = ch & 15; *(pg8::u32x4*)(klds + row * RT_KROWB + c16 * 16) = kv[i]; }
      }
      __syncthreads();
      const size_t tok = (size_t)un.pm * 256 + w * 32 + c;
      float A[16], B[16];
      route_half(PQ, klds, tok, hd, 0, c, hh, A);
      route_half(PQ, klds, tok, hd, 1, c, hh, B);
      wave_lds_sync();
#pragma unroll
      for (int i = 0; i < 16; ++i) { tab[c * 33 + i] = __float_as_uint(A[i]) & 127u; tab[c * 33 + 16 + i] = __float_as_uint(B[i]) & 127u; }
      float cd[32];
    cd[0] = pkid(hh ? A[0] + B[1] : A[0] + B[0], hh ? 1u : 0u, 255u);
    cd[1] = pkid(hh ? A[0] + B[3] : A[0] + B[2], hh ? 3u : 2u, 255u);
    cd[2] = pkid(hh ? A[0] + B[5] : A[0] + B[4], hh ? 5u : 4u, 255u);
    cd[3] = pkid(hh ? A[0] + B[7] : A[0] + B[6], hh ? 7u : 6u, 255u);
    cd[4] = pkid(hh ? A[0] + B[9] : A[0] + B[8], hh ? 9u : 8u, 255u);
    cd[5] = pkid(hh ? A[0] + B[11] : A[0] + B[10], hh ? 11u : 10u, 255u);
    cd[6] = pkid(hh ? A[0] + B[13] : A[0] + B[12], hh ? 13u : 12u, 255u);
    cd[7] = pkid(hh ? A[0] + B[15] : A[0] + B[14], hh ? 15u : 14u, 255u);
    cd[8] = pkid(hh ? A[1] + B[1] : A[1] + B[0], hh ? 17u : 16u, 255u);
    cd[9] = pkid(hh ? A[1] + B[3] : A[1] + B[2], hh ? 19u : 18u, 255u);
    cd[10] = pkid(hh ? A[1] + B[5] : A[1] + B[4], hh ? 21u : 20u, 255u);
    cd[11] = pkid(hh ? A[1] + B[7] : A[1] + B[6], hh ? 23u : 22u, 255u);
    cd[12] = pkid(hh ? A[2] + B[1] : A[2] + B[0], hh ? 33u : 32u, 255u);
    cd[13] = pkid(hh ? A[2] + B[3] : A[2] + B[2], hh ? 35u : 34u, 255u);
    cd[14] = pkid(hh ? A[3] + B[0] : A[2] + B[4], hh ? 48u : 36u, 255u);
    cd[15] = pkid(hh ? A[3] + B[2] : A[3] + B[1], hh ? 50u : 49u, 255u);
    cd[16] = pkid(hh ? A[4] + B[0] : A[3] + B[3], hh ? 64u : 51u, 255u);
    cd[17] = pkid(hh ? A[4] + B[2] : A[4] + B[1], hh ? 66u : 65u, 255u);
    cd[18] = pkid(hh ? A[5] + B[1] : A[5] + B[0], hh ? 81u : 80u, 255u);
    cd[19] = pkid(hh ? A[6] + B[1] : A[6] + B[0], hh ? 97u : 96u, 255u);
    cd[20] = pkid(hh ? A[7] + B[1] : A[7] + B[0], hh ? 113u : 112u, 255u);
    cd[21] = pkid(hh ? A[9] + B[0] : A[8] + B[0], hh ? 144u : 128u, 255u);
    cd[22] = pkid(hh ? A[11] + B[0] : A[10] + B[0], hh ? 176u : 160u, 255u);
    cd[23] = pkid(hh ? A[13] + B[0] : A[12] + B[0], hh ? 208u : 192u, 255u);
    cd[24] = pkid(hh ? A[15] + B[0] : A[14] + B[0], hh ? 240u : 224u, 255u);
#pragma unroll
      for (int k = 25; k < 32; ++k) cd[k] = -3.0e38f;
      sort32_desc(cd);
      float F[16];
#pragma unroll
      for (int i = 0; i < 16; ++i) F[i] = cd[i];
      partner_merge16(F);
      wave_lds_sync();
      float ex[16], sum = 0.f;
#pragma unroll
      for (int i = 0; i < 16; ++i) { ex[i] = __expf(F[i] - F[0]); sum += ex[i]; }
      const float inv = 1.0f / sum;
      int eo[8]; float go[8];
#pragma unroll
      for (int j = 0; j < 8; ++j) {
        float fa = F[j], fb = F[8 + j], ea = ex[j], eb = ex[8 + j];
        asm volatile("" : "+v"(fa), "+v"(fb), "+v"(ea), "+v"(eb));
        const float f = hh ? fb : fa;
        const unsigned cid = __float_as_uint(f) & 255u;
        const unsigned i1 = tab[c * 33 + (cid >> 4)], i2 = tab[c * 33 + 16 + (cid & 15u)];
        eo[j] = (int)(i1 * 128u + i2);
        go[j] = (hh ? eb : ea) * inv;
      }
      int* ep = EXP + tok * 128 + hd * 16 + 8 * hh; float* gp = GATE + tok * 128 + hd * 16 + 8 * hh;
      *(int4*)ep = make_int4(eo[0], eo[1], eo[2], eo[3]); *(int4*)(ep + 4) = make_int4(eo[4], eo[5], eo[6], eo[7]);
      *(float4*)gp = make_float4(go[0], go[1], go[2], go[3]); *(float4*)(gp + 4) = make_float4(go[4], go[5], go[6], go[7]);
    }
  }
}

#ifndef XCDMASK
#define XCDMASK 0xffffffffu
#endif
#ifndef R_PREP
#define R_PREP 1
#endif
#ifndef R_GEMM
#define R_GEMM 1
#endif
#ifndef R_ATT
#define R_ATT 1
#endif
#ifndef R_SSM
#define R_SSM 1
#endif
#ifndef R_XAT
#define R_XAT 1
#endif
#ifndef R_RTE
#define R_RTE 1
#endif
#ifndef R_NORM
#define R_NORM 1
#endif
#ifndef R_BAR
#define R_BAR 0
#endif
#ifndef DBG_STAGE
#define DBG_STAGE 0
#endif
#ifndef R_GATH
#define R_GATH 1
#endif
#define LDS_BYTES 163840
#ifndef FIRST_SEAM_XCD
#define FIRST_SEAM_XCD 1
#endif
#ifndef STAG_INP
#define STAG_INP 0
#endif
#ifndef STAG_PQ
#define STAG_PQ 0
#endif
#ifndef R_INP
#define R_INP 1
#endif
#ifndef R_XQ
#define R_XQ 1
#endif
#ifndef R_PQ
#define R_PQ 1
#endif
#ifndef LATE_PREP
#define LATE_PREP 1
#endif
#ifndef LATE_W
#define LATE_W 1
#endif
#ifndef LATE_UF
#define LATE_UF 0
#endif
#ifndef LATE_VF
#define LATE_VF 8
#endif
#ifndef GATH_NS
#define GATH_NS 4
#endif
#ifndef GATH_NBU
#define GATH_NBU 16
#endif
#ifndef GATH_NB
#define GATH_NB 16
#endif
__device__ __forceinline__ SsmC make_ssmc() {
  SsmC SC; char* b = (char*)KP(I_ws) + (size_t)O_SC * 1048576;
  SC.lam = (float2*)b; SC.lamL = (float2*)(b + 16384); SC.Bbar = (bf16_t*)(b + 32768); SC.CmT = (bf16_t*)(b + 32768 + 131072);
  SC.E = (float2*)(b + 1048576); return SC;
}
__device__ __forceinline__ void grid_seam(int k, cg::grid_group& grid, unsigned char* lds) {
  if ((XCDMASK >> k) & 1u) {
    XcdBarrier xb; xb.bar = WSP(unsigned, O_BAR); xb.x = xb_xcc_id(); xb.st = (volatile LAS unsigned*)(lds + LDS_BYTES - 16);
    xcd_barrier(xb);
  } else grid.sync();
}
#define SEAM(k) grid_seam(k, grid, lds)


#define DBG_DUMP_BF16(stage, OFF) if (DBG_STAGE == (stage)) { const bf16_t* s_ = WSP(bf16_t, OFF); float* o_ = (float*)KP(I_H); \
    for (size_t i_ = (size_t)bid * NTHR + threadIdx.x; i_ < (size_t)NTOK * 1024; i_ += (size_t)gridDim.x * NTHR) o_[i_] = bf2f(s_[i_]); return; }

#define DBG_DUMP_HALF(stage, OFF, LD, COL0) if (DBG_STAGE == (stage)) { const bf16_t* s_ = WSP(bf16_t, OFF); float* o_ = (float*)KP(I_H); \
    for (size_t i_ = (size_t)bid * NTHR + threadIdx.x; i_ < (size_t)NTOK * 1024; i_ += (size_t)gridDim.x * NTHR) { const size_t r_ = i_ >> 10, c_ = i_ & 511; o_[i_] = bf2f(s_[r_ * (LD) + (COL0) + c_]); } return; }

#define DBG_DUMP_CYC(stage, PTR, NELEM) if (DBG_STAGE == (stage)) { const bf16_t* s_ = (PTR); float* o_ = (float*)KP(I_H); \
    for (size_t i_ = (size_t)bid * NTHR + threadIdx.x; i_ < (size_t)NTOK * 1024; i_ += (size_t)gridDim.x * NTHR) o_[i_] = bf2f(s_[i_ % (size_t)(NELEM)]); return; }
__global__ void __launch_bounds__(NTHR) fwd_megakernel(Params P) {
  cg::grid_group grid = cg::this_grid();
  extern __shared__ __attribute__((aligned(16))) unsigned char lds[];
  const int bid = blockIdx.x;
  {
    volatile LAS unsigned* xb_st = (volatile LAS unsigned*)(lds + LDS_BYTES - 16);
    if (threadIdx.x == 0) { xb_st[0] = 0u; xb_st[1] = 0u; }
    __syncthreads();
#if FIRST_SEAM_XCD
    if (threadIdx.x == 0) (void)xb_add(&WSP(unsigned, O_BAR)[XB_XCNT(xb_xcc_id())], 1u);
#else
    if (bid == 0) { unsigned* bw = WSP(unsigned, O_BAR); for (int i = threadIdx.x; i < XCD_BAR_WORDS; i += NTHR) bw[i] = 0u; }
#endif
  }
#ifdef PROBE_MFMA4
  if (bid == 0 && threadIdx.x < 64) { const unsigned c = probe_mfma4(lds); if (threadIdx.x == 0) __hip_atomic_store(DBG_CNT_PTR, c, __ATOMIC_RELAXED, __HIP_MEMORY_SCOPE_AGENT); }
  __syncthreads();
#endif
  for (int rep = 0; rep < R_PREP; ++rep) {
    prep_weights<0>(lds, bid, (int)gridDim.x);
    { float* z = SS1_PTR; for (int i = bid * NTHR + threadIdx.x; i < 3 * NTOK + 4096; i += gridDim.x * NTHR) z[i] = 0.f; }
    prep_rmsnorm(KP(I_x), KP(I_g_mix), WSP(bf16_t, O_XN), NTOK);
    prep_rmsnorm(KP(I_mem), KP(I_g_mem), WSP(bf16_t, O_MEMN), 512);
    { SsmIn si{KP(I_a_re), KP(I_a_im), KP(I_log_dt), KP(I_b_re), KP(I_b_im), KP(I_c_re), KP(I_c_im)}; prep_ssm(si, make_ssmc()); }
    prep_cvt_bf16(KP(I_sub_keys), WSP(bf16_t, O_SKB), (size_t)262144);
    { const size_t nlate = (LATE_PREP && gridDim.x > 144u) ? (size_t)LATE_UF * 2048 * 1024 : 0;
      prep_cvt_fp4(KP(I_peer_u), WSP(unsigned char, O_PU8), (size_t)16384 * 1024 - nlate, PU4_SCALE, bid, (int)gridDim.x); }
    if (!(LATE_W && LATE_PREP && gridDim.x > 144u)) prep_weights<1>(lds, bid, (int)gridDim.x);
    { const size_t nlate = (LATE_PREP && gridDim.x > 144u) ? (size_t)LATE_VF * 2048 * 1024 : 0;
      prep_cvt_fp4(KP(I_peer_v), WSP(unsigned char, O_PV8), (size_t)16384 * 1024 - nlate, PV4_SCALE, bid, (int)gridDim.x); }
    if (rep + 1 < R_PREP) grid.sync();
  }
#if FIRST_SEAM_XCD
  if (gridDim.x == 0x7fffffffu) grid.sync();
  SEAM(14);
#else
  grid.sync();
  if (threadIdx.x == 0) (void)xb_add(&WSP(unsigned, O_BAR)[XB_XCNT(xb_xcc_id())], 1u);
#endif
  for (int rep = 0; rep < R_GEMM * R_INP; ++rep) {
#if STAG_INP > 0
    if ((bid >> 3) & 1) { const unsigned long long t0_ = __builtin_amdgcn_s_memrealtime(); while (__builtin_amdgcn_s_memrealtime() - t0_ < (unsigned long long)STAG_INP * 100ull) __builtin_amdgcn_s_sleep(8); }
#endif
    run_gemm(lds, WSP(bf16_t, O_XN), WSP(bf16_t, O_WIN), NTOK, 1536, 1024, bid, GEpiInProj{WSP(bf16_t, O_QK), WSP(bf16_t, O_QK + 16), WSP(bf16_t, O_VT), WSP(bf16_t, O_U16)});
    { const int cv = (gridDim.x >= 256u) ? (int)bid - 128 : (int)bid;
      if (cv >= 0) run_gemm(lds, WSP(bf16_t, O_WIN) + (size_t)1536 * 1024, WSP(bf16_t, O_XN), 512, NTOK, 1024, cv, GEpiVT{WSP(bf16_t, O_VT)}); }
    SEAM(0);
  }
  DBG_DUMP_BF16(1, O_QK)
  DBG_DUMP_CYC(20, WSP(bf16_t, O_WGLU), 262144)
  DBG_DUMP_CYC(21, WSP(bf16_t, O_WOUT), 1048576)
  DBG_DUMP_CYC(22, WSP(bf16_t, O_MEMN), 524288)
  for (int rep = 0; rep < R_ATT; ++rep) {
    ph_attn(WSP(bf16_t, O_QK), WSP(bf16_t, O_QK + 16), WSP(bf16_t, O_VT), KP(I_g_attn_out), WSP(bf16_t, O_MIX), lds);
    if (rep + 1 < R_ATT) SEAM(1);
  }
  for (int rep = 0; rep < R_SSM; ++rep) {
    ph_ssm<false>(KP(I_d_skip), WSP(bf16_t, O_U16), make_ssmc(), WSP(bf16_t, O_Y), lds);
    SEAM(1);
    ph_ssm<true>(KP(I_d_skip), WSP(bf16_t, O_U16), make_ssmc(), WSP(bf16_t, O_Y), lds);
    SEAM(2);
  }
#if defined(DBG_DELAY) && DBG_DELAY > 0
  { const unsigned long long t0_ = __builtin_amdgcn_s_memrealtime(); while (__builtin_amdgcn_s_memrealtime() - t0_ < (unsigned long long)DBG_DELAY * 100ull) __builtin_amdgcn_s_sleep(32); }
  SEAM(2);
#endif
  DBG_DUMP_HALF(2, O_MIX, 1024, 0)
  DBG_DUMP_HALF(3, O_Y, 512, 0)
  DBG_DUMP_HALF(13, O_U16, 512, 0)
  for (int rep = 0; rep < R_GEMM; ++rep) {
#if defined(DBG_INV) && DBG_INV == 1
    asm volatile("buffer_inv sc0 sc1\n\ts_waitcnt vmcnt(0)" ::: "memory"); __syncthreads();
#endif
#if defined(DBG_GLU_A) && DBG_GLU_A == 1
    run_gemm(lds, WSP(bf16_t, O_XN), WSP(bf16_t, O_WGLU), NTOK, 512, 512, bid, GEpiGlu{WSP(bf16_t, O_Y), KP(I_b_glu), WSP(bf16_t, O_MIX)});
#elif defined(DBG_GLU_A) && DBG_GLU_A == 3
    run_gemm(lds, WSP(bf16_t, O_U16), WSP(bf16_t, O_WGLU), NTOK, 512, 512, bid, GEpiGlu{WSP(bf16_t, O_Y), KP(I_b_glu), WSP(bf16_t, O_MIX)});
#elif defined(DBG_GLU_A) && DBG_GLU_A == 2
    run_gemm(lds, WSP(bf16_t, O_Y), WSP(bf16_t, O_WIN), NTOK, 512, 512, bid, GEpiGlu{WSP(bf16_t, O_Y), KP(I_b_glu), WSP(bf16_t, O_MIX)});
#else
    run_gemm_nc(lds, WSP(bf16_t, O_Y), WSP(bf16_t, O_WGLU), NTOK, 512, 512, bid, GEpiGluN{WSP(bf16_t, O_Y), KP(I_b_glu), WSP(bf16_t, O_MIX), KP(I_g_ssm_out), SS3_PTR, CNT3_PTR});
#endif
    if (bid >= 128 && bid < 136) run_gemm(lds, WSP(bf16_t, O_MEMN), WSP(bf16_t, O_WXKV), 512, 1024, 1024, bid - 128, GEpiXkv{WSP(bf16_t, O_KM), WSP(bf16_t, O_VTM)});
    if (bid >= 136 && bid < 144) run_gemm(lds, WSP(bf16_t, O_WXKV) + (size_t)1024 * 1024, WSP(bf16_t, O_MEMN), 1024, 512, 1024, bid - 136, GEpiXvT{WSP(bf16_t, O_VTM)});
    if (LATE_PREP && gridDim.x > 144u && bid >= 144) {
      if (LATE_W) prep_weights<1>(lds, bid - 144, (int)gridDim.x - 144);
      if (LATE_UF > 0) { const size_t nlate = (size_t)LATE_UF * 2048 * 1024, n0 = (size_t)16384 * 1024 - nlate;
        prep_cvt_fp4(KP(I_peer_u) + n0, WSP(unsigned char, O_PU8) + n0 / 2, nlate, PU4_SCALE, bid - 144, (int)gridDim.x - 144); }
      if (LATE_VF > 0) { const size_t nlate = (size_t)LATE_VF * 2048 * 1024, n0 = (size_t)16384 * 1024 - nlate;
        prep_cvt_fp4(KP(I_peer_v) + n0, WSP(unsigned char, O_PV8) + n0 / 2, nlate, PV4_SCALE, bid - 144, (int)gridDim.x - 144); }
    }
    SEAM(3);
  }
  DBG_DUMP_HALF(14, O_MIX, 1024, 512)
  DBG_DUMP_HALF(15, O_Y, 512, 0)
  DBG_DUMP_CYC(16, (const bf16_t*)make_ssmc().E, 1048576)
  DBG_DUMP_BF16(4, O_MIX)
  for (int rep = 0; rep < R_GEMM; ++rep) {
    run_gemm(lds, WSP(bf16_t, O_MIX), WSP(bf16_t, O_WOUT), NTOK, 1024, 1024, bid, GEpiResB<false>{KP(I_x), WSP(bf16_t, O_XN), SS1_PTR});
    SEAM(5);
    DBG_DUMP_BF16(5, O_XN)
    for (int xb_i = 0; xb_i < R_BAR; ++xb_i) SEAM(5);
  }
  for (int rep = 0; rep < R_GEMM * R_XQ; ++rep) {
    run_gemm(lds, WSP(bf16_t, O_XN), WSP(bf16_t, O_WXQ), NTOK, 1024, 1024, bid, GEpiBf16S{WSP(bf16_t, O_QK), 1024, SS1_PTR});
    if (threadIdx.x == 0) { __builtin_amdgcn_fence(__ATOMIC_ACQUIRE, "agent"); asm volatile("s_waitcnt vmcnt(0)" ::: "memory"); }
  __syncthreads();
  }
  for (int rep = 0; rep < R_XAT; ++rep) {
    ph_xattn(WSP(bf16_t, O_QK), WSP(bf16_t, O_KM), WSP(bf16_t, O_VTM), WSP(bf16_t, O_XO), lds);
    SEAM(8);
    DBG_DUMP_BF16(8, O_XO)
  }
  run_gemm(lds, WSP(bf16_t, O_XO), WSP(bf16_t, O_WXO), NTOK, 1024, 1024, bid, GEpiResB<true>{WSP(bf16_t, O_XN), WSP(bf16_t, O_MIX), SS2_PTR});
  SEAM(9);
  DBG_DUMP_BF16(9, O_MIX)
  for (int rep = 0; rep < R_GEMM * R_PQ; ++rep) {
#if STAG_PQ > 0
    if ((bid >> 3) & 1) { const unsigned long long t0_ = __builtin_amdgcn_s_memrealtime(); while (__builtin_amdgcn_s_memrealtime() - t0_ < (unsigned long long)STAG_PQ * 100ull) __builtin_amdgcn_s_sleep(8); }
#endif
    run_gemm(lds, WSP(bf16_t, O_MIX), WSP(bf16_t, O_WPQ), NTOK, 2048, 1024, bid, GEpiBf16S{WSP(bf16_t, O_QK), 2048, SS2_PTR});
    if (threadIdx.x == 0) { __builtin_amdgcn_fence(__ATOMIC_ACQUIRE, "agent"); asm volatile("s_waitcnt vmcnt(0)" ::: "memory"); }
  __syncthreads();
  }
  for (int rep = 0; rep < R_RTE; ++rep) {
    ph_route(WSP(bf16_t, O_QK), WSP(bf16_t, O_SKB), WSP(int, O_EXP), WSP(float, O_GATE), lds);
    SEAM(12);
  }
  for (int rep = 0; rep < R_GATH; ++rep) {
    float* Hout = (rep + 1 < R_GATH) ? WSP(float, O_QK) : (float*)KP(I_H);
    ph_gather18<GATH_NS, GATH_NB, GATH_NBU>(WSP(bf16_t, O_MIX), WSP(int, O_EXP), WSP(float, O_GATE), WSP(unsigned char, O_PU8), WSP(unsigned char, O_PV8), KP(I_g_final), KP(I_H), Hout, lds, SS2_PTR, KP(I_g_ffn));
    if (rep + 1 < R_GATH) SEAM(13);
  }
}

extern "C" void kernel_launch(void* const* d_in, const int* in_sizes, int n_in, void* d_out, int out_size, void* d_ws,
                              size_t ws_size, hipStream_t stream) {
  Params P{};
  const float** pp = (const float**)&P;
  for (int i = 0; i < 28; ++i) pp[i] = (const float*)d_in[i];
  P.H = (float*)d_out; P.ws = (char*)d_ws;
  static int grid_blocks = 0;
  if (!grid_blocks) {
    int dev = 0, cus = 0, per_cu = 0;
    (void)hipGetDevice(&dev);
    (void)hipDeviceGetAttribute(&cus, hipDeviceAttributeMultiprocessorCount, dev);
    (void)hipFuncSetAttribute((const void*)fwd_megakernel, hipFuncAttributeMaxDynamicSharedMemorySize, LDS_BYTES);
    (void)hipOccupancyMaxActiveBlocksPerMultiprocessor(&per_cu, fwd_megakernel, NTHR, LDS_BYTES);
    grid_blocks = per_cu >= 1 ? cus : -1;
  }
  if (grid_blocks < 0) return;
#if FIRST_SEAM_XCD
  (void)hipMemsetAsync((char*)d_ws + (size_t)O_BAR * 1048576, 0, XCD_BAR_WORDS * 4, stream);
#endif
  void* args[] = {&P};
  (void)hipLaunchCooperativeKernel((void*)fwd_megakernel, dim3(grid_blocks), dim3(NTHR), args, LDS_BYTES, stream);
}
```
